# Optimizing an MI355X kernel written in HIP

```python
import numpy as np
import jax
import jax.numpy as jnp
from jax import lax

D_MODEL = 1024
BATCH = 8
SEQ = 2048
DEPTH = 2

D_FF = 4 * D_MODEL
EPS = 1e-6
Q_BLOCK = 128
N_BRANCH = 3
MASK_NEG = -1e30

GDN_HEADS = 4
GDN_DK = 128
GDN_DV = 128
GDN_CONV = 4
GDN_CHUNK = 64
GDN_QK_W = GDN_HEADS * GDN_DK
GDN_V_W = GDN_HEADS * GDN_DV

NSA_HEADS = 8
NSA_KV_HEADS = 2
NSA_DH = 64
NSA_GROUP = NSA_HEADS // NSA_KV_HEADS
NSA_W = NSA_HEADS * NSA_DH
NSA_KV_W = NSA_KV_HEADS * NSA_DH
CMP_LEN = 32
CMP_STRIDE = 16
SEL_LEN = 64
SEL_TOPK = 8
WINDOW = 512
FORCE_BONUS = 1e3

SB_HEADS = 8
SB_DH = 64
SB_W = SB_HEADS * SB_DH

IN_SPLITS = (GDN_QK_W, GDN_QK_W, GDN_V_W, GDN_V_W, GDN_HEADS, GDN_HEADS,
             NSA_W, 6 * NSA_KV_W, 3 * NSA_HEADS,
             SB_W, SB_W, SB_W,
             N_BRANCH * D_MODEL)
N_IN = sum(IN_SPLITS)

kernel_name = 'hybrid_gdn_nsa_stickbreak_block'


def rms_norm(x, g):
    xf = x.astype(jnp.float32)
    y = xf * lax.rsqrt(jnp.mean(xf * xf, axis=-1, keepdims=True) + EPS)
    return (y * g.astype(jnp.float32)).astype(x.dtype)


def l2_norm(x):
    xf = x.astype(jnp.float32)
    return xf * lax.rsqrt(jnp.sum(xf * xf, axis=-1, keepdims=True) + EPS)


def causal_depthwise_conv(x, w):
    c = x.shape[-1]
    k = w.shape[0]
    return lax.conv_general_dilated(x, w[:, None, :].astype(x.dtype), window_strides=(1,),
                                    padding=[(k - 1, 0)], dimension_numbers=('NWC', 'WIO', 'NWC'),
                                    feature_group_count=c)


def chunk_gated_delta_rule(q, k, v, g, beta):
    b, h, s, dk = q.shape
    dv = v.shape[-1]
    c = GDN_CHUNK
    n = s // c
    q = q.reshape(b, h, n, c, dk)
    k = k.reshape(b, h, n, c, dk)
    v = v.reshape(b, h, n, c, dv)
    g = jnp.cumsum(g.reshape(b, h, n, c), axis=-1)
    beta = beta.reshape(b, h, n, c)
    incl = jnp.tril(jnp.ones((c, c), dtype=bool))
    strict = jnp.tril(jnp.ones((c, c), dtype=bool), -1)
    diff = g[..., :, None] - g[..., None, :]
    decay = jnp.where(incl, jnp.exp(jnp.where(incl, diff, 0.0)), 0.0)
    k_beta = k * beta[..., None]
    a_strict = jnp.where(strict, jnp.einsum('bhnid,bhnjd->bhnij', k_beta, k) * decay, 0.0)
    eye = jnp.eye(c, dtype=q.dtype)
    t_inv = lax.linalg.triangular_solve(a_strict + eye, jnp.broadcast_to(eye, a_strict.shape),
                                        left_side=True, lower=True)
    u = jnp.einsum('bhnij,bhnjd->bhnid', t_inv, v * beta[..., None])
    w = jnp.einsum('bhnij,bhnjd->bhnid', t_inv, k_beta * jnp.exp(g)[..., None])
    attn = jnp.einsum('bhnid,bhnjd->bhnij', q, k) * decay
    g_last = g[..., -1]
    k_dec = k * jnp.exp(g_last[..., None] - g)[..., None]

    def step(state, xs):
        q_c, kd_c, u_c, w_c, g_c, attn_c, gl_c = xs
        v_new = u_c - jnp.einsum('bhck,bhkv->bhcv', w_c, state)
        o = (jnp.einsum('bhck,bhkv->bhcv', q_c * jnp.exp(g_c)[..., None], state)
             + jnp.einsum('bhij,bhjv->bhiv', attn_c, v_new))
        state = state * jnp.exp(gl_c)[..., None, None] + jnp.einsum('bhck,bhcv->bhkv', kd_c, v_new)
        return state, o

    xs = tuple(jnp.moveaxis(t, 2, 0) for t in (q, k_dec, u, w, g, attn, g_last))
    state0 = jnp.zeros((b, h, dk, dv), q.dtype)
    _, o = lax.scan(step, state0, xs)
    return jnp.moveaxis(o, 0, 2).reshape(b, h, s, dv)


def gated_deltanet(q, k, v, z, a, bt, conv_w, a_log, dt_bias, norm_g):
    b, s, _ = q.shape
    dt = q.dtype
    f32 = jnp.float32
    qkv = jax.nn.silu(causal_depthwise_conv(jnp.concatenate([q, k, v], axis=-1), conv_w))
    q, k, v = jnp.split(qkv, [GDN_QK_W, 2 * GDN_QK_W], axis=-1)

    def heads(t, d):
        return t.reshape(b, s, GDN_HEADS, d).transpose(0, 2, 1, 3)

    qh = l2_norm(heads(q, GDN_DK)) * (GDN_DK ** -0.5)
    kh = l2_norm(heads(k, GDN_DK))
    vh = heads(v, GDN_DV).astype(f32)
    beta = jax.nn.sigmoid(bt.astype(f32)).transpose(0, 2, 1)
    g = -(jnp.exp(a_log.astype(f32))[:, None]
          * jax.nn.softplus(a.astype(f32) + dt_bias.astype(f32)).transpose(0, 2, 1))
    o = chunk_gated_delta_rule(qh, kh, vh, g, beta).transpose(0, 2, 1, 3)
    o = rms_norm(o, norm_g) * jax.nn.silu(z.astype(f32).reshape(b, s, GDN_HEADS, GDN_DV))
    return o.reshape(b, s, GDN_V_W).astype(dt)


def native_sparse_attention(q, kv, gate_logits, cmp_wk, cmp_pk, cmp_wv, cmp_pv):
    b, s, _ = q.shape
    dt = q.dtype
    f32 = jnp.float32
    g_, hg, dh = NSA_KV_HEADS, NSA_GROUP, NSA_DH
    qh = (q * (dh ** -0.5)).reshape(b, s, g_, hg, dh)
    k_cmp, v_cmp, k_slc, v_slc, k_win, v_win = [t.reshape(b, s, g_, dh) for t in jnp.split(kv, 6, axis=-1)]
    pos = jnp.arange(s)

    n_cmp = (s - CMP_LEN) // CMP_STRIDE + 1
    blk_start = jnp.arange(n_cmp) * CMP_STRIDE
    gidx = blk_start[:, None] + jnp.arange(CMP_LEN)[None, :]
    kc = jnp.einsum('bnlgd,lde->bnge', k_cmp[:, gidx] + cmp_pk[:, None, :], cmp_wk)
    vc = jnp.einsum('bnlgd,lde->bnge', v_cmp[:, gidx] + cmp_pv[:, None, :], cmp_wv)
    s_cmp = jnp.einsum('bsghd,bngd->bghsn', qh, kc).astype(f32)
    cmp_valid = (blk_start + CMP_LEN - 1)[None, :] <= pos[:, None]
    p_cmp = jax.nn.softmax(jnp.where(cmp_valid, s_cmp, MASK_NEG), axis=-1) * cmp_valid
    o_cmp = jnp.einsum('bghsn,bngd->bsghd', p_cmp.astype(dt), vc)

    n_sel = s // SEL_LEN
    top_k = min(SEL_TOPK, n_sel)
    sel_start_np = np.arange(n_sel) * SEL_LEN
    cmp_start_np = np.arange(n_cmp) * CMP_STRIDE
    overlap = ((cmp_start_np[None, :] < sel_start_np[:, None] + SEL_LEN)
               & (cmp_start_np[None, :] + CMP_LEN > sel_start_np[:, None])).astype(np.float32)
    imp = jnp.einsum('bghsn,jn->bgsj', p_cmp, jnp.asarray(overlap))
    blk = jnp.arange(n_sel)[None, :]
    cur = (pos // SEL_LEN)[:, None]
    sel_valid = blk <= cur
    forced = (blk == 0) | (blk == cur) | (blk == cur - 1)
    score = jnp.where(sel_valid, imp + FORCE_BONUS * forced, MASK_NEG)
    _, sel_idx = lax.top_k(score, top_k)

    ks = k_slc.reshape(b, n_sel, SEL_LEN, g_, dh).transpose(0, 3, 1, 2, 4)
    vs = v_slc.reshape(b, n_sel, SEL_LEN, g_, dh).transpose(0, 3, 1, 2, 4)
    kw = jnp.pad(k_win, ((0, 0), (WINDOW, 0), (0, 0), (0, 0)))
    vw = jnp.pad(v_win, ((0, 0), (WINDOW, 0), (0, 0), (0, 0)))
    b_ix = jnp.arange(b)[:, None, None, None]
    g_ix = jnp.arange(g_)[None, :, None, None]

    def query_block(qb):
        q0 = qb * Q_BLOCK
        qt = lax.dynamic_slice_in_dim(qh, q0, Q_BLOCK, axis=1)
        tq = q0 + jnp.arange(Q_BLOCK)
        idx = lax.dynamic_slice_in_dim(sel_idx, q0, Q_BLOCK, axis=2)
        kg = ks[b_ix, g_ix, idx]
        vg = vs[b_ix, g_ix, idx]
        kpos = idx[..., None] * SEL_LEN + jnp.arange(SEL_LEN)
        smask = kpos <= tq[None, None, :, None, None]
        ss = jnp.einsum('bqghd,bgqkld->bghqkl', qt, kg).astype(f32)
        ss = jnp.where(smask[:, :, None], ss, MASK_NEG)
        ps = jax.nn.softmax(ss.reshape(b, g_, hg, Q_BLOCK, -1), axis=-1).reshape(ss.shape).astype(dt)
        o_s = jnp.einsum('bghqkl,bgqkld->bqghd', ps, vg)
        kwt = lax.dynamic_slice_in_dim(kw, q0, WINDOW + Q_BLOCK, axis=1)
        vwt = lax.dynamic_slice_in_dim(vw, q0, WINDOW + Q_BLOCK, axis=1)
        spos = q0 - WINDOW + jnp.arange(WINDOW + Q_BLOCK)
        dist = tq[:, None] - spos[None, :]
        wmask = (dist >= 0) & (dist < WINDOW) & (spos[None, :] >= 0)
        sw = jnp.einsum('bqghd,bsgd->bghqs', qt, kwt).astype(f32)
        pw = jax.nn.softmax(jnp.where(wmask, sw, MASK_NEG), axis=-1).astype(dt)
        o_w = jnp.einsum('bghqs,bsgd->bqghd', pw, vwt)
        return o_s, o_w

    o_slc, o_win = lax.map(query_block, jnp.arange(s // Q_BLOCK))
    o_slc = jnp.moveaxis(o_slc, 0, 1).reshape(b, s, g_, hg, dh)
    o_win = jnp.moveaxis(o_win, 0, 1).reshape(b, s, g_, hg, dh)
    gates = jax.nn.sigmoid(gate_logits.astype(f32)).reshape(b, s, g_, hg, 3).astype(dt)
    o = gates[..., 0:1] * o_cmp + gates[..., 1:2] * o_slc + gates[..., 2:3] * o_win
    return o.reshape(b, s, NSA_W)


def stick_breaking_attention(q, k, v):
    b, s, _ = q.shape
    f32 = jnp.float32
    qh = (q * (SB_DH ** -0.5)).reshape(b, s, SB_HEADS, SB_DH)
    kh = k.reshape(b, s, SB_HEADS, SB_DH)
    vh = v.reshape(b, s, SB_HEADS, SB_DH)
    spos = jnp.arange(s)

    def query_block(qb):
        q0 = qb * Q_BLOCK
        qt = lax.dynamic_slice_in_dim(qh, q0, Q_BLOCK, axis=1)
        tq = q0 + jnp.arange(Q_BLOCK)
        z = jnp.einsum('bqhd,bshd->bhqs', qt, kh).astype(f32)
        causal = spos[None, :] < tq[:, None]
        cum = jnp.cumsum(jnp.where(causal, jax.nn.log_sigmoid(-z), 0.0), axis=-1)
        log_a = jax.nn.log_sigmoid(z) + cum[..., -1:] - cum
        a = jnp.where(causal, jnp.exp(log_a), 0.0).astype(v.dtype)
        return jnp.einsum('bhqs,bshd->bqhd', a, vh)

    o = lax.map(query_block, jnp.arange(s // Q_BLOCK))
    return jnp.moveaxis(o, 0, 1).reshape(b, s, SB_W)


def hybrid_mixer(h, w_in, gdn_conv_w, gdn_a_log, gdn_dt_bias, gdn_norm_g,
                 nsa_cmp_wk, nsa_cmp_pk, nsa_cmp_wv, nsa_cmp_pv,
                 w_br_gdn, w_br_nsa, w_br_sb, w_out):
    b, s, _ = h.shape
    split_points = [int(p) for p in np.cumsum(IN_SPLITS)[:-1]]
    (gq, gk, gv, gz, ga, gb, nq, nkv, ngate, sq, sk, sv, merge_logits) = jnp.split(h @ w_in, split_points, axis=-1)
    y_a = gated_deltanet(gq, gk, gv, gz, ga, gb, gdn_conv_w, gdn_a_log, gdn_dt_bias, gdn_norm_g)
    y_b = native_sparse_attention(nq, nkv, ngate, nsa_cmp_wk, nsa_cmp_pk, nsa_cmp_wv, nsa_cmp_pv)
    y_c = stick_breaking_attention(sq, sk, sv)
    gate = jax.nn.sigmoid(merge_logits.astype(jnp.float32)).astype(h.dtype).reshape(b, s, N_BRANCH, D_MODEL)
    merged = (gate[:, :, 0] * (y_a @ w_br_gdn) + gate[:, :, 1] * (y_b @ w_br_nsa)
              + gate[:, :, 2] * (y_c @ w_br_sb))
    return merged @ w_out


def squared_relu_mlp(h, w1, w2):
    return jnp.square(jax.nn.relu(h @ w1)) @ w2


def setup_inputs(seed: int = 0) -> dict:
    key = jax.random.key(seed)
    k = jax.random.split(key, 24)
    f32 = jnp.float32

    def dense(kk, shape, fan_in):
        return jax.random.normal(kk, shape, f32) * (fan_in ** -0.5)

    def gain(kk, n):
        return 1.0 + 0.02 * jax.random.normal(kk, (DEPTH, n), f32)

    dt = jnp.exp(jax.random.uniform(k[7], (DEPTH, GDN_HEADS), f32, -6.9077553, -2.3025851))
    return {
        'x': jax.random.normal(k[0], (BATCH, SEQ, D_MODEL), f32),
        'g_mix_pre': gain(k[1], D_MODEL),
        'g_mix_post': gain(k[2], D_MODEL),
        'g_ff_pre': gain(k[3], D_MODEL),
        'g_ff_post': gain(k[4], D_MODEL),
        'w_in': dense(k[5], (DEPTH, D_MODEL, N_IN), D_MODEL),
        'gdn_conv_w': dense(k[6], (DEPTH, GDN_CONV, 2 * GDN_QK_W + GDN_V_W), GDN_CONV),
        'gdn_a_log': jnp.log(jax.random.uniform(k[8], (DEPTH, GDN_HEADS), f32, 1.0, 16.0)),
        'gdn_dt_bias': dt + jnp.log(-jnp.expm1(-dt)),
        'gdn_norm_g': gain(k[9], GDN_DV),
        'nsa_cmp_wk': dense(k[10], (DEPTH, CMP_LEN, NSA_DH, NSA_DH), CMP_LEN * NSA_DH),
        'nsa_cmp_pk': 0.1 * jax.random.normal(k[11], (DEPTH, CMP_LEN, NSA_DH), f32),
        'nsa_cmp_wv': dense(k[12], (DEPTH, CMP_LEN, NSA_DH, NSA_DH), CMP_LEN * NSA_DH),
        'nsa_cmp_pv': 0.1 * jax.random.normal(k[13], (DEPTH, CMP_LEN, NSA_DH), f32),
        'w_br_gdn': dense(k[14], (DEPTH, GDN_V_W, D_MODEL), GDN_V_W),
        'w_br_nsa': dense(k[15], (DEPTH, NSA_W, D_MODEL), NSA_W),
        'w_br_sb': dense(k[16], (DEPTH, SB_W, D_MODEL), SB_W),
        'w_out': dense(k[17], (DEPTH, D_MODEL, D_MODEL), D_MODEL),
        'w_ff1': dense(k[18], (DEPTH, D_MODEL, D_FF), D_MODEL),
        'w_ff2': dense(k[19], (DEPTH, D_FF, D_MODEL), D_FF),
    }


def reference(x, g_mix_pre, g_mix_post, g_ff_pre, g_ff_post, w_in, gdn_conv_w, gdn_a_log,
              gdn_dt_bias, gdn_norm_g, nsa_cmp_wk, nsa_cmp_pk, nsa_cmp_wv, nsa_cmp_pv,
              w_br_gdn, w_br_nsa, w_br_sb, w_out, w_ff1, w_ff2):
    for l in range(DEPTH):
        h = rms_norm(x, g_mix_pre[l])
        y = hybrid_mixer(h, w_in[l], gdn_conv_w[l], gdn_a_log[l], gdn_dt_bias[l], gdn_norm_g[l],
                         nsa_cmp_wk[l], nsa_cmp_pk[l], nsa_cmp_wv[l], nsa_cmp_pv[l],
                         w_br_gdn[l], w_br_nsa[l], w_br_sb[l], w_out[l])
        x = x + rms_norm(y, g_mix_post[l])
        h = rms_norm(x, g_ff_pre[l])
        x = x + rms_norm(squared_relu_mlp(h, w_ff1[l], w_ff2[l]), g_ff_post[l])
    return x
```

```cpp
#include <hip/hip_runtime.h>
#include <hip/hip_bf16.h>
#include <hip/hip_cooperative_groups.h>
#include <cstdio>
namespace cg = cooperative_groups;

typedef unsigned short u16;
using bf16x8 = __attribute__((ext_vector_type(8))) short;
using s16x4  = __attribute__((ext_vector_type(4))) short;
using f32x4  = __attribute__((ext_vector_type(4))) float;
using f32x16 = __attribute__((ext_vector_type(16))) float;
#define DI __device__ __forceinline__

constexpr int T_TOK = 16384, SEQL = 2048;
constexpr int NPJ = 4896;
constexpr int N_IN = 7968;
constexpr int C_GQ = 0, C_GK = 512, C_GV = 1024, C_GZ = 1536, C_GA = 2048, C_GB = 2052, C_NQ = 2056, C_NKV = 2568,
              C_NG = 3336, C_SQ = 3360, C_SK = 3872;
constexpr size_t OFF_WBR  = 0;
constexpr size_t OFF_WOUT = 3145728;
constexpr size_t OFF_WBIG = 5242880;
constexpr size_t OFF_PROJ = 22020096;
constexpr size_t OFF_SCR  = OFF_PROJ + 160432128;
constexpr size_t OFF_H    = OFF_SCR + 33554432;
constexpr size_t OFF_HALO = OFF_H + 33554432;
constexpr size_t OFF_KC   = OFF_HALO + 2359296;
constexpr size_t OFF_VCT  = OFF_KC + 262144;
constexpr size_t OFF_EGL  = OFF_VCT + 262144;
constexpr size_t OFF_WT   = OFF_EGL + 4096;
constexpr size_t OFF_CB   = OFF_WT + 524288;
constexpr size_t OFF_BAR  = OFF_CB + 512;
constexpr size_t OFF_QCTR = OFF_BAR + 14336;
constexpr size_t WS_NEED  = OFF_BAR + 16384;
constexpr int LDS_XST = 155648;
constexpr int LDS_BYTES = LDS_XST + 32;

struct Params {
  const float* x; const float* g_mix_pre; const float* g_mix_post; const float* g_ff_pre; const float* g_ff_post;
  const float* w_in; const float* conv_w; const float* a_log; const float* dt_bias; const float* norm_g;
  const float* cmp_wk; const float* cmp_pk; const float* cmp_wv; const float* cmp_pv;
  const float* w_br0; const float* w_br1; const float* w_br2; const float* w_out; const float* w_ff1; const float* w_ff2;
  float* out; char* ws;
};

extern __shared__ __attribute__((aligned(16))) char g_shm[];

typedef __bf16 bf2_t __attribute__((ext_vector_type(2)));
typedef float f2_t __attribute__((ext_vector_type(2)));
typedef unsigned u32x2 __attribute__((ext_vector_type(2)));
typedef unsigned u32x4 __attribute__((ext_vector_type(4)));
DI unsigned cvt2(float a, float b) { f2_t v; v[0] = a; v[1] = b; return __builtin_bit_cast(unsigned, __builtin_convertvector(v, bf2_t)); }
DI u16 f2bf(float x) { return (u16)(cvt2(x, x) & 0xffffu); }
DI float bf2f(u16 b) { return __uint_as_float(((unsigned)b) << 16); }
DI float bfs(short b) { return __uint_as_float(((unsigned)(u16)b) << 16); }
DI bf16x8 ld8(const u16* p) { return *(const bf16x8*)p; }
DI s16x4 ld4(const u16* p) { return *(const s16x4*)p; }
DI f32x4 mfma16(bf16x8 a, bf16x8 b, f32x4 c) { return __builtin_amdgcn_mfma_f32_16x16x32_bf16(a, b, c, 0, 0, 0); }
DI f32x16 mfma32(bf16x8 a, bf16x8 b, f32x16 c) { return __builtin_amdgcn_mfma_f32_32x32x16_bf16(a, b, c, 0, 0, 0); }
DI s16x4 pack4(float a, float b, float c, float d) { u32x2 r; r[0] = cvt2(a, b); r[1] = cvt2(c, d); return __builtin_bit_cast(s16x4, r); }
DI float sigmoidf_(float x) { return 1.f / (1.f + __expf(-x)); }
DI float softplusf_(float x) { return fmaxf(x, 0.f) + log1pf(__expf(-fabsf(x))); }
DI int lv(int v) { asm volatile("" : "+v"(v)); return v; }
DI char* lsp(char* q) { auto g = (__attribute__((address_space(1))) char*)q; asm volatile("" : "+s"(g)); return (char*)g; }
typedef const __attribute__((address_space(4))) Params* kparg_t;
#if defined(__HIP_DEVICE_COMPILE__)
DI Params kp() { kparg_t q = (kparg_t)__builtin_amdgcn_kernarg_segment_ptr(); asm volatile("" : "+s"(q)); return *q; }
#else
DI Params kp() { return Params{}; }
#endif
DI char* lds_base() { auto q = (__attribute__((address_space(3))) char*)g_shm; asm volatile("" : "+v"(q)); return (char*)q; }
DI void lds_barrier() { asm volatile("s_waitcnt lgkmcnt(0)" ::: "memory"); __builtin_amdgcn_s_barrier(); asm volatile("" ::: "memory"); }
DI int crow(int i, int h) { return (i & 3) + 8 * (i >> 2) + 4 * h; }
DI bf16x8 pack8(const f32x16& x, int s) {
  u32x4 r;
  r[0] = cvt2(x[8 * s + 0], x[8 * s + 1]); r[1] = cvt2(x[8 * s + 2], x[8 * s + 3]);
  r[2] = cvt2(x[8 * s + 4], x[8 * s + 5]); r[3] = cvt2(x[8 * s + 6], x[8 * s + 7]);
  return __builtin_bit_cast(bf16x8, r);
}

static __device__ __attribute__((always_inline)) inline void convert_weight(const float* W, int K, int N, u16* out, int ldo, bool winmap) {
  float* lds = (float*)lds_base();
  const int tid = lv(threadIdx.x);
  const int nkt = K / 64, nnt = (N + 127) / 128;
  for (int t = blockIdx.x; t < nkt * nnt; t += gridDim.x) {
    const int kt = t % nkt, nt = t / nkt, k0 = kt * 64, n0 = nt * 128;
#pragma unroll
    for (int q = 0; q < 16; ++q) {
      const int e = tid + q * 512, kk = e >> 7, nn = e & 127, n = n0 + nn;
      lds[kk * 129 + nn] = (n < N) ? W[(size_t)(k0 + kk) * N + n] : 0.f;
    }
    lds_barrier();
#pragma unroll
    for (int rep = 0; rep < 2; ++rep) {
      const int nn = (tid >> 3) + 64 * rep, ks = tid & 7, n = n0 + nn;
      if (n < N) {
        const int orow = winmap ? (n < NPJ ? n : n + 224) : n;
        u32x4 v;
#pragma unroll
        for (int e = 0; e < 4; ++e) v[e] = cvt2(lds[(ks * 8 + 2 * e) * 129 + nn], lds[(ks * 8 + 2 * e + 1) * 129 + nn]);
        *(u32x4*)(out + (size_t)orow * ldo + k0 + ks * 8) = v;
      }
    }
    lds_barrier();
  }
  __syncthreads();
}

static __device__ __attribute__((always_inline)) inline void convert_mixer_weights(const Params& p, int l) {
  char* ws = lsp(p.ws);
  convert_weight(p.w_in + (size_t)l * 1024 * N_IN, 1024, N_IN, (u16*)(ws + OFF_WBIG), 1024, true);
  convert_weight(p.w_br0 + (size_t)l * 512 * 1024, 512, 1024, (u16*)(ws + OFF_WBR), 512, false);
  convert_weight(p.w_br1 + (size_t)l * 512 * 1024, 512, 1024, (u16*)(ws + OFF_WBR) + 1024 * 512, 512, false);
  convert_weight(p.w_br2 + (size_t)l * 512 * 1024, 512, 1024, (u16*)(ws + OFF_WBR) + 2 * 1024 * 512, 512, false);
  convert_weight(p.w_out + (size_t)l * 1024 * 1024, 1024, 1024, (u16*)(ws + OFF_WOUT), 1024, false);
  convert_weight(p.cmp_wk + (size_t)l * 131072, 2048, 64, (u16*)(ws + OFF_WT), 2048, false);
  convert_weight(p.cmp_wv + (size_t)l * 131072, 2048, 64, (u16*)(ws + OFF_WT) + 64 * 2048, 2048, false);
  if (blockIdx.x < 2) {
    const int kv = blockIdx.x, tid = lv(threadIdx.x), e = tid & 63, part = tid >> 6;
    const float* W = (kv ? p.cmp_wv : p.cmp_wk) + (size_t)l * 131072;
    const float* pp = (kv ? p.cmp_pv : p.cmp_pk) + (size_t)l * 2048;
    float* red = (float*)lds_base();
    float sacc = 0.f;
    for (int k = part * 256; k < part * 256 + 256; ++k) sacc += pp[k] * W[k * 64 + e];
    red[part * 64 + e] = sacc;
    __syncthreads();
    if (tid < 64) { float t = 0.f; for (int q = 0; q < 8; ++q) t += red[q * 64 + tid]; ((float*)(ws + OFF_CB))[kv * 64 + tid] = t; }
    __syncthreads();
  }
}
static __device__ __attribute__((always_inline)) inline void convert_ffn_weights(const Params& p, int l) {
  char* ws = lsp(p.ws);
  convert_weight(p.w_ff1 + (size_t)l * 1024 * 4096, 1024, 4096, (u16*)(ws + OFF_WBIG), 1024, false);
  convert_weight(p.w_ff2 + (size_t)l * 4096 * 1024, 4096, 1024, (u16*)(ws + OFF_WBIG) + (size_t)4096 * 1024, 4096, false);
}

DI float wave_sum(float v) {
#pragma unroll
  for (int o = 32; o > 0; o >>= 1) v += __shfl_xor(v, o);
  return v;
}
static __device__ __attribute__((always_inline)) inline void phase_norm(const float* xin, const u16* y, const float* g_post, const float* g_next, float* xout, u16* H) {
  const int tidn = lv(threadIdx.x);
  const int wave = tidn >> 6, lane = tidn & 63;
  for (int row0 = (blockIdx.x * 8 + wave) * 2; row0 < T_TOK; row0 += gridDim.x * 16) {
    float xv[2][16], yv[2][16];
#pragma unroll
    for (int rr = 0; rr < 2; ++rr)
#pragma unroll
      for (int i = 0; i < 4; ++i) {
        f32x4 t = *(const f32x4*)(xin + (size_t)(row0 + rr) * 1024 + i * 256 + lane * 4);
        xv[rr][i * 4 + 0] = t[0]; xv[rr][i * 4 + 1] = t[1]; xv[rr][i * 4 + 2] = t[2]; xv[rr][i * 4 + 3] = t[3];
      }
    if (y) {
      float ss[2] = {0.f, 0.f};
#pragma unroll
      for (int rr = 0; rr < 2; ++rr)
#pragma unroll
        for (int i = 0; i < 4; ++i) {
          s16x4 t = ld4(y + (size_t)(row0 + rr) * 1024 + i * 256 + lane * 4);
#pragma unroll
          for (int e = 0; e < 4; ++e) { yv[rr][i * 4 + e] = bfs(t[e]); ss[rr] += yv[rr][i * 4 + e] * yv[rr][i * 4 + e]; }
        }
#pragma unroll
      for (int o = 32; o > 0; o >>= 1) { float t0 = __shfl_xor(ss[0], o), t1 = __shfl_xor(ss[1], o); ss[0] += t0; ss[1] += t1; }
#pragma unroll
      for (int rr = 0; rr < 2; ++rr) {
        const float r = rsqrtf(ss[rr] * (1.f / 1024.f) + 1e-6f);
#pragma unroll
        for (int i = 0; i < 4; ++i) {
          f32x4 g = *(const f32x4*)(g_post + i * 256 + lane * 4);
          f32x4 o;
#pragma unroll
          for (int e = 0; e < 4; ++e) { xv[rr][i * 4 + e] += yv[rr][i * 4 + e] * r * g[e]; o[e] = xv[rr][i * 4 + e]; }
          *(f32x4*)(xout + (size_t)(row0 + rr) * 1024 + i * 256 + lane * 4) = o;
        }
      }
    }
    if (g_next) {
      float ss[2] = {0.f, 0.f};
#pragma unroll
      for (int rr = 0; rr < 2; ++rr)
#pragma unroll
        for (int i = 0; i < 16; ++i) ss[rr] += xv[rr][i] * xv[rr][i];
#pragma unroll
      for (int o = 32; o > 0; o >>= 1) { float t0 = __shfl_xor(ss[0], o), t1 = __shfl_xor(ss[1], o); ss[0] += t0; ss[1] += t1; }
#pragma unroll
      for (int rr = 0; rr < 2; ++rr) {
        const float r = rsqrtf(ss[rr] * (1.f / 1024.f) + 1e-6f);
#pragma unroll
        for (int i = 0; i < 4; ++i) {
          f32x4 g = *(const f32x4*)(g_next + i * 256 + lane * 4);
          *(s16x4*)(H + (size_t)(row0 + rr) * 1024 + i * 256 + lane * 4) =
              pack4(xv[rr][i * 4] * r * g[0], xv[rr][i * 4 + 1] * r * g[1], xv[rr][i * 4 + 2] * r * g[2], xv[rr][i * 4 + 3] * r * g[3]);
        }
      }
    }
  }
}

constexpr int BM = 256, BK = 64, HALF = 128, HT = HALF * BK;
DI int lds_byte(int r, int c) {
  int st = (r >> 4) * 2 + (c >> 5), rr = r & 15, cc = c & 31, ob = rr * 64 + cc * 2;
  return st * 1024 + (ob ^ (((ob >> 9) & 1) << 5));
}
DI void stage_rc(int b, int& R, int& C) {
  int st = b / 1024, sb = b % 1024, swz = sb ^ (((sb >> 9) & 1) << 5);
  R = (st >> 1) * 16 + swz / 64; C = (st & 1) * 32 + (swz % 64) / 2;
}
DI void tile_map(int wgid, int nM, int nN, int& pm, int& pn) {
  const int NXCD = 8, WGM = 8;
  int nwg = nM * nN;
  { int q = nwg / NXCD, r = nwg % NXCD, xcd = wgid % NXCD, off = wgid / NXCD;
    wgid = (xcd < r ? xcd * (q + 1) : r * (q + 1) + (xcd - r) * q) + off; }
  int nig = WGM * nN, gid = wgid / nig, fm = gid * WGM, gsz = min(nM - fm, WGM);
  pm = fm + ((wgid % nig) % gsz); pn = (wgid % nig) / gsz;
}

struct NoPre { DI void operator()(int, int, int) const {} };
template <class Epi, class Pre = NoPre>
DI void gemm_tile(const u16* A, int lda, const u16* Bt, int ldb, int K, int brow, int bcol, Epi epi, Pre pre = Pre()) {
  u16* shm = (u16*)g_shm;
#define SA(b, h) (shm + ((b) * 2 + (h)) * HT)
#define SB(b, h) (shm + (4 + (b) * 2 + (h)) * HT)
#define STAGE(P, BASE, LD, br, kt) do { const char* _gb = (const char*)((BASE) + (size_t)(br) * (LD) + (size_t)(kt) * BK); \
    for (int _i = 0; _i < 2; ++_i) { int _b = tidx * 16 + _i * 8192; \
      __builtin_amdgcn_global_load_lds((const unsigned*)(_gb + (((LD) == lda) ? offA[_i] : offB[_i])), \
        (__attribute__((address_space(3))) unsigned*)((char*)(P) + _b), 16, 0, 0); } } while (0)
#define LDA(dst, b, h) for (int m = 0; m < 4; ++m) for (int k = 0; k < 2; ++k) \
    dst[m][k] = *reinterpret_cast<const bf16x8*>((char*)SA(b, h) + lds_byte(wr * 64 + m * 16 + fr, k * 32 + fq * 8))
#define LDB(dst, b, h) for (int n = 0; n < 2; ++n) for (int k = 0; k < 2; ++k) \
    dst[n][k] = *reinterpret_cast<const bf16x8*>((char*)SB(b, h) + lds_byte(wc * 32 + n * 16 + fr, k * 32 + fq * 8))
#define MMA(ai, bj, At_, Bt_) do { __builtin_amdgcn_s_setprio(1); \
    for (int m = 0; m < 4; ++m) for (int n = 0; n < 2; ++n) for (int k = 0; k < 2; ++k) \
      acc[ai][bj][m][n] = __builtin_amdgcn_mfma_f32_16x16x32_bf16(Bt_[n][k], At_[m][k], acc[ai][bj][m][n], 0, 0, 0); \
    __builtin_amdgcn_s_setprio(0); } while (0)
#define WAIT_V(n) asm volatile("s_waitcnt vmcnt(" #n ")" ::: "memory")
#define WAIT_L(n) asm volatile("s_waitcnt lgkmcnt(" #n ")" ::: "memory")
#define BAR __builtin_amdgcn_s_barrier()
#define SCHED __builtin_amdgcn_sched_barrier(0)
  int tidx = threadIdx.x; asm volatile("" : "+v"(tidx));
  const int wid = tidx >> 6, lane = tidx & 63, wr = wid >> 2, wc = wid & 3, fr = lane & 15, fq = lane >> 4;
  unsigned offA[2], offB[2];
#pragma unroll
  for (int _i = 0; _i < 2; ++_i) { int _r, _c; stage_rc(tidx * 16 + _i * 8192, _r, _c); offA[_i] = (unsigned)(_r * lda + _c) * 2u; offB[_i] = (unsigned)(_r * ldb + _c) * 2u; }
  f32x4 acc[2][2][4][2] = {};
  bf16x8 At[4][2], B0[2][2], B1[2][2];
  const int nt = K / BK;
  STAGE(SB(0, 0), Bt, ldb, bcol, 0); STAGE(SA(0, 0), A, lda, brow, 0);
  STAGE(SB(0, 1), Bt, ldb, bcol + HALF, 0); STAGE(SA(0, 1), A, lda, brow + HALF, 0);
  if (wr == 1) BAR;
  WAIT_V(4); BAR;
  STAGE(SB(1, 0), Bt, ldb, bcol, 1); STAGE(SA(1, 0), A, lda, brow, 1); STAGE(SB(1, 1), Bt, ldb, bcol + HALF, 1);
  WAIT_V(6); BAR;
  for (int t = 0; t < nt - 2; t += 2) {
    LDB(B0, 0, 0); SCHED; LDA(At, 0, 0); STAGE(SA(1, 1), A, lda, brow + HALF, t + 1);
    WAIT_L(8); BAR; WAIT_L(0); MMA(0, 0, At, B0); BAR; SCHED;
    LDB(B1, 0, 1); STAGE(SB(0, 0), Bt, ldb, bcol, t + 2);
    BAR; WAIT_L(0); MMA(0, 1, At, B1); BAR;
    LDA(At, 0, 1); STAGE(SA(0, 0), A, lda, brow, t + 2);
    BAR; WAIT_L(0); MMA(1, 0, At, B0); BAR; SCHED;
    STAGE(SB(0, 1), Bt, ldb, bcol + HALF, t + 2);
    WAIT_V(6); BAR; MMA(1, 1, At, B1); BAR;
    LDB(B0, 1, 0); SCHED; LDA(At, 1, 0); STAGE(SA(0, 1), A, lda, brow + HALF, t + 2);
    WAIT_L(8); BAR; WAIT_L(0); MMA(0, 0, At, B0); BAR; SCHED;
    LDB(B1, 1, 1); STAGE(SB(1, 0), Bt, ldb, bcol, t + 3);
    BAR; WAIT_L(0); MMA(0, 1, At, B1); BAR;
    LDA(At, 1, 1); STAGE(SA(1, 0), A, lda, brow, t + 3);
    BAR; WAIT_L(0); MMA(1, 0, At, B0); BAR; SCHED;
    STAGE(SB(1, 1), Bt, ldb, bcol + HALF, t + 3);
    WAIT_V(6); BAR; MMA(1, 1, At, B1); BAR;
  }
  { LDB(B0, 0, 0); LDA(At, 0, 0); STAGE(SA(1, 1), A, lda, brow + HALF, nt - 1);
    BAR; WAIT_L(0); MMA(0, 0, At, B0); BAR;
    LDB(B1, 0, 1); BAR; WAIT_L(0); MMA(0, 1, At, B1); BAR;
    LDA(At, 0, 1); WAIT_V(4); BAR; WAIT_L(0); MMA(1, 0, At, B0); MMA(1, 1, At, B1); BAR; }
  { LDB(B0, 1, 0); LDA(At, 1, 0); WAIT_V(2); BAR; WAIT_L(0); MMA(0, 0, At, B0); BAR;
    LDB(B1, 1, 1); WAIT_V(0); BAR; WAIT_L(0); MMA(0, 1, At, B1); BAR;
    LDA(At, 1, 1); BAR; WAIT_L(0); MMA(1, 0, At, B0); MMA(1, 1, At, B1); BAR; }
  if (wr == 0) BAR;
  int tid2 = tidx; asm volatile("" : "+v"(tid2));
  const int wid2 = tid2 >> 6, lane2 = tid2 & 63, wr2 = wid2 >> 2, wc2 = wid2 & 3, fr2 = lane2 & 15, fq2 = lane2 >> 4;
#pragma unroll
  for (int ai = 0; ai < 2; ++ai)
#pragma unroll
    for (int bj = 0; bj < 2; ++bj)
#pragma unroll
      for (int m = 0; m < 4; ++m) {
#pragma unroll
        for (int n = 0; n < 2; ++n)
          pre(n, brow + ai * HALF + wr2 * 64 + m * 16 + fr2, bcol + bj * HALF + wc2 * 32 + n * 16 + fq2 * 4);
#pragma unroll
        for (int n = 0; n < 2; ++n)
          epi(n, brow + ai * HALF + wr2 * 64 + m * 16 + fr2, bcol + bj * HALF + wc2 * 32 + n * 16 + fq2 * 4, acc[ai][bj][m][n]);
      }
  __syncthreads();
#undef SA
#undef SB
#undef STAGE
#undef LDA
#undef LDB
#undef MMA
}

static __device__ __attribute__((always_inline)) inline void phase_inproj(const Params& p) {
  char* ws = lsp(p.ws);
  u16* H = (u16*)(ws + OFF_H); u16* WinT = (u16*)(ws + OFF_WBIG); u16* PROJ = (u16*)(ws + OFF_PROJ);
  u16* HALO = (u16*)(ws + OFF_HALO);
  const int nM = 64, nN = 20;
  for (int t = blockIdx.x; t < nM * nN; t += gridDim.x) {
    int pm, pn; tile_map(t, nM, nN, pm, pn);
    gemm_tile(H, 1024, WinT, 1024, 1024, pm * 256, pn * 256, [&](int idx, int row, int col, f32x4 v) {
      if (col < NPJ) {
        s16x4 b = pack4(v[0], v[1], v[2], v[3]);
        *(s16x4*)(PROJ + (size_t)row * NPJ + col) = b;
        if (col < 1536 && (row & 63) >= 61) *(s16x4*)(HALO + ((size_t)(row >> 6) * 3 + ((row & 63) - 61)) * 1536 + col) = b;
      }
    });
  }
}

static __device__ __attribute__((always_inline)) inline void sb_attn_wave(const Params& p, int witem) {
  u16* PROJ = (u16*)(lsp(p.ws) + OFF_PROJ);
  const int tid = lv(threadIdx.x), lane = tid & 63, w = tid >> 6, lq5 = lane & 31, hf = lane >> 5;
  u16* VT = (u16*)lds_base() + w * (64 * 40);
  const int b = witem >> 8, h = (witem >> 5) & 7, qt = witem & 31;
  const int t0 = qt * 64;
  bf16x8 qf[2][4];
#pragma unroll
  for (int qi = 0; qi < 2; ++qi)
#pragma unroll
    for (int s = 0; s < 4; ++s) {
      bf16x8 raw = ld8(PROJ + ((size_t)b * SEQL + t0 + 32 * qi + lq5) * NPJ + C_SQ + h * 64 + 16 * s + 8 * hf);
#pragma unroll
      for (int e = 0; e < 8; ++e) raw[e] = (short)f2bf(bfs(raw[e]) * 0.125f);
      qf[qi][s] = raw;
    }
  f32x16 oacc[2][2];
#pragma unroll
  for (int i = 0; i < 16; ++i) { oacc[0][0][i] = 0.f; oacc[0][1][i] = 0.f; oacc[1][0][i] = 0.f; oacc[1][1][i] = 0.f; }
  float carry[2] = {1.f, 1.f};
#pragma unroll 1
  for (int k0 = t0 + 32; k0 >= 0; k0 -= 32) {
    const size_t krow = ((size_t)b * SEQL + k0 + lq5) * NPJ + C_SK + h * 64;
    {
      bf16x8 v0 = ld8(PROJ + krow + 512 + hf * 32), v1 = ld8(PROJ + krow + 512 + hf * 32 + 8);
      bf16x8 v2 = ld8(PROJ + krow + 512 + hf * 32 + 16), v3 = ld8(PROJ + krow + 512 + hf * 32 + 24);
#pragma unroll
      for (int e = 0; e < 8; ++e) {
        VT[(hf * 32 + e) * 40 + lq5] = (u16)v0[e]; VT[(hf * 32 + 8 + e) * 40 + lq5] = (u16)v1[e];
        VT[(hf * 32 + 16 + e) * 40 + lq5] = (u16)v2[e]; VT[(hf * 32 + 24 + e) * 40 + lq5] = (u16)v3[e];
      }
    }
    bf16x8 kf[4];
#pragma unroll
    for (int s = 0; s < 4; ++s) kf[s] = ld8(PROJ + krow + 16 * s + 8 * hf);
#pragma unroll
    for (int qi = 0; qi < 2; ++qi) {
      if (k0 >= t0 + 32 * qi + 31) continue;
      f32x16 st;
#pragma unroll
      for (int i = 0; i < 16; ++i) st[i] = 0.f;
#pragma unroll
      for (int s = 0; s < 4; ++s) st = mfma32(kf[s], qf[qi][s], st);
      const int t = t0 + 32 * qi + lq5;
      float m[16];
#pragma unroll
      for (int i = 0; i < 16; ++i) {
        const float z = fminf(fmaxf(st[i], -80.f), 80.f);
        const float e = __expf(z);
        const float r = __builtin_amdgcn_rcpf(1.f + e);
        const bool c = (k0 + crow(i, hf)) < t;
        m[i] = c ? r : 1.f;
        st[i] = c ? e * r : 0.f;
      }
      float T[4], P[4];
#pragma unroll
      for (int gi = 0; gi < 4; ++gi) { T[gi] = (m[4 * gi] * m[4 * gi + 1]) * (m[4 * gi + 2] * m[4 * gi + 3]); P[gi] = __shfl_xor(T[gi], 32); }
      float aft[4];
      aft[3] = (hf == 0) ? P[3] : 1.f;
      aft[2] = T[3] * P[3] * ((hf == 0) ? P[2] : 1.f);
      aft[1] = T[3] * P[3] * T[2] * P[2] * ((hf == 0) ? P[1] : 1.f);
      aft[0] = T[3] * P[3] * T[2] * P[2] * T[1] * P[1] * ((hf == 0) ? P[0] : 1.f);
      const float cin = carry[qi];
#pragma unroll
      for (int gi = 0; gi < 4; ++gi) {
        const float base = cin * aft[gi];
        const float w2 = m[4 * gi + 3], w1 = w2 * m[4 * gi + 2], w0 = w1 * m[4 * gi + 1];
        st[4 * gi + 0] *= base * w0;
        st[4 * gi + 1] *= base * w1;
        st[4 * gi + 2] *= base * w2;
        st[4 * gi + 3] *= base;
      }
      carry[qi] = cin * ((T[0] * P[0]) * (T[1] * P[1])) * ((T[2] * P[2]) * (T[3] * P[3]));
#pragma unroll
      for (int s = 0; s < 2; ++s) {
        bf16x8 pf = pack8(st, s);
#pragma unroll
        for (int dt = 0; dt < 2; ++dt) {
          const u16* vp = VT + (32 * dt + lq5) * 40 + 16 * s + 4 * hf;
          s16x4 lo = ld4(vp), hi = ld4(vp + 8);
          bf16x8 vf = __builtin_shufflevector(lo, hi, 0, 1, 2, 3, 4, 5, 6, 7);
          oacc[qi][dt] = mfma32(vf, pf, oacc[qi][dt]);
        }
      }
    }
    if (k0 <= t0 && __all(carry[0] < 1.2e-38f && carry[1] < 1.2e-38f)) break;
  }
#pragma unroll
  for (int qi = 0; qi < 2; ++qi)
#pragma unroll
    for (int dt = 0; dt < 2; ++dt)
#pragma unroll
      for (int g4 = 0; g4 < 4; ++g4)
        *(s16x4*)(PROJ + ((size_t)b * SEQL + t0 + 32 * qi + lq5) * NPJ + C_SQ + h * 64 + 32 * dt + 8 * g4 + 4 * hf) =
            pack4(oacc[qi][dt][4 * g4], oacc[qi][dt][4 * g4 + 1], oacc[qi][dt][4 * g4 + 2], oacc[qi][dt][4 * g4 + 3]);
}

static __device__ __attribute__((always_inline)) inline void nsa_compress(const Params& p, int l, int item) {
  char* ws = lsp(p.ws);
  const u16* PROJ = (const u16*)(ws + OFF_PROJ);
  u16* KC = (u16*)(ws + OFF_KC); u16* VCT = (u16*)(ws + OFF_VCT);
  const u16* WT = (const u16*)(ws + OFF_WT); const float* CB = (const float*)(ws + OFF_CB);
  float* red = (float*)lds_base();
  const int tid = lv(threadIdx.x), lane = tid & 63, w = tid >> 6, lq5 = lane & 31, hf = lane >> 5;
  const int nt4 = item & 3, kv = (item >> 2) & 1, g = (item >> 3) & 1, b = item >> 4;
  const int n = 32 * nt4 + lq5;
  f32x16 acc[2];
#pragma unroll
  for (int i = 0; i < 16; ++i) { acc[0][i] = 0.f; acc[1][i] = 0.f; }
#pragma unroll 4
  for (int ks = 0; ks < 16; ++ks) {
    const int ll = 4 * w + (ks >> 2), d0 = (ks & 3) * 16 + 8 * hf;
    bf16x8 a;
#pragma unroll
    for (int e = 0; e < 8; ++e) a[e] = 0;
    if (n < 127) a = ld8(PROJ + ((size_t)b * SEQL + 16 * n + ll) * NPJ + C_NKV + kv * 128 + g * 64 + d0);
#pragma unroll
    for (int et = 0; et < 2; ++et)
      acc[et] = mfma32(a, ld8(WT + ((size_t)(kv * 64 + 32 * et + lq5)) * 2048 + ll * 64 + d0), acc[et]);
  }
#pragma unroll
  for (int et = 0; et < 2; ++et)
#pragma unroll
    for (int i = 0; i < 16; ++i) red[(w * 32 + crow(i, hf)) * 64 + 32 * et + lq5] = acc[et][i];
  __syncthreads();
  {
    const int nl = tid >> 4, e0 = (tid & 15) * 4;
    float v[4];
#pragma unroll
    for (int q = 0; q < 4; ++q) v[q] = CB[kv * 64 + e0 + q];
#pragma unroll
    for (int ww = 0; ww < 8; ++ww)
#pragma unroll
      for (int q = 0; q < 4; ++q) v[q] += red[(ww * 32 + nl) * 64 + e0 + q];
    const int nn = 32 * nt4 + nl;
    if (nn >= 127) { v[0] = 0.f; v[1] = 0.f; v[2] = 0.f; v[3] = 0.f; }
    if (kv == 0) *(s16x4*)(KC + ((size_t)(b * 2 + g) * 128 + nn) * 64 + e0) = pack4(v[0], v[1], v[2], v[3]);
    else {
#pragma unroll
      for (int q = 0; q < 4; ++q) VCT[((size_t)(b * 2 + g) * 64 + e0 + q) * 128 + nn] = f2bf(v[q]);
    }
  }
  __syncthreads();
}

static __device__ __attribute__((always_inline)) inline void gdn_prep(const Params& p, int l, int item) {
  char* ws = lsp(p.ws);
  u16* PROJ = (u16*)(ws + OFF_PROJ); u16* HALO = (u16*)(ws + OFF_HALO);
  u16* WG = (u16*)(ws + OFF_SCR); u16* ATT = (u16*)(ws + OFF_SCR + 16777216);
  float* EGL = (float*)(ws + OFF_EGL);
  u16* Qb = (u16*)lds_base();
  u16* Kb = Qb + 64 * 136;
  u16* vbT = Kb + 64 * 136;
  u16* kbT = vbT + 128 * 72;
  float* As = (float*)(kbT + 128 * 72);
  u16* Tb = (u16*)(As + 64 * 65);
  float* sg = (float*)(Tb + 64 * 72);
  float* sbeta = sg + 64; float* sgc = sbeta + 64;
  const int tid = lv(threadIdx.x), lane = tid & 63, w = tid >> 6, lr = lane & 15, lq = lane >> 4;
  const int c = item & 31, h = (item >> 5) & 3, b = item >> 7;
  const int t0 = b * SEQL + c * 64;
  const int i = tid & 63, cgp = tid >> 6;
  const float* cw = p.conv_w + (size_t)l * 4 * 1536;
  if (tid < 64) {
    float a = bf2f(PROJ[(size_t)(t0 + tid) * NPJ + C_GA + h]);
    float bt = bf2f(PROJ[(size_t)(t0 + tid) * NPJ + C_GB + h]);
    sg[tid] = -__expf(p.a_log[l * 4 + h]) * softplusf_(a + p.dt_bias[l * 4 + h]);
    sbeta[tid] = sigmoidf_(bt);
  }
  float qkv[3][16];
  {
    bf16x8 xr[3][4][2];
#pragma unroll
    for (int sec = 0; sec < 3; ++sec)
#pragma unroll
      for (int j = 0; j < 4; ++j) {
        const int colb = sec * 512 + h * 128 + cgp * 16;
        const int ii = i - 3 + j;
        const u16* src = (ii >= 0) ? PROJ + (size_t)(t0 + ii) * NPJ + colb
                                   : HALO + ((size_t)(max(t0 >> 6, 1) - 1) * 3 + (3 + ii)) * 1536 + colb;
        xr[sec][j][0] = ld8(src); xr[sec][j][1] = ld8(src + 8);
      }
#pragma unroll
    for (int sec = 0; sec < 3; ++sec) {
      const int colb = sec * 512 + h * 128 + cgp * 16;
#pragma unroll
      for (int e = 0; e < 16; ++e) qkv[sec][e] = 0.f;
#pragma unroll
      for (int j = 0; j < 4; ++j) {
        const int ii = i - 3 + j;
        const float keep = (ii >= 0 || c > 0) ? 1.f : 0.f;
#pragma unroll
        for (int e = 0; e < 8; ++e) {
          qkv[sec][e] += (keep * cw[j * 1536 + colb + e]) * bfs(xr[sec][j][0][e]);
          qkv[sec][8 + e] += (keep * cw[j * 1536 + colb + 8 + e]) * bfs(xr[sec][j][1][e]);
        }
      }
#pragma unroll
      for (int e = 0; e < 16; ++e) { float x = qkv[sec][e]; qkv[sec][e] = x * __builtin_amdgcn_rcpf(1.f + __expf(-x)); }
    }
  }
  {
    float sq = 0.f, sk = 0.f;
#pragma unroll
    for (int e = 0; e < 16; ++e) { sq += qkv[0][e] * qkv[0][e]; sk += qkv[1][e] * qkv[1][e]; }
    float* rdn = As;
    rdn[(0 * 8 + cgp) * 64 + i] = sq; rdn[(1 * 8 + cgp) * 64 + i] = sk;
    __syncthreads();
    sq = 0.f; sk = 0.f;
#pragma unroll
    for (int cc = 0; cc < 8; ++cc) { sq += rdn[(0 * 8 + cc) * 64 + i]; sk += rdn[(1 * 8 + cc) * 64 + i]; }
    float rq = rsqrtf(sq + 1e-6f) * 0.08838834764831845f, rk = rsqrtf(sk + 1e-6f);
#pragma unroll
    for (int e = 0; e < 16; ++e) { qkv[0][e] *= rq; qkv[1][e] *= rk; }
  }
  if (tid < 64) {
    float sc_ = sg[tid];
#pragma unroll
    for (int o = 1; o < 64; o <<= 1) { float t = __shfl_up(sc_, o); if (lane >= o) sc_ += t; }
    sgc[tid] = sc_;
    if (tid == 63) EGL[item] = __expf(sc_);
  }
  __syncthreads();
  {
    const float gci = sgc[i], gl = sgc[63], bi = sbeta[i];
    const float eg = __expf(gci), ekd = __expf(gl - gci);
    bf16x8 a0, a1, b0, b1, c0, c1, d0, d1;
#pragma unroll
    for (int e = 0; e < 8; ++e) {
      a0[e] = (short)f2bf(qkv[0][e]); a1[e] = (short)f2bf(qkv[0][8 + e]);
      b0[e] = (short)f2bf(qkv[1][e]); b1[e] = (short)f2bf(qkv[1][8 + e]);
      c0[e] = (short)f2bf(qkv[0][e] * eg); c1[e] = (short)f2bf(qkv[0][8 + e] * eg);
      d0[e] = (short)f2bf(qkv[1][e] * ekd); d1[e] = (short)f2bf(qkv[1][8 + e] * ekd);
    }
    *(bf16x8*)(Qb + i * 136 + cgp * 16) = a0; *(bf16x8*)(Qb + i * 136 + cgp * 16 + 8) = a1;
    *(bf16x8*)(Kb + i * 136 + cgp * 16) = b0; *(bf16x8*)(Kb + i * 136 + cgp * 16 + 8) = b1;
    u16* gq = PROJ + (size_t)(t0 + i) * NPJ + C_GQ + h * 128 + cgp * 16;
    u16* gk = PROJ + (size_t)(t0 + i) * NPJ + C_GK + h * 128 + cgp * 16;
    *(bf16x8*)gq = c0; *(bf16x8*)(gq + 8) = c1;
    *(bf16x8*)gk = d0; *(bf16x8*)(gk + 8) = d1;
#pragma unroll
    for (int e = 0; e < 16; ++e) {
      vbT[(cgp * 16 + e) * 72 + i] = f2bf(qkv[2][e] * bi);
      kbT[(cgp * 16 + e) * 72 + i] = f2bf(qkv[1][e] * bi * eg);
    }
  }
  __syncthreads();
#pragma unroll 1
  for (int jj = 0; jj < 2; ++jj) {
    const int tile = w * 2 + jj, ti = tile >> 2, tj = tile & 3;
    f32x4 acc = {0.f, 0.f, 0.f, 0.f};
    if (tj <= ti) {
#pragma unroll
      for (int ks = 0; ks < 4; ++ks)
        acc = mfma16(ld8(Kb + (ti * 16 + lr) * 136 + ks * 32 + lq * 8), ld8(Kb + (tj * 16 + lr) * 136 + ks * 32 + lq * 8), acc);
    }
    const int j = tj * 16 + lr;
#pragma unroll
    for (int r = 0; r < 4; ++r) {
      const int ir = ti * 16 + lq * 4 + r;
      As[ir * 65 + j] = (j < ir) ? sbeta[ir] * acc[r] * __expf(sgc[ir] - sgc[j]) : 0.f;
    }
  }
  __syncthreads();
  if (w != 0) {
#pragma unroll 1
    for (int tile = w - 1; tile < 16; tile += 7) {
      const int ti = tile >> 2, tj = tile & 3;
      f32x4 acc = {0.f, 0.f, 0.f, 0.f};
      if (tj <= ti) {
#pragma unroll
        for (int ks = 0; ks < 4; ++ks)
          acc = mfma16(ld8(Qb + (ti * 16 + lr) * 136 + ks * 32 + lq * 8), ld8(Kb + (tj * 16 + lr) * 136 + ks * 32 + lq * 8), acc);
      }
      const int j = tj * 16 + lr;
#pragma unroll
      for (int r = 0; r < 4; ++r) {
        const int ir = ti * 16 + lq * 4 + r;
        const float dec = (j <= ir) ? __expf(sgc[ir] - sgc[j]) : 0.f;
        ATT[(size_t)item * 4096 + ir * 64 + j] = f2bf(acc[r] * dec);
      }
    }
  }
  if (w == 0) {
    float Ar[64], Tc[64];
#pragma unroll
    for (int ir = 0; ir < 64; ++ir) Ar[ir] = As[ir * 65 + lane];
#pragma unroll
    for (int ir = 0; ir < 64; ++ir) {
      float sacc = (ir == lane) ? 1.f : 0.f;
#pragma unroll
      for (int j = 0; j < ir; ++j) sacc -= __uint_as_float(__builtin_amdgcn_readlane(__float_as_uint(Ar[ir]), j)) * Tc[j];
      Tc[ir] = sacc;
    }
#pragma unroll
    for (int ir = 0; ir < 64; ++ir) Tb[ir * 72 + lane] = f2bf(Tc[ir]);
  }
  __syncthreads();
#pragma unroll 1
  for (int jj = 0; jj < 8; ++jj) {
    const int job = w * 8 + jj, which = job >> 5, tile = job & 31, ti = tile >> 3, tn = tile & 7;
    const u16* BT = which ? kbT : vbT;
    f32x4 acc = {0.f, 0.f, 0.f, 0.f};
#pragma unroll
    for (int ks = 0; ks < 2; ++ks)
      acc = mfma16(ld8(Tb + (ti * 16 + lr) * 72 + ks * 32 + lq * 8), ld8(BT + (tn * 16 + lr) * 72 + ks * 32 + lq * 8), acc);
    const int d = tn * 16 + lr;
#pragma unroll
    for (int r = 0; r < 4; ++r) {
      const int ir = ti * 16 + lq * 4 + r;
      if (which == 0) PROJ[(size_t)(t0 + ir) * NPJ + C_GV + h * 128 + d] = f2bf(acc[r]);
      else WG[(size_t)(t0 + ir) * 512 + h * 128 + d] = f2bf(acc[r]);
    }
  }
  __syncthreads();
}

static __device__ __attribute__((always_inline)) inline void gdn_scan(const Params& p, int l, int bh) {
  char* ws = lsp(p.ws);
  u16* PROJ = (u16*)(ws + OFF_PROJ);
  const u16* WG = (const u16*)(ws + OFF_SCR); const u16* ATT = (const u16*)(ws + OFF_SCR + 16777216);
  const float* EGL = (const float*)(ws + OFF_EGL);
  u16* St = (u16*)lds_base();
  u16* Wl = St + 128 * 136;
  u16* Ql = Wl + 64 * 136;
  u16* KdT = Ql + 64 * 136;
  u16* VnT = KdT + 128 * 72;
  u16* At = VnT + 128 * 72;
  float* red = (float*)(At + 64 * 72);
  float* egls = red + 128;
  const int tid = lv(threadIdx.x), lane = tid & 63, w = tid >> 6, lr = lane & 15, lq = lane >> 4;
  const int b = bh >> 2, h = bh & 3;
  const float* ng = p.norm_g + l * 128;
  f32x4 S[8];
#pragma unroll
  for (int v = 0; v < 8; ++v) S[v] = f32x4{0.f, 0.f, 0.f, 0.f};
  for (int idx = tid; idx < 128 * 136; idx += 512) St[idx] = 0;
  const int it = w >> 1, vb = (w & 1) * 4;
  float ngv[4];
#pragma unroll
  for (int n = 0; n < 4; ++n) ngv[n] = ng[(vb + n) * 16 + lr];
  const int r0 = tid >> 4, seg0 = tid & 15;
  const int ra = tid >> 3, sega = tid & 7;
  bf16x8 pw[2], pq[2], pk[2], pa;
  u16 un[16];
  {
    const int t0 = b * SEQL;
#pragma unroll
    for (int rep = 0; rep < 2; ++rep) {
      const int r = r0 + rep * 32;
      pw[rep] = ld8(WG + (size_t)(t0 + r) * 512 + h * 128 + seg0 * 8);
      pq[rep] = ld8(PROJ + (size_t)(t0 + r) * NPJ + C_GQ + h * 128 + seg0 * 8);
      pk[rep] = ld8(PROJ + (size_t)(t0 + r) * NPJ + C_GK + h * 128 + seg0 * 8);
    }
    pa = ld8(ATT + (size_t)(bh * 32) * 4096 + ra * 64 + sega * 8);
#pragma unroll
    for (int n = 0; n < 4; ++n)
#pragma unroll
      for (int r = 0; r < 4; ++r)
        un[n * 4 + r] = PROJ[(size_t)(t0 + it * 16 + lq * 4 + r) * NPJ + C_GV + h * 128 + (vb + n) * 16 + lr];
    if (tid < 32) egls[tid] = EGL[bh * 32 + tid];
  }
#pragma unroll 1
  for (int c = 0; c < 32; ++c) {
    const int t0 = b * SEQL + c * 64;
#pragma unroll
    for (int rep = 0; rep < 2; ++rep) {
      const int r = r0 + rep * 32;
      *(bf16x8*)(Wl + r * 136 + seg0 * 8) = pw[rep];
      *(bf16x8*)(Ql + r * 136 + seg0 * 8) = pq[rep];
#pragma unroll
      for (int e = 0; e < 8; ++e) KdT[(seg0 * 8 + e) * 72 + r] = (u16)pk[rep][e];
    }
    *(bf16x8*)(At + ra * 72 + sega * 8) = pa;
    u16 uc[16], zc[16];
#pragma unroll
    for (int q = 0; q < 16; ++q) uc[q] = un[q];
#pragma unroll
    for (int n = 0; n < 4; ++n)
#pragma unroll
      for (int r = 0; r < 4; ++r)
        zc[n * 4 + r] = PROJ[(size_t)(t0 + it * 16 + lq * 4 + r) * NPJ + C_GZ + h * 128 + (vb + n) * 16 + lr];
    lds_barrier();
    if (c + 1 < 32) {
      const int t1 = t0 + 64;
#pragma unroll
      for (int rep = 0; rep < 2; ++rep) {
        const int r = r0 + rep * 32;
        pw[rep] = ld8(WG + (size_t)(t1 + r) * 512 + h * 128 + seg0 * 8);
        pq[rep] = ld8(PROJ + (size_t)(t1 + r) * NPJ + C_GQ + h * 128 + seg0 * 8);
        pk[rep] = ld8(PROJ + (size_t)(t1 + r) * NPJ + C_GK + h * 128 + seg0 * 8);
      }
      pa = ld8(ATT + (size_t)(bh * 32 + c + 1) * 4096 + ra * 64 + sega * 8);
#pragma unroll
      for (int n = 0; n < 4; ++n)
#pragma unroll
        for (int r = 0; r < 4; ++r)
          un[n * 4 + r] = PROJ[(size_t)(t1 + it * 16 + lq * 4 + r) * NPJ + C_GV + h * 128 + (vb + n) * 16 + lr];
    }
    f32x4 vacc[4], oacc[4];
#pragma unroll
    for (int n = 0; n < 4; ++n) { vacc[n] = f32x4{0.f, 0.f, 0.f, 0.f}; oacc[n] = f32x4{0.f, 0.f, 0.f, 0.f}; }
#pragma unroll
    for (int kh = 0; kh < 2; ++kh) {
      bf16x8 fw[2], fq_[2], fb[2][4];
#pragma unroll
      for (int k2 = 0; k2 < 2; ++k2) {
        const int ks = kh * 2 + k2;
        fw[k2] = ld8(Wl + (it * 16 + lr) * 136 + ks * 32 + lq * 8);
        fq_[k2] = ld8(Ql + (it * 16 + lr) * 136 + ks * 32 + lq * 8);
#pragma unroll
        for (int n = 0; n < 4; ++n) fb[k2][n] = ld8(St + ((vb + n) * 16 + lr) * 136 + ks * 32 + lq * 8);
      }
      __builtin_amdgcn_sched_barrier(0);
#pragma unroll
      for (int k2 = 0; k2 < 2; ++k2)
#pragma unroll
        for (int n = 0; n < 4; ++n) {
          vacc[n] = mfma16(fw[k2], fb[k2][n], vacc[n]);
          oacc[n] = mfma16(fq_[k2], fb[k2][n], oacc[n]);
        }
      __builtin_amdgcn_sched_barrier(0);
    }
#pragma unroll
    for (int n = 0; n < 4; ++n) {
      const int v = (vb + n) * 16 + lr;
      *(s16x4*)(VnT + v * 72 + it * 16 + lq * 4) =
          pack4(bf2f(uc[n * 4 + 0]) - vacc[n][0], bf2f(uc[n * 4 + 1]) - vacc[n][1], bf2f(uc[n * 4 + 2]) - vacc[n][2], bf2f(uc[n * 4 + 3]) - vacc[n][3]);
    }
    lds_barrier();
#pragma unroll
    for (int ks = 0; ks < 2; ++ks) {
      bf16x8 aa = ld8(At + (it * 16 + lr) * 72 + ks * 32 + lq * 8);
#pragma unroll
      for (int n = 0; n < 4; ++n)
        oacc[n] = mfma16(aa, ld8(VnT + ((vb + n) * 16 + lr) * 72 + ks * 32 + lq * 8), oacc[n]);
    }
    {
      bf16x8 ak0 = ld8(KdT + (w * 16 + lr) * 72 + lq * 8), ak1 = ld8(KdT + (w * 16 + lr) * 72 + 32 + lq * 8);
#pragma unroll
      for (int vt = 0; vt < 8; ++vt) {
        f32x4 a = S[vt] * egls[c];
        a = mfma16(ak0, ld8(VnT + (vt * 16 + lr) * 72 + lq * 8), a);
        a = mfma16(ak1, ld8(VnT + (vt * 16 + lr) * 72 + 32 + lq * 8), a);
        S[vt] = a;
        *(s16x4*)(St + (vt * 16 + lr) * 136 + w * 16 + lq * 4) = pack4(a[0], a[1], a[2], a[3]);
      }
    }
    {
      float ssr[4];
#pragma unroll
      for (int r = 0; r < 4; ++r) {
        float sq = 0.f;
#pragma unroll
        for (int n = 0; n < 4; ++n) sq += oacc[n][r] * oacc[n][r];
        sq += __shfl_xor(sq, 1); sq += __shfl_xor(sq, 2); sq += __shfl_xor(sq, 4); sq += __shfl_xor(sq, 8);
        ssr[r] = sq;
      }
      if (lr == 0) {
#pragma unroll
        for (int r = 0; r < 4; ++r) red[(it * 16 + lq * 4 + r) * 2 + (w & 1)] = ssr[r];
      }
    }
    lds_barrier();
#pragma unroll
    for (int r = 0; r < 4; ++r) {
      const int ir = it * 16 + lq * 4 + r;
      const float rs = rsqrtf((red[ir * 2] + red[ir * 2 + 1]) * (1.f / 128.f) + 1e-6f);
#pragma unroll
      for (int n = 0; n < 4; ++n) {
        const int v = (vb + n) * 16 + lr;
        const float z = bf2f(zc[n * 4 + r]);
        const float y = oacc[n][r] * rs * ngv[n] * z * __builtin_amdgcn_rcpf(1.f + __expf(-z));
        PROJ[(size_t)(t0 + ir) * NPJ + C_GV + h * 128 + v] = f2bf(y);
      }
    }
  }
  __syncthreads();
}


static __device__ __attribute__((always_inline)) inline void nsa_attn(const Params& p, int item) {
  char* ws = lsp(p.ws);
  u16* PROJ = (u16*)(ws + OFF_PROJ);
  const u16* KC = (const u16*)(ws + OFF_KC); const u16* VCT = (const u16*)(ws + OFF_VCT);
  u16* Ks = (u16*)lds_base();
  float* impw = (float*)(Ks + 4 * 64 * 72);
  unsigned* selm = (unsigned*)(impw + 4 * 64 * 32);
  unsigned* uni = selm + 64;
  const int tid = lv(threadIdx.x), lane = tid & 63, w = tid >> 6;
  const int hh = w & 3, qhalf = w >> 2, lq5 = lane & 31, hf = lane >> 5;
  const int qb = 31 - (item >> 4), bg = item & 15, b = bg >> 1, g = bg & 1;
  const int ql = qhalf * 32 + lq5, tpos = qb * 64 + ql;
  const size_t row = (size_t)b * SEQL + tpos;
  const int head = g * 4 + hh;
  bf16x8 qf[4];
#pragma unroll
  for (int s = 0; s < 4; ++s) {
    bf16x8 raw = ld8(PROJ + row * NPJ + C_NQ + head * 64 + 16 * s + 8 * hf);
#pragma unroll
    for (int e = 0; e < 8; ++e) raw[e] = (short)f2bf(bfs(raw[e]) * 0.125f);
    qf[s] = raw;
  }
  if (tid == 0) *uni = 0u;
  float gate[3];
#pragma unroll
  for (int i = 0; i < 3; ++i) gate[i] = sigmoidf_(bf2f(PROJ[row * NPJ + C_NG + head * 3 + i]));
  f32x16 ofin[2];
  {
    f32x16 sc[4];
    const u16* kcb = KC + (size_t)(b * 2 + g) * 128 * 64;
#pragma unroll
    for (int mt = 0; mt < 4; ++mt) {
#pragma unroll
      for (int i = 0; i < 16; ++i) sc[mt][i] = 0.f;
#pragma unroll
      for (int s = 0; s < 4; ++s) sc[mt] = mfma32(ld8(kcb + (32 * mt + lq5) * 64 + 16 * s + 8 * hf), qf[s], sc[mt]);
    }
    const int nlim = (tpos >= 31) ? min(126, (tpos - 31) >> 4) : -1;
    float mx = -1e30f;
#pragma unroll
    for (int mt = 0; mt < 4; ++mt)
#pragma unroll
      for (int i = 0; i < 16; ++i) { int n = 32 * mt + crow(i, hf); if (n <= nlim) mx = fmaxf(mx, sc[mt][i]); }
    mx = fmaxf(mx, __shfl_xor(mx, 32));
    float ls = 0.f;
#pragma unroll
    for (int mt = 0; mt < 4; ++mt)
#pragma unroll
      for (int i = 0; i < 16; ++i) {
        int n = 32 * mt + crow(i, hf);
        float pv = (n <= nlim) ? __expf(sc[mt][i] - mx) : 0.f;
        sc[mt][i] = pv; ls += pv;
      }
    ls += __shfl_xor(ls, 32);
    const float inv = ls > 0.f ? 1.f / ls : 0.f;
#pragma unroll
    for (int mt = 0; mt < 4; ++mt)
#pragma unroll
      for (int i = 0; i < 16; ++i) sc[mt][i] *= inv;
    f32x16 oc[2];
#pragma unroll
    for (int i = 0; i < 16; ++i) { oc[0][i] = 0.f; oc[1][i] = 0.f; }
    const u16* vcb = VCT + (size_t)(b * 2 + g) * 64 * 128;
#pragma unroll
    for (int mt = 0; mt < 4; ++mt)
#pragma unroll
      for (int s = 0; s < 2; ++s) {
        bf16x8 pf = pack8(sc[mt], s);
#pragma unroll
        for (int dt = 0; dt < 2; ++dt) {
          const u16* vp = vcb + (32 * dt + lq5) * 128 + 32 * mt + 16 * s + 4 * hf;
          s16x4 lo = ld4(vp), hi = ld4(vp + 8);
          bf16x8 vf = __builtin_shufflevector(lo, hi, 0, 1, 2, 3, 4, 5, 6, 7);
          oc[dt] = mfma32(vf, pf, oc[dt]);
        }
      }
#pragma unroll
    for (int i = 0; i < 16; ++i) { ofin[0][i] = gate[0] * oc[0][i]; ofin[1][i] = gate[0] * oc[1][i]; }
    float G[4][4], rl[4][4];
#pragma unroll
    for (int mt = 0; mt < 4; ++mt)
#pragma unroll
      for (int gi = 0; gi < 4; ++gi) {
        G[mt][gi] = sc[mt][4 * gi] + sc[mt][4 * gi + 1] + sc[mt][4 * gi + 2] + sc[mt][4 * gi + 3];
        rl[mt][gi] = __shfl_xor(sc[mt][4 * gi + 3], 32);
      }
#pragma unroll
    for (int mt = 0; mt < 4; ++mt)
#pragma unroll
      for (int gi = 0; gi < 4; ++gi) {
        float prev;
        if (hf == 1) prev = rl[mt][gi];
        else prev = (gi > 0) ? rl[mt][gi > 0 ? gi - 1 : 0] : (mt > 0 ? rl[mt > 0 ? mt - 1 : 0][3] : 0.f);
        impw[(hh * 64 + ql) * 32 + 8 * mt + 2 * gi + hf] = G[mt][gi] + prev;
      }
  }
  __syncthreads();
  if (tid < 64) {
    float scv[32];
#pragma unroll
    for (int j = 0; j < 32; ++j) {
      float v = impw[(0 * 64 + tid) * 32 + j] + impw[(1 * 64 + tid) * 32 + j] + impw[(2 * 64 + tid) * 32 + j] + impw[(3 * 64 + tid) * 32 + j];
      if (j == 0 || j == qb || j == qb - 1) v += 1000.f;
      scv[j] = (j <= qb) ? v : -1e30f;
    }
    unsigned m = 0u;
#pragma unroll 1
    for (int k = 0; k < 8; ++k) {
      float bv = -1e29f; int best = -1;
#pragma unroll
      for (int j = 0; j < 32; ++j) { bool take = !((m >> j) & 1u) && scv[j] > bv; bv = take ? scv[j] : bv; best = take ? j : best; }
      if (best >= 0) m |= 1u << best;
    }
    selm[tid] = m;
    atomicOr(uni, m);
  }
  __syncthreads();
  const unsigned U = *uni;
  const unsigned sm = selm[ql];
#pragma unroll 1
  for (int mode = 0; mode < 2; ++mode) {
    float mrun = -1e30f, lrun = 0.f;
    f32x16 oacc[2];
#pragma unroll
    for (int i = 0; i < 16; ++i) { oacc[0][i] = 0.f; oacc[1][i] = 0.f; }
    const unsigned tmask = mode ? ((2u << qb) - 1u) & ~((1u << max(0, qb - 8)) - 1u) : U;
    const int r_ld = 32 * (w & 1) + (lane & 31), seg_ld = (w >> 1) * 2 + (lane >> 5);
    const int kcol = C_NKV + (mode ? 4 : 2) * 128 + g * 64 + seg_ld * 8;
    unsigned rem = tmask;
    int j = __ffs(rem) - 1;
    rem &= rem - 1u;
    bf16x8 kreg = ld8(PROJ + ((size_t)b * SEQL + 64 * j + r_ld) * NPJ + kcol);
    bf16x8 vreg = ld8(PROJ + ((size_t)b * SEQL + 64 * j + r_ld) * NPJ + kcol + 128);
    int buf = 0;
#pragma unroll 1
    while (j >= 0) {
      u16* Kb_ = Ks + buf * (2 * 64 * 72);
      u16* Vb_ = Kb_ + 64 * 72;
      *(bf16x8*)(Kb_ + r_ld * 72 + seg_ld * 8) = kreg;
#pragma unroll
      for (int e = 0; e < 8; ++e) Vb_[(seg_ld * 8 + e) * 72 + r_ld] = (u16)vreg[e];
      __syncthreads();
      const int jn = rem ? (__ffs(rem) - 1) : -1;
      rem &= rem - 1u;
      if (jn >= 0) {
        kreg = ld8(PROJ + ((size_t)b * SEQL + 64 * jn + r_ld) * NPJ + kcol);
        vreg = ld8(PROJ + ((size_t)b * SEQL + 64 * jn + r_ld) * NPJ + kcol + 128);
      }
      const bool selj = mode ? true : (((sm >> j) & 1u) != 0u);
      if (mode || __any(selj)) {
        f32x16 st[2];
#pragma unroll
        for (int mt = 0; mt < 2; ++mt) {
#pragma unroll
          for (int i = 0; i < 16; ++i) st[mt][i] = 0.f;
#pragma unroll
          for (int s = 0; s < 4; ++s) st[mt] = mfma32(ld8(Kb_ + (32 * mt + lq5) * 72 + 16 * s + 8 * hf), qf[s], st[mt]);
        }
        const bool need_mask = (j == qb) || (mode && j == qb - 8);
        float mloc = -1e30f;
        if (need_mask) {
#pragma unroll
          for (int mt = 0; mt < 2; ++mt)
#pragma unroll
            for (int i = 0; i < 16; ++i) {
              const int dist = tpos - (64 * j + 32 * mt + crow(i, hf));
              const bool ok = selj && dist >= 0 && dist < 512;
              st[mt][i] = ok ? st[mt][i] : -1e30f;
              mloc = fmaxf(mloc, st[mt][i]);
            }
        } else {
#pragma unroll
          for (int mt = 0; mt < 2; ++mt)
#pragma unroll
            for (int i = 0; i < 16; ++i) mloc = fmaxf(mloc, st[mt][i]);
          mloc = selj ? mloc : -1e30f;
        }
        mloc = fmaxf(mloc, __shfl_xor(mloc, 32));
        const float mnew = fmaxf(mrun, mloc);
        const float alpha = __expf(mrun - mnew);
        const bool live = selj && (mnew > -1e29f);
        float psum = 0.f;
#pragma unroll
        for (int mt = 0; mt < 2; ++mt)
#pragma unroll
          for (int i = 0; i < 16; ++i) {
            float pv = __expf(st[mt][i] - mnew);
            pv = live ? pv : 0.f;
            st[mt][i] = pv; psum += pv;
          }
        lrun = lrun * alpha + psum;
        mrun = mnew;
#pragma unroll
        for (int i = 0; i < 16; ++i) { oacc[0][i] *= alpha; oacc[1][i] *= alpha; }
#pragma unroll
        for (int mt = 0; mt < 2; ++mt)
#pragma unroll
          for (int s = 0; s < 2; ++s) {
            bf16x8 pf = pack8(st[mt], s);
#pragma unroll
            for (int dt = 0; dt < 2; ++dt) {
              const u16* vp = Vb_ + (32 * dt + lq5) * 72 + 32 * mt + 16 * s + 4 * hf;
              s16x4 lo = ld4(vp), hi = ld4(vp + 8);
              bf16x8 vf = __builtin_shufflevector(lo, hi, 0, 1, 2, 3, 4, 5, 6, 7);
              oacc[dt] = mfma32(vf, pf, oacc[dt]);
            }
          }
      }
      buf ^= 1;
      j = jn;
    }
    const float ltot = lrun + __shfl_xor(lrun, 32);
    const float sc_ = (ltot > 0.f) ? gate[1 + mode] / ltot : 0.f;
#pragma unroll
    for (int i = 0; i < 16; ++i) { ofin[0][i] += sc_ * oacc[0][i]; ofin[1][i] += sc_ * oacc[1][i]; }
    __syncthreads();
  }
#pragma unroll
  for (int dt = 0; dt < 2; ++dt)
#pragma unroll
    for (int g4 = 0; g4 < 4; ++g4)
      *(s16x4*)(PROJ + row * NPJ + C_NQ + head * 64 + 32 * dt + 8 * g4 + 4 * hf) =
          pack4(ofin[dt][4 * g4], ofin[dt][4 * g4 + 1], ofin[dt][4 * g4 + 2], ofin[dt][4 * g4 + 3]);
  __syncthreads();
}

static __device__ __attribute__((always_inline)) inline void phase_merge(const Params& p) {
  char* ws = lsp(p.ws);
  u16* H = (u16*)(ws + OFF_H); u16* WinT = (u16*)(ws + OFF_WBIG); u16* PROJ = (u16*)(ws + OFF_PROJ);
  u16* WbrT = (u16*)(ws + OFF_WBR); u16* M = (u16*)(ws + OFF_SCR);
  const int nM = 64, nN = 4;
  for (int t = blockIdx.x; t < nM * nN; t += gridDim.x) {
    int pm, pn; tile_map(t, nM, nN, pm, pn);
#pragma unroll 1
    for (int i = 0; i < 3; ++i) {
      const int boff = 5120 + i * 1024 + pn * 256;
      gemm_tile(H, 1024, WinT, 1024, 1024, pm * 256, boff, [&](int idx, int row, int col, f32x4 v) {
        *(s16x4*)(PROJ + (size_t)row * NPJ + C_SK + (col - 5120 - i * 1024)) = pack4(sigmoidf_(v[0]), sigmoidf_(v[1]), sigmoidf_(v[2]), sigmoidf_(v[3]));
      });
      const int ycol = (i == 0) ? C_GV : (i == 1 ? C_NQ : C_SQ);
      s16x4 gbuf[2], mbuf[2];
      gemm_tile(PROJ + ycol, NPJ, WbrT + (size_t)i * 1024 * 512, 512, 512, pm * 256, pn * 256, [&](int idx, int row, int col, f32x4 v) {
        const s16x4 gte = gbuf[idx];
        float o0 = bfs(gte[0]) * v[0], o1 = bfs(gte[1]) * v[1], o2 = bfs(gte[2]) * v[2], o3 = bfs(gte[3]) * v[3];
        if (i > 0) { const s16x4 pv = mbuf[idx]; o0 += bfs(pv[0]); o1 += bfs(pv[1]); o2 += bfs(pv[2]); o3 += bfs(pv[3]); }
        *(s16x4*)(M + (unsigned)(row * 1024 + col)) = pack4(o0, o1, o2, o3);
      }, [&](int idx, int row, int col) {
        gbuf[idx] = ld4(PROJ + (unsigned)(row * NPJ + C_SK + col));
        if (i > 0) mbuf[idx] = ld4(M + (unsigned)(row * 1024 + col));
      });
    }
  }
}

template <int MODE>
static __device__ __attribute__((always_inline)) inline void phase_gemm(const u16* A, int lda, const u16* Bt, int ldb, int K, int nM, int nN, u16* C, int ldc) {
  for (int t = blockIdx.x; t < nM * nN; t += gridDim.x) {
    int pm, pn; tile_map(t, nM, nN, pm, pn);
    gemm_tile(A, lda, Bt, ldb, K, pm * 256, pn * 256, [&](int idx, int row, int col, f32x4 v) {
      if (MODE == 1) {
#pragma unroll
        for (int q = 0; q < 4; ++q) { float t = fmaxf(v[q], 0.f); v[q] = t * t; }
      }
      *(s16x4*)(C + (size_t)row * ldc + col) = pack4(v[0], v[1], v[2], v[3]);
    });
  }
}


#define XB_TMO      128
#define XB_XCNT(j)  (256  + 64 * (j))
#define XB_XSUB(j)  (1280 + 64 * (j))
#define XB_XGEN(j)  (2304 + 64 * (j))
#define XB_TOP      3328
#define XB_TOPGEN   3392
#define XCD_BAR_WORDS 3456
#define XB_SPIN_CAP (1u << 18)
#define LAS __attribute__((address_space(3)))
DI unsigned xb_ld(unsigned* q)              { return __hip_atomic_load(q, __ATOMIC_RELAXED, __HIP_MEMORY_SCOPE_AGENT); }
DI unsigned xb_add(unsigned* q, unsigned v) { return __hip_atomic_fetch_add(q, v, __ATOMIC_RELAXED, __HIP_MEMORY_SCOPE_AGENT); }
DI unsigned xb_xcc_id() { return (unsigned)__builtin_amdgcn_s_getreg((3 << 11) | 20) & 0xFu; }
#define XB_SPIN(cond, bar) do { unsigned _sp = 0; while (cond) { __builtin_amdgcn_s_sleep(1); \
    if ((++_sp & 255u) == 0u) { if (xb_ld(&(bar)[XB_TMO])) break; if (_sp > XB_SPIN_CAP) { atomicAdd(&(bar)[XB_TMO], 1u); break; } } } } while (0)
struct XcdBarrier { unsigned* bar; unsigned x; volatile LAS unsigned* st; };
DI XcdBarrier xcd_barrier_post(unsigned* bar, volatile LAS unsigned* st) {
  XcdBarrier b; b.bar = bar; b.x = xb_xcc_id(); b.st = st;
  if (threadIdx.x == 0) (void)xb_add(&bar[XB_XCNT(b.x)], 1u);
  return b;
}
DI void xcd_barrier_complete(unsigned* bar, unsigned x, unsigned& nloc, unsigned& nx) {
  const unsigned G = gridDim.x * gridDim.y * gridDim.z;
  unsigned sum, cnt, mine, sp = 0u;
  for (;;) {
    sum = 0u; cnt = 0u; mine = 0u;
#pragma unroll
    for (unsigned j = 0; j < 16; ++j) { const unsigned c = xb_ld(&bar[XB_XCNT(j)]); sum += c; cnt += (c > 0u) ? 1u : 0u; mine = (j == x) ? c : mine; }
    if (sum == G) break;
    __builtin_amdgcn_s_sleep(1);
    if ((++sp & 255u) == 0u) { if (xb_ld(&bar[XB_TMO])) break; if (sp > XB_SPIN_CAP) { atomicAdd(&bar[XB_TMO], 1u); break; } }
  }
  nloc = mine > 0u ? mine : 1u; nx = cnt > 0u ? cnt : 1u;
}
DI void xcd_barrier(const XcdBarrier& b) {
  asm volatile("s_waitcnt vmcnt(0)" ::: "memory");
  __syncthreads();
  if (threadIdx.x == 0) {
    unsigned* bar = b.bar;
    __builtin_amdgcn_s_waitcnt(0);
    unsigned nloc = b.st[0], nx = b.st[1];
    if (nloc == 0u) { xcd_barrier_complete(bar, b.x, nloc, nx); b.st[0] = nloc; b.st[1] = nx; }
    const unsigned old = xb_add(&bar[XB_XSUB(b.x)], 1u);
    const unsigned gen = old / nloc;
    if (old + 1u == (gen + 1u) * nloc) {
      __builtin_amdgcn_fence(__ATOMIC_RELEASE, "agent");
      asm volatile("s_waitcnt vmcnt(0)" ::: "memory");
      const unsigned og = xb_add(&bar[XB_TOP], 1u);
      const unsigned tg = og / nx;
      if (og + 1u == (tg + 1u) * nx) xb_add(&bar[XB_TOPGEN], 1u);
      else XB_SPIN(xb_ld(&bar[XB_TOPGEN]) == tg, bar);
      __builtin_amdgcn_fence(__ATOMIC_ACQUIRE, "agent");
      xb_add(&bar[XB_XGEN(b.x)], 1u);
      asm volatile("s_waitcnt vmcnt(0)" ::: "memory");
    } else {
      XB_SPIN(xb_ld(&bar[XB_XGEN(b.x)]) == gen, bar);
      __builtin_amdgcn_fence(__ATOMIC_ACQUIRE, "agent");
      asm volatile("s_waitcnt vmcnt(0)" ::: "memory");
    }
  }
  __syncthreads();
}

__global__ void __launch_bounds__(512) fwd_megakernel(Params p_unused) {
#define p (kp())
  cg::grid_group grid = cg::this_grid();
  volatile LAS unsigned* xst = (volatile LAS unsigned*)((LAS char*)g_shm + LDS_XST);
  if (threadIdx.x == 0) { xst[0] = 0u; xst[1] = 0u; }
  __syncthreads();
  (void)xcd_barrier_post((unsigned*)(lsp(p.ws) + OFF_BAR), xst);
#define GSYNC() do { XcdBarrier xb_; xb_.bar = (unsigned*)(lsp(p.ws) + OFF_BAR); unsigned xx_ = xb_xcc_id(); asm volatile("" : "+s"(xx_)); xb_.x = xx_; \
    xb_.st = (volatile LAS unsigned*)((LAS char*)g_shm + LDS_XST); xcd_barrier(xb_); } while (0)
#define WSP(off) ((u16*)(lsp(p.ws) + (off)))
  phase_norm(p.x, nullptr, nullptr, p.g_mix_pre, nullptr, WSP(OFF_H));
  convert_mixer_weights(p, 0);
  if (p.ws == nullptr) grid.sync();
  GSYNC();
#pragma unroll 1
  for (int l = 0; l < 2; ++l) {
    phase_inproj(p);
    GSYNC();
    {
      volatile LAS int* qslot = (volatile LAS int*)((LAS char*)g_shm + LDS_XST + 16);
#pragma unroll 1
      for (;;) {
        if (threadIdx.x == 0) *qslot = (int)atomicAdd((unsigned*)(lsp(p.ws) + OFF_QCTR) + l * 64 + 32, 1u);
        __syncthreads();
        const int it = *qslot;
        __syncthreads();
        if (it >= 1152) break;
        if (it < 128) nsa_compress(p, l, it);
        else gdn_prep(p, l, it - 128);
      }
    }
    GSYNC();
    if (blockIdx.x < 32) gdn_scan(p, l, blockIdx.x);
    {
      volatile LAS int* qslot = (volatile LAS int*)((LAS char*)g_shm + LDS_XST + 16);
#pragma unroll 1
      for (;;) {
        if (threadIdx.x == 0) *qslot = (int)atomicAdd((unsigned*)(lsp(p.ws) + OFF_QCTR) + l * 64, 1u);
        __syncthreads();
        const int it = *qslot;
        __syncthreads();
        if (it >= 768) break;
        if (it < 192) nsa_attn(p, it);
        else if (it < 448) { sb_attn_wave(p, (it - 192) * 8 + (lv(threadIdx.x) >> 6)); __syncthreads(); }
        else nsa_attn(p, it - 256);
      }
    }
    GSYNC();
    phase_merge(p);
    GSYNC();
    phase_gemm<0>(WSP(OFF_SCR), 1024, WSP(OFF_WOUT), 1024, 1024, 64, 4, WSP(OFF_H), 1024);
    GSYNC();
    phase_norm(l == 0 ? p.x : p.out, WSP(OFF_H), p.g_mix_post + l * 1024, p.g_ff_pre + l * 1024, p.out, WSP(OFF_H));
    convert_ffn_weights(p, l);
    GSYNC();
    phase_gemm<1>(WSP(OFF_H), 1024, WSP(OFF_WBIG), 1024, 1024, 64, 16, WSP(OFF_PROJ), 4096);
    GSYNC();
    phase_gemm<0>(WSP(OFF_PROJ), 4096, WSP(OFF_WBIG) + (size_t)4096 * 1024, 4096, 4096, 64, 4, WSP(OFF_SCR), 1024);
    GSYNC();
    phase_norm(p.out, WSP(OFF_SCR), p.g_ff_post + l * 1024, (l == 0) ? p.g_mix_pre + 1024 : nullptr, p.out, WSP(OFF_H));
    if (l == 0) { convert_mixer_weights(p, 1); GSYNC(); }
  }
}
#undef p

extern "C" void kernel_launch(void* const* d_in, const int* in_sizes, int n_in, void* d_out, int out_size, void* d_ws,
                              size_t ws_size, hipStream_t stream) {
  static int grid_blocks = 0;
  if (!grid_blocks) {
    int dev = 0, cus = 0, per_cu = 0;
    (void)hipGetDevice(&dev);
    (void)hipDeviceGetAttribute(&cus, hipDeviceAttributeMultiprocessorCount, dev);
    (void)hipFuncSetAttribute((const void*)fwd_megakernel, hipFuncAttributeMaxDynamicSharedMemorySize, LDS_BYTES);
    (void)hipOccupancyMaxActiveBlocksPerMultiprocessor(&per_cu, (const void*)fwd_megakernel, 512, LDS_BYTES);
    if (per_cu < 1) per_cu = 1;
    grid_blocks = cus * 1;
    if (ws_size < WS_NEED) fprintf(stderr, "workspace too small: %zu < %zu\n", ws_size, (size_t)WS_NEED);
  }
  Params p{};
  p.x = (const float*)d_in[0]; p.g_mix_pre = (const float*)d_in[1]; p.g_mix_post = (const float*)d_in[2];
  p.g_ff_pre = (const float*)d_in[3]; p.g_ff_post = (const float*)d_in[4]; p.w_in = (const float*)d_in[5];
  p.conv_w = (const float*)d_in[6]; p.a_log = (const float*)d_in[7]; p.dt_bias = (const float*)d_in[8];
  p.norm_g = (const float*)d_in[9]; p.cmp_wk = (const float*)d_in[10]; p.cmp_pk = (const float*)d_in[11];
  p.cmp_wv = (const float*)d_in[12]; p.cmp_pv = (const float*)d_in[13]; p.w_br0 = (const float*)d_in[14];
  p.w_br1 = (const float*)d_in[15]; p.w_br2 = (const float*)d_in[16]; p.w_out = (const float*)d_in[17];
  p.w_ff1 = (const float*)d_in[18]; p.w_ff2 = (const float*)d_in[19];
  p.out = (float*)d_out; p.ws = (char*)d_ws;
  (void)hipMemsetAsync((char*)d_ws + OFF_BAR, 0, 16384, stream);
  void* args[] = {&p};
  hipError_t e = hipLaunchCooperativeKernel((const void*)fwd_megakernel, dim3(grid_blocks), dim3(512), args, LDS_BYTES, stream);
  if (e != hipSuccess) fprintf(stderr, "cooperative launch failed: %s (grid %d)\n", hipGetErrorString(e), grid_blocks);
}
```

```cpp
#include <hip/hip_runtime.h>
#include <hip/hip_bf16.h>
#include <hip/hip_cooperative_groups.h>
#include <cstdio>
namespace cg = cooperative_groups;

typedef unsigned short u16;
using bf16x8 = __attribute__((ext_vector_type(8))) short;
using s16x4  = __attribute__((ext_vector_type(4))) short;
using f32x4  = __attribute__((ext_vector_type(4))) float;
using f32x16 = __attribute__((ext_vector_type(16))) float;
#define DI __device__ __forceinline__

constexpr int T_TOK = 16384, SEQL = 2048;
constexpr int NPJ = 4896;
constexpr int N_IN = 7968;
constexpr int C_GQ = 0, C_GK = 512, C_GV = 1024, C_GZ = 1536, C_GA = 2048, C_GB = 2052, C_NQ = 2056, C_NKV = 2568,
              C_NG = 3336, C_SQ = 3360, C_SK = 3872;
constexpr size_t OFF_WBR  = 0;
constexpr size_t OFF_WOUT = 3145728;
constexpr size_t OFF_WBIG = 5242880;
constexpr size_t OFF_PROJ = 22020096;
constexpr size_t OFF_SCR  = OFF_PROJ + 160432128;
constexpr size_t OFF_H    = OFF_SCR + 33554432;
constexpr size_t OFF_HALO = OFF_H + 33554432;
constexpr size_t OFF_KC   = OFF_HALO + 2359296;
constexpr size_t OFF_VCT  = OFF_KC + 262144;
constexpr size_t OFF_EGL  = OFF_VCT + 262144;
constexpr size_t OFF_WT   = OFF_EGL + 4096;
constexpr size_t OFF_CB   = OFF_WT + 524288;
constexpr size_t OFF_BAR  = OFF_CB + 512;
constexpr size_t OFF_QCTR = OFF_BAR + 14336;
constexpr size_t WS_NEED  = OFF_BAR + 16384;
constexpr int LDS_XST = 155648;
constexpr int LDS_BYTES = LDS_XST + 32;

struct Params {
  const float* x; const float* g_mix_pre; const float* g_mix_post; const float* g_ff_pre; const float* g_ff_post;
  const float* w_in; const float* conv_w; const float* a_log; const float* dt_bias; const float* norm_g;
  const float* cmp_wk; const float* cmp_pk; const float* cmp_wv; const float* cmp_pv;
  const float* w_br0; const float* w_br1; const float* w_br2; const float* w_out; const float* w_ff1; const float* w_ff2;
  float* out; char* ws;
};

extern __shared__ __attribute__((aligned(16))) char g_shm[];

typedef __bf16 bf2_t __attribute__((ext_vector_type(2)));
typedef float f2_t __attribute__((ext_vector_type(2)));
typedef unsigned u32x2 __attribute__((ext_vector_type(2)));
typedef unsigned u32x4 __attribute__((ext_vector_type(4)));
DI unsigned cvt2(float a, float b) { f2_t v; v[0] = a; v[1] = b; return __builtin_bit_cast(unsigned, __builtin_convertvector(v, bf2_t)); }
DI u16 f2bf(float x) { return (u16)(cvt2(x, x) & 0xffffu); }
DI float bf2f(u16 b) { return __uint_as_float(((unsigned)b) << 16); }
DI float bfs(short b) { return __uint_as_float(((unsigned)(u16)b) << 16); }
DI bf16x8 ld8(const u16* p) { return *(const bf16x8*)p; }
DI s16x4 ld4(const u16* p) { return *(const s16x4*)p; }
DI f32x4 mfma16(bf16x8 a, bf16x8 b, f32x4 c) { return __builtin_amdgcn_mfma_f32_16x16x32_bf16(a, b, c, 0, 0, 0); }
DI f32x16 mfma32(bf16x8 a, bf16x8 b, f32x16 c) { return __builtin_amdgcn_mfma_f32_32x32x16_bf16(a, b, c, 0, 0, 0); }
DI s16x4 pack4(float a, float b, float c, float d) { u32x2 r; r[0] = cvt2(a, b); r[1] = cvt2(c, d); return __builtin_bit_cast(s16x4, r); }
DI float sigmoidf_(float x) { return 1.f / (1.f + __expf(-x)); }
DI float softplusf_(float x) { return fmaxf(x, 0.f) + log1pf(__expf(-fabsf(x))); }
DI int lv(int v) { asm volatile("" : "+v"(v)); return v; }
DI char* lsp(char* q) { auto g = (__attribute__((address_space(1))) char*)q; asm volatile("" : "+s"(g)); return (char*)g; }
typedef const __attribute__((address_space(4))) Params* kparg_t;
#if defined(__HIP_DEVICE_COMPILE__)
DI Params kp() { kparg_t q = (kparg_t)__builtin_amdgcn_kernarg_segment_ptr(); asm volatile("" : "+s"(q)); return *q; }
#else
DI Params kp() { return Params{}; }
#endif
DI char* lds_base() { auto q = (__attribute__((address_space(3))) char*)g_shm; asm volatile("" : "+v"(q)); return (char*)q; }
DI void lds_barrier() { asm volatile("s_waitcnt lgkmcnt(0)" ::: "memory"); __builtin_amdgcn_s_barrier(); asm volatile("" ::: "memory"); }
DI int crow(int i, int h) { return (i & 3) + 8 * (i >> 2) + 4 * h; }
DI bf16x8 pack8(const f32x16& x, int s) {
  u32x4 r;
  r[0] = cvt2(x[8 * s + 0], x[8 * s + 1]); r[1] = cvt2(x[8 * s + 2], x[8 * s + 3]);
  r[2] = cvt2(x[8 * s + 4], x[8 * s + 5]); r[3] = cvt2(x[8 * s + 6], x[8 * s + 7]);
  return __builtin_bit_cast(bf16x8, r);
}

static __device__ __attribute__((always_inline)) inline void convert_weight(const float* W, int K, int N, u16* out, int ldo, bool winmap) {
  float* lds = (float*)lds_base();
  const int tid = lv(threadIdx.x);
  const int nkt = K / 64, nnt = (N + 127) / 128;
  for (int t = blockIdx.x; t < nkt * nnt; t += gridDim.x) {
    const int kt = t % nkt, nt = t / nkt, k0 = kt * 64, n0 = nt * 128;
#pragma unroll
    for (int q = 0; q < 4; ++q) {
      const int e = tid + q * 512, kk = e >> 5, nn = (e & 31) * 4, n = n0 + nn;
      f32x4 v = f32x4{0.f, 0.f, 0.f, 0.f};
      if (n < N) v = *(const f32x4*)(W + (size_t)(k0 + kk) * N + n);
      lds[kk * 129 + nn + 0] = v[0]; lds[kk * 129 + nn + 1] = v[1]; lds[kk * 129 + nn + 2] = v[2]; lds[kk * 129 + nn + 3] = v[3];
    }
    lds_barrier();
#pragma unroll
    for (int rep = 0; rep < 2; ++rep) {
      const int nn = (tid >> 3) + 64 * rep, ks = tid & 7, n = n0 + nn;
      if (n < N) {
        const int orow = winmap ? (n < NPJ ? n : n + 224) : n;
        u32x4 v;
#pragma unroll
        for (int e = 0; e < 4; ++e) v[e] = cvt2(lds[(ks * 8 + 2 * e) * 129 + nn], lds[(ks * 8 + 2 * e + 1) * 129 + nn]);
        *(u32x4*)(out + (size_t)orow * ldo + k0 + ks * 8) = v;
      }
    }
    lds_barrier();
  }
  __syncthreads();
}

static __device__ __attribute__((always_inline)) inline void convert_mixer_weights(const Params& p, int l) {
  char* ws = lsp(p.ws);
  convert_weight(p.w_in + (size_t)l * 1024 * N_IN, 1024, N_IN, (u16*)(ws + OFF_WBIG), 1024, true);
  convert_weight(p.w_br0 + (size_t)l * 512 * 1024, 512, 1024, (u16*)(ws + OFF_WBR), 512, false);
  convert_weight(p.w_br1 + (size_t)l * 512 * 1024, 512, 1024, (u16*)(ws + OFF_WBR) + 1024 * 512, 512, false);
  convert_weight(p.w_br2 + (size_t)l * 512 * 1024, 512, 1024, (u16*)(ws + OFF_WBR) + 2 * 1024 * 512, 512, false);
  convert_weight(p.w_out + (size_t)l * 1024 * 1024, 1024, 1024, (u16*)(ws + OFF_WOUT), 1024, false);
  convert_weight(p.cmp_wk + (size_t)l * 131072, 2048, 64, (u16*)(ws + OFF_WT), 2048, false);
  convert_weight(p.cmp_wv + (size_t)l * 131072, 2048, 64, (u16*)(ws + OFF_WT) + 64 * 2048, 2048, false);
  if (blockIdx.x < 2) {
    const int kv = blockIdx.x, tid = lv(threadIdx.x), e = tid & 63, part = tid >> 6;
    const float* W = (kv ? p.cmp_wv : p.cmp_wk) + (size_t)l * 131072;
    const float* pp = (kv ? p.cmp_pv : p.cmp_pk) + (size_t)l * 2048;
    float* red = (float*)lds_base();
    float sacc = 0.f;
    for (int k = part * 256; k < part * 256 + 256; ++k) sacc += pp[k] * W[k * 64 + e];
    red[part * 64 + e] = sacc;
    __syncthreads();
    if (tid < 64) { float t = 0.f; for (int q = 0; q < 8; ++q) t += red[q * 64 + tid]; ((float*)(ws + OFF_CB))[kv * 64 + tid] = t; }
    __syncthreads();
  }
}
static __device__ __attribute__((always_inline)) inline void convert_ffn_weights(const Params& p, int l) {
  char* ws = lsp(p.ws);
  convert_weight(p.w_ff1 + (size_t)l * 1024 * 4096, 1024, 4096, (u16*)(ws + OFF_WBIG), 1024, false);
  convert_weight(p.w_ff2 + (size_t)l * 4096 * 1024, 4096, 1024, (u16*)(ws + OFF_WBIG) + (size_t)4096 * 1024, 4096, false);
}

DI float wave_sum(float v) {
#pragma unroll
  for (int o = 32; o > 0; o >>= 1) v += __shfl_xor(v, o);
  return v;
}
static __device__ __attribute__((always_inline)) inline void phase_norm(const float* xin, const u16* y, const float* g_post, const float* g_next, float* xout, u16* H) {
  const int tidn = lv(threadIdx.x);
  const int wave = tidn >> 6, lane = tidn & 63;
  for (int row0 = (blockIdx.x * 8 + wave) * 2; row0 < T_TOK; row0 += gridDim.x * 16) {
    float xv[2][16], yv[2][16];
#pragma unroll
    for (int rr = 0; rr < 2; ++rr)
#pragma unroll
      for (int i = 0; i < 4; ++i) {
        f32x4 t = *(const f32x4*)(xin + (size_t)(row0 + rr) * 1024 + i * 256 + lane * 4);
        xv[rr][i * 4 + 0] = t[0]; xv[rr][i * 4 + 1] = t[1]; xv[rr][i * 4 + 2] = t[2]; xv[rr][i * 4 + 3] = t[3];
      }
    if (y) {
      float ss[2] = {0.f, 0.f};
#pragma unroll
      for (int rr = 0; rr < 2; ++rr)
#pragma unroll
        for (int i = 0; i < 4; ++i) {
          s16x4 t = ld4(y + (size_t)(row0 + rr) * 1024 + i * 256 + lane * 4);
#pragma unroll
          for (int e = 0; e < 4; ++e) { yv[rr][i * 4 + e] = bfs(t[e]); ss[rr] += yv[rr][i * 4 + e] * yv[rr][i * 4 + e]; }
        }
#pragma unroll
      for (int o = 32; o > 0; o >>= 1) { float t0 = __shfl_xor(ss[0], o), t1 = __shfl_xor(ss[1], o); ss[0] += t0; ss[1] += t1; }
#pragma unroll
      for (int rr = 0; rr < 2; ++rr) {
        const float r = rsqrtf(ss[rr] * (1.f / 1024.f) + 1e-6f);
#pragma unroll
        for (int i = 0; i < 4; ++i) {
          f32x4 g = *(const f32x4*)(g_post + i * 256 + lane * 4);
          f32x4 o;
#pragma unroll
          for (int e = 0; e < 4; ++e) { xv[rr][i * 4 + e] += yv[rr][i * 4 + e] * r * g[e]; o[e] = xv[rr][i * 4 + e]; }
          *(f32x4*)(xout + (size_t)(row0 + rr) * 1024 + i * 256 + lane * 4) = o;
        }
      }
    }
    if (g_next) {
      float ss[2] = {0.f, 0.f};
#pragma unroll
      for (int rr = 0; rr < 2; ++rr)
#pragma unroll
        for (int i = 0; i < 16; ++i) ss[rr] += xv[rr][i] * xv[rr][i];
#pragma unroll
      for (int o = 32; o > 0; o >>= 1) { float t0 = __shfl_xor(ss[0], o), t1 = __shfl_xor(ss[1], o); ss[0] += t0; ss[1] += t1; }
#pragma unroll
      for (int rr = 0; rr < 2; ++rr) {
        const float r = rsqrtf(ss[rr] * (1.f / 1024.f) + 1e-6f);
#pragma unroll
        for (int i = 0; i < 4; ++i) {
          f32x4 g = *(const f32x4*)(g_next + i * 256 + lane * 4);
          *(s16x4*)(H + (size_t)(row0 + rr) * 1024 + i * 256 + lane * 4) =
              pack4(xv[rr][i * 4] * r * g[0], xv[rr][i * 4 + 1] * r * g[1], xv[rr][i * 4 + 2] * r * g[2], xv[rr][i * 4 + 3] * r * g[3]);
        }
      }
    }
  }
}

constexpr int BM = 256, BK = 64, HALF = 128, HT = HALF * BK;
DI int lds_byte(int r, int c) {
  int st = (r >> 4) * 2 + (c >> 5), rr = r & 15, cc = c & 31, ob = rr * 64 + cc * 2;
  return st * 1024 + (ob ^ (((ob >> 9) & 1) << 5));
}
DI void stage_rc(int b, int& R, int& C) {
  int st = b / 1024, sb = b % 1024, swz = sb ^ (((sb >> 9) & 1) << 5);
  R = (st >> 1) * 16 + swz / 64; C = (st & 1) * 32 + (swz % 64) / 2;
}
DI void tile_map(int wgid, int nM, int nN, int& pm, int& pn) {
  const int NXCD = 8, WGM = 8;
  int nwg = nM * nN;
  { int q = nwg / NXCD, r = nwg % NXCD, xcd = wgid % NXCD, off = wgid / NXCD;
    wgid = (xcd < r ? xcd * (q + 1) : r * (q + 1) + (xcd - r) * q) + off; }
  int nig = WGM * nN, gid = wgid / nig, fm = gid * WGM, gsz = min(nM - fm, WGM);
  pm = fm + ((wgid % nig) % gsz); pn = (wgid % nig) / gsz;
}

struct NoPre { DI void operator()(int, int, int) const {} };
template <class Epi, class Pre = NoPre>
DI void gemm_tile(const u16* A, int lda, const u16* Bt, int ldb, int K, int brow, int bcol, Epi epi, Pre pre = Pre()) {
  u16* shm = (u16*)g_shm;
#define SA(b, h) (shm + ((b) * 2 + (h)) * HT)
#define SB(b, h) (shm + (4 + (b) * 2 + (h)) * HT)
#define STAGE(P, BASE, LD, br, kt) do { const char* _gb = (const char*)((BASE) + (size_t)(br) * (LD) + (size_t)(kt) * BK); \
    for (int _i = 0; _i < 2; ++_i) { int _b = tidx * 16 + _i * 8192; \
      __builtin_amdgcn_global_load_lds((const unsigned*)(_gb + (((LD) == lda) ? offA[_i] : offB[_i])), \
        (__attribute__((address_space(3))) unsigned*)((char*)(P) + _b), 16, 0, 0); } } while (0)
#define LDA(dst, b, h) for (int m = 0; m < 4; ++m) for (int k = 0; k < 2; ++k) \
    dst[m][k] = *reinterpret_cast<const bf16x8*>((char*)SA(b, h) + lds_byte(wr * 64 + m * 16 + fr, k * 32 + fq * 8))
#define LDB(dst, b, h) for (int n = 0; n < 2; ++n) for (int k = 0; k < 2; ++k) \
    dst[n][k] = *reinterpret_cast<const bf16x8*>((char*)SB(b, h) + lds_byte(wc * 32 + n * 16 + fr, k * 32 + fq * 8))
#define MMA(ai, bj, At_, Bt_) do { __builtin_amdgcn_s_setprio(1); \
    for (int m = 0; m < 4; ++m) for (int n = 0; n < 2; ++n) for (int k = 0; k < 2; ++k) \
      acc[ai][bj][m][n] = __builtin_amdgcn_mfma_f32_16x16x32_bf16(Bt_[n][k], At_[m][k], acc[ai][bj][m][n], 0, 0, 0); \
    __builtin_amdgcn_s_setprio(0); } while (0)
#define WAIT_V(n) asm volatile("s_waitcnt vmcnt(" #n ")" ::: "memory")
#define WAIT_L(n) asm volatile("s_waitcnt lgkmcnt(" #n ")" ::: "memory")
#define BAR __builtin_amdgcn_s_barrier()
#define SCHED __builtin_amdgcn_sched_barrier(0)
  int tidx = threadIdx.x; asm volatile("" : "+v"(tidx));
  const int wid = tidx >> 6, lane = tidx & 63, wr = wid >> 2, wc = wid & 3, fr = lane & 15, fq = lane >> 4;
  unsigned offA[2], offB[2];
#pragma unroll
  for (int _i = 0; _i < 2; ++_i) { int _r, _c; stage_rc(tidx * 16 + _i * 8192, _r, _c); offA[_i] = (unsigned)(_r * lda + _c) * 2u; offB[_i] = (unsigned)(_r * ldb + _c) * 2u; }
  f32x4 acc[2][2][4][2] = {};
  bf16x8 At[4][2], B0[2][2], B1[2][2];
  const int nt = K / BK;
  STAGE(SB(0, 0), Bt, ldb, bcol, 0); STAGE(SA(0, 0), A, lda, brow, 0);
  STAGE(SB(0, 1), Bt, ldb, bcol + HALF, 0); STAGE(SA(0, 1), A, lda, brow + HALF, 0);
  if (wr == 1) BAR;
  WAIT_V(4); BAR;
  STAGE(SB(1, 0), Bt, ldb, bcol, 1); STAGE(SA(1, 0), A, lda, brow, 1); STAGE(SB(1, 1), Bt, ldb, bcol + HALF, 1);
  WAIT_V(6); BAR;
  for (int t = 0; t < nt - 2; t += 2) {
    LDB(B0, 0, 0); SCHED; LDA(At, 0, 0); STAGE(SA(1, 1), A, lda, brow + HALF, t + 1);
    WAIT_L(8); BAR; WAIT_L(0); MMA(0, 0, At, B0); BAR; SCHED;
    LDB(B1, 0, 1); STAGE(SB(0, 0), Bt, ldb, bcol, t + 2);
    BAR; WAIT_L(0); MMA(0, 1, At, B1); BAR;
    LDA(At, 0, 1); STAGE(SA(0, 0), A, lda, brow, t + 2);
    BAR; WAIT_L(0); MMA(1, 0, At, B0); BAR; SCHED;
    STAGE(SB(0, 1), Bt, ldb, bcol + HALF, t + 2);
    WAIT_V(6); BAR; MMA(1, 1, At, B1); BAR;
    LDB(B0, 1, 0); SCHED; LDA(At, 1, 0); STAGE(SA(0, 1), A, lda, brow + HALF, t + 2);
    WAIT_L(8); BAR; WAIT_L(0); MMA(0, 0, At, B0); BAR; SCHED;
    LDB(B1, 1, 1); STAGE(SB(1, 0), Bt, ldb, bcol, t + 3);
    BAR; WAIT_L(0); MMA(0, 1, At, B1); BAR;
    LDA(At, 1, 1); STAGE(SA(1, 0), A, lda, brow, t + 3);
    BAR; WAIT_L(0); MMA(1, 0, At, B0); BAR; SCHED;
    STAGE(SB(1, 1), Bt, ldb, bcol + HALF, t + 3);
    WAIT_V(6); BAR; MMA(1, 1, At, B1); BAR;
  }
  { LDB(B0, 0, 0); LDA(At, 0, 0); STAGE(SA(1, 1), A, lda, brow + HALF, nt - 1);
    BAR; WAIT_L(0); MMA(0, 0, At, B0); BAR;
    LDB(B1, 0, 1); BAR; WAIT_L(0); MMA(0, 1, At, B1); BAR;
    LDA(At, 0, 1); WAIT_V(4); BAR; WAIT_L(0); MMA(1, 0, At, B0); MMA(1, 1, At, B1); BAR; }
  { LDB(B0, 1, 0); LDA(At, 1, 0); WAIT_V(2); BAR; WAIT_L(0); MMA(0, 0, At, B0); BAR;
    LDB(B1, 1, 1); WAIT_V(0); BAR; WAIT_L(0); MMA(0, 1, At, B1); BAR;
    LDA(At, 1, 1); BAR; WAIT_L(0); MMA(1, 0, At, B0); MMA(1, 1, At, B1); BAR; }
  if (wr == 0) BAR;
  int tid2 = tidx; asm volatile("" : "+v"(tid2));
  const int wid2 = tid2 >> 6, lane2 = tid2 & 63, wr2 = wid2 >> 2, wc2 = wid2 & 3, fr2 = lane2 & 15, fq2 = lane2 >> 4;
#pragma unroll
  for (int ai = 0; ai < 2; ++ai)
#pragma unroll
    for (int bj = 0; bj < 2; ++bj)
#pragma unroll
      for (int m = 0; m < 4; ++m) {
#pragma unroll
        for (int n = 0; n < 2; ++n)
          pre(n, brow + ai * HALF + wr2 * 64 + m * 16 + fr2, bcol + bj * HALF + wc2 * 32 + n * 16 + fq2 * 4);
#pragma unroll
        for (int n = 0; n < 2; ++n)
          epi(n, brow + ai * HALF + wr2 * 64 + m * 16 + fr2, bcol + bj * HALF + wc2 * 32 + n * 16 + fq2 * 4, acc[ai][bj][m][n]);
      }
  __syncthreads();
#undef SA
#undef SB
#undef STAGE
#undef LDA
#undef LDB
#undef MMA
}

static __device__ __attribute__((always_inline)) inline void phase_inproj(const Params& p) {
  char* ws = lsp(p.ws);
  u16* H = (u16*)(ws + OFF_H); u16* WinT = (u16*)(ws + OFF_WBIG); u16* PROJ = (u16*)(ws + OFF_PROJ);
  u16* HALO = (u16*)(ws + OFF_HALO);
  const int nM = 64, nN = 20;
  for (int t = blockIdx.x; t < nM * nN; t += gridDim.x) {
    int pm, pn; tile_map(t, nM, nN, pm, pn);
    gemm_tile(H, 1024, WinT, 1024, 1024, pm * 256, pn * 256, [&](int idx, int row, int col, f32x4 v) {
      if (col < NPJ) {
        s16x4 b = pack4(v[0], v[1], v[2], v[3]);
        *(s16x4*)(PROJ + (size_t)row * NPJ + col) = b;
        if (col < 1536 && (row & 63) >= 61) *(s16x4*)(HALO + ((size_t)(row >> 6) * 3 + ((row & 63) - 61)) * 1536 + col) = b;
      }
    });
  }
}

static __device__ __attribute__((always_inline)) inline void sb_attn_wave(const Params& p, int witem) {
  u16* PROJ = (u16*)(lsp(p.ws) + OFF_PROJ);
  const int tid = lv(threadIdx.x), lane = tid & 63, w = tid >> 6, lq5 = lane & 31, hf = lane >> 5;
  u16* VT = (u16*)lds_base() + w * (64 * 40);
  const int b = witem >> 8, h = (witem >> 5) & 7, qt = witem & 31;
  const int t0 = qt * 64;
  bf16x8 qf[2][4];
#pragma unroll
  for (int qi = 0; qi < 2; ++qi)
#pragma unroll
    for (int s = 0; s < 4; ++s) {
      bf16x8 raw = ld8(PROJ + ((size_t)b * SEQL + t0 + 32 * qi + lq5) * NPJ + C_SQ + h * 64 + 16 * s + 8 * hf);
#pragma unroll
      for (int e = 0; e < 8; ++e) raw[e] = (short)f2bf(bfs(raw[e]) * 0.125f);
      qf[qi][s] = raw;
    }
  f32x16 oacc[2][2];
#pragma unroll
  for (int i = 0; i < 16; ++i) { oacc[0][0][i] = 0.f; oacc[0][1][i] = 0.f; oacc[1][0][i] = 0.f; oacc[1][1][i] = 0.f; }
  float carry[2] = {1.f, 1.f};
#pragma unroll 1
  for (int k0 = t0 + 32; k0 >= 0; k0 -= 32) {
    const size_t krow = ((size_t)b * SEQL + k0 + lq5) * NPJ + C_SK + h * 64;
    {
      bf16x8 v0 = ld8(PROJ + krow + 512 + hf * 32), v1 = ld8(PROJ + krow + 512 + hf * 32 + 8);
      bf16x8 v2 = ld8(PROJ + krow + 512 + hf * 32 + 16), v3 = ld8(PROJ + krow + 512 + hf * 32 + 24);
#pragma unroll
      for (int e = 0; e < 8; ++e) {
        VT[(hf * 32 + e) * 40 + lq5] = (u16)v0[e]; VT[(hf * 32 + 8 + e) * 40 + lq5] = (u16)v1[e];
        VT[(hf * 32 + 16 + e) * 40 + lq5] = (u16)v2[e]; VT[(hf * 32 + 24 + e) * 40 + lq5] = (u16)v3[e];
      }
    }
    bf16x8 kf[4];
#pragma unroll
    for (int s = 0; s < 4; ++s) kf[s] = ld8(PROJ + krow + 16 * s + 8 * hf);
#pragma unroll
    for (int qi = 0; qi < 2; ++qi) {
      if (k0 >= t0 + 32 * qi + 31) continue;
      f32x16 st;
#pragma unroll
      for (int i = 0; i < 16; ++i) st[i] = 0.f;
#pragma unroll
      for (int s = 0; s < 4; ++s) st = mfma32(kf[s], qf[qi][s], st);
      const int t = t0 + 32 * qi + lq5;
      float m[16];
#pragma unroll
      for (int i = 0; i < 16; ++i) {
        const float z = fminf(fmaxf(st[i], -80.f), 80.f);
        const float e = __expf(z);
        const float r = __builtin_amdgcn_rcpf(1.f + e);
        const bool c = (k0 + crow(i, hf)) < t;
        m[i] = c ? r : 1.f;
        st[i] = c ? e * r : 0.f;
      }
      float T[4], P[4];
#pragma unroll
      for (int gi = 0; gi < 4; ++gi) { T[gi] = (m[4 * gi] * m[4 * gi + 1]) * (m[4 * gi + 2] * m[4 * gi + 3]); P[gi] = __shfl_xor(T[gi], 32); }
      float aft[4];
      aft[3] = (hf == 0) ? P[3] : 1.f;
      aft[2] = T[3] * P[3] * ((hf == 0) ? P[2] : 1.f);
      aft[1] = T[3] * P[3] * T[2] * P[2] * ((hf == 0) ? P[1] : 1.f);
      aft[0] = T[3] * P[3] * T[2] * P[2] * T[1] * P[1] * ((hf == 0) ? P[0] : 1.f);
      const float cin = carry[qi];
#pragma unroll
      for (int gi = 0; gi < 4; ++gi) {
        const float base = cin * aft[gi];
        const float w2 = m[4 * gi + 3], w1 = w2 * m[4 * gi + 2], w0 = w1 * m[4 * gi + 1];
        st[4 * gi + 0] *= base * w0;
        st[4 * gi + 1] *= base * w1;
        st[4 * gi + 2] *= base * w2;
        st[4 * gi + 3] *= base;
      }
      carry[qi] = cin * ((T[0] * P[0]) * (T[1] * P[1])) * ((T[2] * P[2]) * (T[3] * P[3]));
#pragma unroll
      for (int s = 0; s < 2; ++s) {
        bf16x8 pf = pack8(st, s);
#pragma unroll
        for (int dt = 0; dt < 2; ++dt) {
          const u16* vp = VT + (32 * dt + lq5) * 40 + 16 * s + 4 * hf;
          s16x4 lo = ld4(vp), hi = ld4(vp + 8);
          bf16x8 vf = __builtin_shufflevector(lo, hi, 0, 1, 2, 3, 4, 5, 6, 7);
          oacc[qi][dt] = mfma32(vf, pf, oacc[qi][dt]);
        }
      }
    }
    if (k0 <= t0 && __all(carry[0] < 1.2e-38f && carry[1] < 1.2e-38f)) break;
  }
#pragma unroll
  for (int qi = 0; qi < 2; ++qi)
#pragma unroll
    for (int dt = 0; dt < 2; ++dt)
#pragma unroll
      for (int g4 = 0; g4 < 4; ++g4)
        *(s16x4*)(PROJ + ((size_t)b * SEQL + t0 + 32 * qi + lq5) * NPJ + C_SQ + h * 64 + 32 * dt + 8 * g4 + 4 * hf) =
            pack4(oacc[qi][dt][4 * g4], oacc[qi][dt][4 * g4 + 1], oacc[qi][dt][4 * g4 + 2], oacc[qi][dt][4 * g4 + 3]);
}

static __device__ __attribute__((always_inline)) inline void nsa_compress(const Params& p, int l, int item) {
  char* ws = lsp(p.ws);
  const u16* PROJ = (const u16*)(ws + OFF_PROJ);
  u16* KC = (u16*)(ws + OFF_KC); u16* VCT = (u16*)(ws + OFF_VCT);
  const u16* WT = (const u16*)(ws + OFF_WT); const float* CB = (const float*)(ws + OFF_CB);
  float* red = (float*)lds_base();
  const int tid = lv(threadIdx.x), lane = tid & 63, w = tid >> 6, lq5 = lane & 31, hf = lane >> 5;
  const int nt4 = item & 3, kv = (item >> 2) & 1, g = (item >> 3) & 1, b = item >> 4;
  const int n = 32 * nt4 + lq5;
  f32x16 acc[2];
#pragma unroll
  for (int i = 0; i < 16; ++i) { acc[0][i] = 0.f; acc[1][i] = 0.f; }
#pragma unroll 4
  for (int ks = 0; ks < 16; ++ks) {
    const int ll = 4 * w + (ks >> 2), d0 = (ks & 3) * 16 + 8 * hf;
    bf16x8 a;
#pragma unroll
    for (int e = 0; e < 8; ++e) a[e] = 0;
    if (n < 127) a = ld8(PROJ + ((size_t)b * SEQL + 16 * n + ll) * NPJ + C_NKV + kv * 128 + g * 64 + d0);
#pragma unroll
    for (int et = 0; et < 2; ++et)
      acc[et] = mfma32(a, ld8(WT + ((size_t)(kv * 64 + 32 * et + lq5)) * 2048 + ll * 64 + d0), acc[et]);
  }
#pragma unroll
  for (int et = 0; et < 2; ++et)
#pragma unroll
    for (int i = 0; i < 16; ++i) red[(w * 32 + crow(i, hf)) * 64 + 32 * et + lq5] = acc[et][i];
  __syncthreads();
  {
    const int nl = tid >> 4, e0 = (tid & 15) * 4;
    float v[4];
#pragma unroll
    for (int q = 0; q < 4; ++q) v[q] = CB[kv * 64 + e0 + q];
#pragma unroll
    for (int ww = 0; ww < 8; ++ww)
#pragma unroll
      for (int q = 0; q < 4; ++q) v[q] += red[(ww * 32 + nl) * 64 + e0 + q];
    const int nn = 32 * nt4 + nl;
    if (nn >= 127) { v[0] = 0.f; v[1] = 0.f; v[2] = 0.f; v[3] = 0.f; }
    if (kv == 0) *(s16x4*)(KC + ((size_t)(b * 2 + g) * 128 + nn) * 64 + e0) = pack4(v[0], v[1], v[2], v[3]);
    else {
#pragma unroll
      for (int q = 0; q < 4; ++q) VCT[((size_t)(b * 2 + g) * 64 + e0 + q) * 128 + nn] = f2bf(v[q]);
    }
  }
  __syncthreads();
}

static __device__ __attribute__((always_inline)) inline void gdn_prep(const Params& p, int l, int item) {
  char* ws = lsp(p.ws);
  u16* PROJ = (u16*)(ws + OFF_PROJ); u16* HALO = (u16*)(ws + OFF_HALO);
  u16* WG = (u16*)(ws + OFF_SCR); u16* ATT = (u16*)(ws + OFF_SCR + 16777216);
  float* EGL = (float*)(ws + OFF_EGL);
  u16* Qb = (u16*)lds_base();
  u16* Kb = Qb + 64 * 136;
  u16* vbT = Kb + 64 * 136;
  u16* kbT = vbT + 128 * 72;
  float* As = (float*)(kbT + 128 * 72);
  u16* Tb = (u16*)(As + 64 * 65);
  float* sg = (float*)(Tb + 64 * 72);
  float* sbeta = sg + 64; float* sgc = sbeta + 64;
  const int tid = lv(threadIdx.x), lane = tid & 63, w = tid >> 6, lr = lane & 15, lq = lane >> 4;
  const int c = item & 31, h = (item >> 5) & 3, b = item >> 7;
  const int t0 = b * SEQL + c * 64;
  const int i = tid & 63, cgp = tid >> 6;
  const float* cw = p.conv_w + (size_t)l * 4 * 1536;
  if (tid < 64) {
    float a = bf2f(PROJ[(size_t)(t0 + tid) * NPJ + C_GA + h]);
    float bt = bf2f(PROJ[(size_t)(t0 + tid) * NPJ + C_GB + h]);
    sg[tid] = -__expf(p.a_log[l * 4 + h]) * softplusf_(a + p.dt_bias[l * 4 + h]);
    sbeta[tid] = sigmoidf_(bt);
  }
  float qkv[3][16];
  {
    bf16x8 xr[3][4][2];
#pragma unroll
    for (int sec = 0; sec < 3; ++sec)
#pragma unroll
      for (int j = 0; j < 4; ++j) {
        const int colb = sec * 512 + h * 128 + cgp * 16;
        const int ii = i - 3 + j;
        const u16* src = (ii >= 0) ? PROJ + (size_t)(t0 + ii) * NPJ + colb
                                   : HALO + ((size_t)(max(t0 >> 6, 1) - 1) * 3 + (3 + ii)) * 1536 + colb;
        xr[sec][j][0] = ld8(src); xr[sec][j][1] = ld8(src + 8);
      }
#pragma unroll
    for (int sec = 0; sec < 3; ++sec) {
      const int colb = sec * 512 + h * 128 + cgp * 16;
#pragma unroll
      for (int e = 0; e < 16; ++e) qkv[sec][e] = 0.f;
#pragma unroll
      for (int j = 0; j < 4; ++j) {
        const int ii = i - 3 + j;
        const float keep = (ii >= 0 || c > 0) ? 1.f : 0.f;
#pragma unroll
        for (int e = 0; e < 8; ++e) {
          qkv[sec][e] += (keep * cw[j * 1536 + colb + e]) * bfs(xr[sec][j][0][e]);
          qkv[sec][8 + e] += (keep * cw[j * 1536 + colb + 8 + e]) * bfs(xr[sec][j][1][e]);
        }
      }
#pragma unroll
      for (int e = 0; e < 16; ++e) { float x = qkv[sec][e]; qkv[sec][e] = x * __builtin_amdgcn_rcpf(1.f + __expf(-x)); }
    }
  }
  {
    float sq = 0.f, sk = 0.f;
#pragma unroll
    for (int e = 0; e < 16; ++e) { sq += qkv[0][e] * qkv[0][e]; sk += qkv[1][e] * qkv[1][e]; }
    float* rdn = As;
    rdn[(0 * 8 + cgp) * 64 + i] = sq; rdn[(1 * 8 + cgp) * 64 + i] = sk;
    __syncthreads();
    sq = 0.f; sk = 0.f;
#pragma unroll
    for (int cc = 0; cc < 8; ++cc) { sq += rdn[(0 * 8 + cc) * 64 + i]; sk += rdn[(1 * 8 + cc) * 64 + i]; }
    float rq = rsqrtf(sq + 1e-6f) * 0.08838834764831845f, rk = rsqrtf(sk + 1e-6f);
#pragma unroll
    for (int e = 0; e < 16; ++e) { qkv[0][e] *= rq; qkv[1][e] *= rk; }
  }
  if (tid < 64) {
    float sc_ = sg[tid];
#pragma unroll
    for (int o = 1; o < 64; o <<= 1) { float t = __shfl_up(sc_, o); if (lane >= o) sc_ += t; }
    sgc[tid] = sc_;
    if (tid == 63) EGL[item] = __expf(sc_);
  }
  __syncthreads();
  {
    const float gci = sgc[i], gl = sgc[63], bi = sbeta[i];
    const float eg = __expf(gci), ekd = __expf(gl - gci);
    bf16x8 a0, a1, b0, b1, c0, c1, d0, d1;
#pragma unroll
    for (int e = 0; e < 8; ++e) {
      a0[e] = (short)f2bf(qkv[0][e]); a1[e] = (short)f2bf(qkv[0][8 + e]);
      b0[e] = (short)f2bf(qkv[1][e]); b1[e] = (short)f2bf(qkv[1][8 + e]);
      c0[e] = (short)f2bf(qkv[0][e] * eg); c1[e] = (short)f2bf(qkv[0][8 + e] * eg);
      d0[e] = (short)f2bf(qkv[1][e] * ekd); d1[e] = (short)f2bf(qkv[1][8 + e] * ekd);
    }
    *(bf16x8*)(Qb + i * 136 + cgp * 16) = a0; *(bf16x8*)(Qb + i * 136 + cgp * 16 + 8) = a1;
    *(bf16x8*)(Kb + i * 136 + cgp * 16) = b0; *(bf16x8*)(Kb + i * 136 + cgp * 16 + 8) = b1;
    u16* gq = PROJ + (size_t)(t0 + i) * NPJ + C_GQ + h * 128 + cgp * 16;
    u16* gk = PROJ + (size_t)(t0 + i) * NPJ + C_GK + h * 128 + cgp * 16;
    *(bf16x8*)gq = c0; *(bf16x8*)(gq + 8) = c1;
    *(bf16x8*)gk = d0; *(bf16x8*)(gk + 8) = d1;
#pragma unroll
    for (int e = 0; e < 16; ++e) {
      vbT[(cgp * 16 + e) * 72 + i] = f2bf(qkv[2][e] * bi);
      kbT[(cgp * 16 + e) * 72 + i] = f2bf(qkv[1][e] * bi * eg);
    }
  }
  __syncthreads();
#pragma unroll 1
  for (int jj = 0; jj < 2; ++jj) {
    const int tile = w * 2 + jj, ti = tile >> 2, tj = tile & 3;
    f32x4 acc = {0.f, 0.f, 0.f, 0.f};
    if (tj <= ti) {
#pragma unroll
      for (int ks = 0; ks < 4; ++ks)
        acc = mfma16(ld8(Kb + (ti * 16 + lr) * 136 + ks * 32 + lq * 8), ld8(Kb + (tj * 16 + lr) * 136 + ks * 32 + lq * 8), acc);
    }
    const int j = tj * 16 + lr;
#pragma unroll
    for (int r = 0; r < 4; ++r) {
      const int ir = ti * 16 + lq * 4 + r;
      As[ir * 65 + j] = (j < ir) ? sbeta[ir] * acc[r] * __expf(sgc[ir] - sgc[j]) : 0.f;
    }
  }
  __syncthreads();
  if (w != 0) {
#pragma unroll 1
    for (int tile = w - 1; tile < 16; tile += 7) {
      const int ti = tile >> 2, tj = tile & 3;
      f32x4 acc = {0.f, 0.f, 0.f, 0.f};
      if (tj <= ti) {
#pragma unroll
        for (int ks = 0; ks < 4; ++ks)
          acc = mfma16(ld8(Qb + (ti * 16 + lr) * 136 + ks * 32 + lq * 8), ld8(Kb + (tj * 16 + lr) * 136 + ks * 32 + lq * 8), acc);
      }
      const int j = tj * 16 + lr;
#pragma unroll
      for (int r = 0; r < 4; ++r) {
        const int ir = ti * 16 + lq * 4 + r;
        const float dec = (j <= ir) ? __expf(sgc[ir] - sgc[j]) : 0.f;
        ATT[(size_t)item * 4096 + ir * 64 + j] = f2bf(acc[r] * dec);
      }
    }
  }
  if (w == 0) {
    float Ar[64], Tc[64];
#pragma unroll
    for (int ir = 0; ir < 64; ++ir) Ar[ir] = As[ir * 65 + lane];
#pragma unroll
    for (int ir = 0; ir < 64; ++ir) {
      float sacc = (ir == lane) ? 1.f : 0.f;
#pragma unroll
      for (int j = 0; j < ir; ++j) sacc -= __uint_as_float(__builtin_amdgcn_readlane(__float_as_uint(Ar[ir]), j)) * Tc[j];
      Tc[ir] = sacc;
    }
#pragma unroll
    for (int ir = 0; ir < 64; ++ir) Tb[ir * 72 + lane] = f2bf(Tc[ir]);
  }
  __syncthreads();
#pragma unroll 1
  for (int jj = 0; jj < 8; ++jj) {
    const int job = w * 8 + jj, which = job >> 5, tile = job & 31, ti = tile >> 3, tn = tile & 7;
    const u16* BT = which ? kbT : vbT;
    f32x4 acc = {0.f, 0.f, 0.f, 0.f};
#pragma unroll
    for (int ks = 0; ks < 2; ++ks)
      acc = mfma16(ld8(Tb + (ti * 16 + lr) * 72 + ks * 32 + lq * 8), ld8(BT + (tn * 16 + lr) * 72 + ks * 32 + lq * 8), acc);
    const int d = tn * 16 + lr;
#pragma unroll
    for (int r = 0; r < 4; ++r) {
      const int ir = ti * 16 + lq * 4 + r;
      if (which == 0) PROJ[(size_t)(t0 + ir) * NPJ + C_GV + h * 128 + d] = f2bf(acc[r]);
      else WG[(size_t)(t0 + ir) * 512 + h * 128 + d] = f2bf(acc[r]);
    }
  }
  __syncthreads();
}

static __device__ __attribute__((always_inline)) inline void gdn_scan(const Params& p, int l, int bh) {
  char* ws = lsp(p.ws);
  u16* PROJ = (u16*)(ws + OFF_PROJ);
  const u16* WG = (const u16*)(ws + OFF_SCR); const u16* ATT = (const u16*)(ws + OFF_SCR + 16777216);
  const float* EGL = (const float*)(ws + OFF_EGL);
  u16* St = (u16*)lds_base();
  u16* Wl = St + 128 * 136;
  u16* Ql = Wl + 64 * 136;
  u16* KdT = Ql + 64 * 136;
  u16* VnT = KdT + 128 * 72;
  u16* At = VnT + 128 * 72;
  float* red = (float*)(At + 64 * 72);
  float* egls = red + 128;
  const int tid = lv(threadIdx.x), lane = tid & 63, w = tid >> 6, lr = lane & 15, lq = lane >> 4;
  const int b = bh >> 2, h = bh & 3;
  const float* ng = p.norm_g + l * 128;
  f32x4 S[8];
#pragma unroll
  for (int v = 0; v < 8; ++v) S[v] = f32x4{0.f, 0.f, 0.f, 0.f};
  for (int idx = tid; idx < 128 * 136; idx += 512) St[idx] = 0;
  const int it = w >> 1, vb = (w & 1) * 4;
  float ngv[4];
#pragma unroll
  for (int n = 0; n < 4; ++n) ngv[n] = ng[(vb + n) * 16 + lr];
  const int r0 = tid >> 4, seg0 = tid & 15;
  const int ra = tid >> 3, sega = tid & 7;
  bf16x8 pw[2], pq[2], pk[2], pa;
  u16 un[16];
  {
    const int t0 = b * SEQL;
#pragma unroll
    for (int rep = 0; rep < 2; ++rep) {
      const int r = r0 + rep * 32;
      pw[rep] = ld8(WG + (size_t)(t0 + r) * 512 + h * 128 + seg0 * 8);
      pq[rep] = ld8(PROJ + (size_t)(t0 + r) * NPJ + C_GQ + h * 128 + seg0 * 8);
      pk[rep] = ld8(PROJ + (size_t)(t0 + r) * NPJ + C_GK + h * 128 + seg0 * 8);
    }
    pa = ld8(ATT + (size_t)(bh * 32) * 4096 + ra * 64 + sega * 8);
#pragma unroll
    for (int n = 0; n < 4; ++n)
#pragma unroll
      for (int r = 0; r < 4; ++r)
        un[n * 4 + r] = PROJ[(size_t)(t0 + it * 16 + lq * 4 + r) * NPJ + C_GV + h * 128 + (vb + n) * 16 + lr];
    if (tid < 32) egls[tid] = EGL[bh * 32 + tid];
  }
#pragma unroll 1
  for (int c = 0; c < 32; ++c) {
    const int t0 = b * SEQL + c * 64;
#pragma unroll
    for (int rep = 0; rep < 2; ++rep) {
      const int r = r0 + rep * 32;
      *(bf16x8*)(Wl + r * 136 + seg0 * 8) = pw[rep];
      *(bf16x8*)(Ql + r * 136 + seg0 * 8) = pq[rep];
#pragma unroll
      for (int e = 0; e < 8; ++e) KdT[(seg0 * 8 + e) * 72 + r] = (u16)pk[rep][e];
    }
    *(bf16x8*)(At + ra * 72 + sega * 8) = pa;
    u16 uc[16], zc[16];
#pragma unroll
    for (int q = 0; q < 16; ++q) uc[q] = un[q];
#pragma unroll
    for (int n = 0; n < 4; ++n)
#pragma unroll
      for (int r = 0; r < 4; ++r)
        zc[n * 4 + r] = PROJ[(size_t)(t0 + it * 16 + lq * 4 + r) * NPJ + C_GZ + h * 128 + (vb + n) * 16 + lr];
    lds_barrier();
    if (c + 1 < 32) {
      const int t1 = t0 + 64;
#pragma unroll
      for (int rep = 0; rep < 2; ++rep) {
        const int r = r0 + rep * 32;
        pw[rep] = ld8(WG + (size_t)(t1 + r) * 512 + h * 128 + seg0 * 8);
        pq[rep] = ld8(PROJ + (size_t)(t1 + r) * NPJ + C_GQ + h * 128 + seg0 * 8);
        pk[rep] = ld8(PROJ + (size_t)(t1 + r) * NPJ + C_GK + h * 128 + seg0 * 8);
      }
      pa = ld8(ATT + (size_t)(bh * 32 + c + 1) * 4096 + ra * 64 + sega * 8);
#pragma unroll
      for (int n = 0; n < 4; ++n)
#pragma unroll
        for (int r = 0; r < 4; ++r)
          un[n * 4 + r] = PROJ[(size_t)(t1 + it * 16 + lq * 4 + r) * NPJ + C_GV + h * 128 + (vb + n) * 16 + lr];
    }
    f32x4 vacc[4], oacc[4];
#pragma unroll
    for (int n = 0; n < 4; ++n) { vacc[n] = f32x4{0.f, 0.f, 0.f, 0.f}; oacc[n] = f32x4{0.f, 0.f, 0.f, 0.f}; }
#pragma unroll
    for (int ks = 0; ks < 4; ++ks) {
      bf16x8 aw = ld8(Wl + (it * 16 + lr) * 136 + ks * 32 + lq * 8);
      bf16x8 aq = ld8(Ql + (it * 16 + lr) * 136 + ks * 32 + lq * 8);
#pragma unroll
      for (int n = 0; n < 4; ++n) {
        bf16x8 bs = ld8(St + ((vb + n) * 16 + lr) * 136 + ks * 32 + lq * 8);
        vacc[n] = mfma16(aw, bs, vacc[n]);
        oacc[n] = mfma16(aq, bs, oacc[n]);
      }
    }
#pragma unroll
    for (int n = 0; n < 4; ++n) {
      const int v = (vb + n) * 16 + lr;
      *(s16x4*)(VnT + v * 72 + it * 16 + lq * 4) =
          pack4(bf2f(uc[n * 4 + 0]) - vacc[n][0], bf2f(uc[n * 4 + 1]) - vacc[n][1], bf2f(uc[n * 4 + 2]) - vacc[n][2], bf2f(uc[n * 4 + 3]) - vacc[n][3]);
    }
    lds_barrier();
#pragma unroll
    for (int ks = 0; ks < 2; ++ks) {
      bf16x8 aa = ld8(At + (it * 16 + lr) * 72 + ks * 32 + lq * 8);
#pragma unroll
      for (int n = 0; n < 4; ++n)
        oacc[n] = mfma16(aa, ld8(VnT + ((vb + n) * 16 + lr) * 72 + ks * 32 + lq * 8), oacc[n]);
    }
    {
      bf16x8 ak0 = ld8(KdT + (w * 16 + lr) * 72 + lq * 8), ak1 = ld8(KdT + (w * 16 + lr) * 72 + 32 + lq * 8);
#pragma unroll
      for (int vt = 0; vt < 8; ++vt) {
        f32x4 a = S[vt] * egls[c];
        a = mfma16(ak0, ld8(VnT + (vt * 16 + lr) * 72 + lq * 8), a);
        a = mfma16(ak1, ld8(VnT + (vt * 16 + lr) * 72 + 32 + lq * 8), a);
        S[vt] = a;
        *(s16x4*)(St + (vt * 16 + lr) * 136 + w * 16 + lq * 4) = pack4(a[0], a[1], a[2], a[3]);
      }
    }
    {
      float ssr[4];
#pragma unroll
      for (int r = 0; r < 4; ++r) {
        float sq = 0.f;
#pragma unroll
        for (int n = 0; n < 4; ++n) sq += oacc[n][r] * oacc[n][r];
        sq += __shfl_xor(sq, 1); sq += __shfl_xor(sq, 2); sq += __shfl_xor(sq, 4); sq += __shfl_xor(sq, 8);
        ssr[r] = sq;
      }
      if (lr == 0) {
#pragma unroll
        for (int r = 0; r < 4; ++r) red[(it * 16 + lq * 4 + r) * 2 + (w & 1)] = ssr[r];
      }
    }
    lds_barrier();
#pragma unroll
    for (int r = 0; r < 4; ++r) {
      const int ir = it * 16 + lq * 4 + r;
      const float rs = rsqrtf((red[ir * 2] + red[ir * 2 + 1]) * (1.f / 128.f) + 1e-6f);
#pragma unroll
      for (int n = 0; n < 4; ++n) {
        const int v = (vb + n) * 16 + lr;
        const float z = bf2f(zc[n * 4 + r]);
        const float y = oacc[n][r] * rs * ngv[n] * z * __builtin_amdgcn_rcpf(1.f + __expf(-z));
        PROJ[(size_t)(t0 + ir) * NPJ + C_GV + h * 128 + v] = f2bf(y);
      }
    }
  }
  __syncthreads();
}


static __device__ __attribute__((always_inline)) inline void nsa_attn(const Params& p, int item) {
  char* ws = lsp(p.ws);
  u16* PROJ = (u16*)(ws + OFF_PROJ);
  const u16* KC = (const u16*)(ws + OFF_KC); const u16* VCT = (const u16*)(ws + OFF_VCT);
  u16* Ks = (u16*)lds_base();
  float* impw = (float*)(Ks + 4 * 64 * 72);
  unsigned* selm = (unsigned*)(impw + 4 * 64 * 32);
  unsigned* uni = selm + 64;
  const int tid = lv(threadIdx.x), lane = tid & 63, w = tid >> 6;
  const int hh = w & 3, qhalf = w >> 2, lq5 = lane & 31, hf = lane >> 5;
  const int qb = 31 - (item >> 4), bg = item & 15, b = bg >> 1, g = bg & 1;
  const int ql = qhalf * 32 + lq5, tpos = qb * 64 + ql;
  const size_t row = (size_t)b * SEQL + tpos;
  const int head = g * 4 + hh;
  bf16x8 qf[4];
#pragma unroll
  for (int s = 0; s < 4; ++s) {
    bf16x8 raw = ld8(PROJ + row * NPJ + C_NQ + head * 64 + 16 * s + 8 * hf);
#pragma unroll
    for (int e = 0; e < 8; ++e) raw[e] = (short)f2bf(bfs(raw[e]) * 0.125f);
    qf[s] = raw;
  }
  if (tid == 0) *uni = 0u;
  float gate[3];
#pragma unroll
  for (int i = 0; i < 3; ++i) gate[i] = sigmoidf_(bf2f(PROJ[row * NPJ + C_NG + head * 3 + i]));
  f32x16 ofin[2];
  {
    f32x16 sc[4];
    const u16* kcb = KC + (size_t)(b * 2 + g) * 128 * 64;
#pragma unroll
    for (int mt = 0; mt < 4; ++mt) {
#pragma unroll
      for (int i = 0; i < 16; ++i) sc[mt][i] = 0.f;
#pragma unroll
      for (int s = 0; s < 4; ++s) sc[mt] = mfma32(ld8(kcb + (32 * mt + lq5) * 64 + 16 * s + 8 * hf), qf[s], sc[mt]);
    }
    const int nlim = (tpos >= 31) ? min(126, (tpos - 31) >> 4) : -1;
    float mx = -1e30f;
#pragma unroll
    for (int mt = 0; mt < 4; ++mt)
#pragma unroll
      for (int i = 0; i < 16; ++i) { int n = 32 * mt + crow(i, hf); if (n <= nlim) mx = fmaxf(mx, sc[mt][i]); }
    mx = fmaxf(mx, __shfl_xor(mx, 32));
    float ls = 0.f;
#pragma unroll
    for (int mt = 0; mt < 4; ++mt)
#pragma unroll
      for (int i = 0; i < 16; ++i) {
        int n = 32 * mt + crow(i, hf);
        float pv = (n <= nlim) ? __expf(sc[mt][i] - mx) : 0.f;
        sc[mt][i] = pv; ls += pv;
      }
    ls += __shfl_xor(ls, 32);
    const float inv = ls > 0.f ? 1.f / ls : 0.f;
#pragma unroll
    for (int mt = 0; mt < 4; ++mt)
#pragma unroll
      for (int i = 0; i < 16; ++i) sc[mt][i] *= inv;
    f32x16 oc[2];
#pragma unroll
    for (int i = 0; i < 16; ++i) { oc[0][i] = 0.f; oc[1][i] = 0.f; }
    const u16* vcb = VCT + (size_t)(b * 2 + g) * 64 * 128;
#pragma unroll
    for (int mt = 0; mt < 4; ++mt)
#pragma unroll
      for (int s = 0; s < 2; ++s) {
        bf16x8 pf = pack8(sc[mt], s);
#pragma unroll
        for (int dt = 0; dt < 2; ++dt) {
          const u16* vp = vcb + (32 * dt + lq5) * 128 + 32 * mt + 16 * s + 4 * hf;
          s16x4 lo = ld4(vp), hi = ld4(vp + 8);
          bf16x8 vf = __builtin_shufflevector(lo, hi, 0, 1, 2, 3, 4, 5, 6, 7);
          oc[dt] = mfma32(vf, pf, oc[dt]);
        }
      }
#pragma unroll
    for (int i = 0; i < 16; ++i) { ofin[0][i] = gate[0] * oc[0][i]; ofin[1][i] = gate[0] * oc[1][i]; }
    float G[4][4], rl[4][4];
#pragma unroll
    for (int mt = 0; mt < 4; ++mt)
#pragma unroll
      for (int gi = 0; gi < 4; ++gi) {
        G[mt][gi] = sc[mt][4 * gi] + sc[mt][4 * gi + 1] + sc[mt][4 * gi + 2] + sc[mt][4 * gi + 3];
        rl[mt][gi] = __shfl_xor(sc[mt][4 * gi + 3], 32);
      }
#pragma unroll
    for (int mt = 0; mt < 4; ++mt)
#pragma unroll
      for (int gi = 0; gi < 4; ++gi) {
        float prev;
        if (hf == 1) prev = rl[mt][gi];
        else prev = (gi > 0) ? rl[mt][gi > 0 ? gi - 1 : 0] : (mt > 0 ? rl[mt > 0 ? mt - 1 : 0][3] : 0.f);
        impw[(hh * 64 + ql) * 32 + 8 * mt + 2 * gi + hf] = G[mt][gi] + prev;
      }
  }
  __syncthreads();
  if (tid < 64) {
    float scv[32];
#pragma unroll
    for (int j = 0; j < 32; ++j) {
      float v = impw[(0 * 64 + tid) * 32 + j] + impw[(1 * 64 + tid) * 32 + j] + impw[(2 * 64 + tid) * 32 + j] + impw[(3 * 64 + tid) * 32 + j];
      if (j == 0 || j == qb || j == qb - 1) v += 1000.f;
      scv[j] = (j <= qb) ? v : -1e30f;
    }
    unsigned m = 0u;
#pragma unroll 1
    for (int k = 0; k < 8; ++k) {
      float bv = -1e29f; int best = -1;
#pragma unroll
      for (int j = 0; j < 32; ++j) { bool take = !((m >> j) & 1u) && scv[j] > bv; bv = take ? scv[j] : bv; best = take ? j : best; }
      if (best >= 0) m |= 1u << best;
    }
    selm[tid] = m;
    atomicOr(uni, m);
  }
  __syncthreads();
  const unsigned U = *uni;
  const unsigned sm = selm[ql];
#pragma unroll 1
  for (int mode = 0; mode < 2; ++mode) {
    float mrun = -1e30f, lrun = 0.f;
    f32x16 oacc[2];
#pragma unroll
    for (int i = 0; i < 16; ++i) { oacc[0][i] = 0.f; oacc[1][i] = 0.f; }
    const unsigned tmask = mode ? ((2u << qb) - 1u) & ~((1u << max(0, qb - 8)) - 1u) : U;
    const int r_ld = 32 * (w & 1) + (lane & 31), seg_ld = (w >> 1) * 2 + (lane >> 5);
    const int kcol = C_NKV + (mode ? 4 : 2) * 128 + g * 64 + seg_ld * 8;
    unsigned rem = tmask;
    int j = __ffs(rem) - 1;
    rem &= rem - 1u;
    bf16x8 kreg = ld8(PROJ + ((size_t)b * SEQL + 64 * j + r_ld) * NPJ + kcol);
    bf16x8 vreg = ld8(PROJ + ((size_t)b * SEQL + 64 * j + r_ld) * NPJ + kcol + 128);
    int buf = 0;
#pragma unroll 1
    while (j >= 0) {
      u16* Kb_ = Ks + buf * (2 * 64 * 72);
      u16* Vb_ = Kb_ + 64 * 72;
      *(bf16x8*)(Kb_ + r_ld * 72 + seg_ld * 8) = kreg;
#pragma unroll
      for (int e = 0; e < 8; ++e) Vb_[(seg_ld * 8 + e) * 72 + r_ld] = (u16)vreg[e];
      __syncthreads();
      const int jn = rem ? (__ffs(rem) - 1) : -1;
      rem &= rem - 1u;
      if (jn >= 0) {
        kreg = ld8(PROJ + ((size_t)b * SEQL + 64 * jn + r_ld) * NPJ + kcol);
        vreg = ld8(PROJ + ((size_t)b * SEQL + 64 * jn + r_ld) * NPJ + kcol + 128);
      }
      const bool selj = mode ? true : (((sm >> j) & 1u) != 0u);
      if (mode || __any(selj)) {
        f32x16 st[2];
#pragma unroll
        for (int mt = 0; mt < 2; ++mt) {
#pragma unroll
          for (int i = 0; i < 16; ++i) st[mt][i] = 0.f;
#pragma unroll
          for (int s = 0; s < 4; ++s) st[mt] = mfma32(ld8(Kb_ + (32 * mt + lq5) * 72 + 16 * s + 8 * hf), qf[s], st[mt]);
        }
        const bool need_mask = (j == qb) || (mode && j == qb - 8);
        float mloc = -1e30f;
        if (need_mask) {
#pragma unroll
          for (int mt = 0; mt < 2; ++mt)
#pragma unroll
            for (int i = 0; i < 16; ++i) {
              const int dist = tpos - (64 * j + 32 * mt + crow(i, hf));
              const bool ok = selj && dist >= 0 && dist < 512;
              st[mt][i] = ok ? st[mt][i] : -1e30f;
              mloc = fmaxf(mloc, st[mt][i]);
            }
        } else {
#pragma unroll
          for (int mt = 0; mt < 2; ++mt)
#pragma unroll
            for (int i = 0; i < 16; ++i) mloc = fmaxf(mloc, st[mt][i]);
          mloc = selj ? mloc : -1e30f;
        }
        mloc = fmaxf(mloc, __shfl_xor(mloc, 32));
        const float mnew = fmaxf(mrun, mloc);
        const float alpha = __expf(mrun - mnew);
        const bool live = selj && (mnew > -1e29f);
        float psum = 0.f;
#pragma unroll
        for (int mt = 0; mt < 2; ++mt)
#pragma unroll
          for (int i = 0; i < 16; ++i) {
            float pv = __expf(st[mt][i] - mnew);
            pv = live ? pv : 0.f;
            st[mt][i] = pv; psum += pv;
          }
        lrun = lrun * alpha + psum;
        mrun = mnew;
#pragma unroll
        for (int i = 0; i < 16; ++i) { oacc[0][i] *= alpha; oacc[1][i] *= alpha; }
#pragma unroll
        for (int mt = 0; mt < 2; ++mt)
#pragma unroll
          for (int s = 0; s < 2; ++s) {
            bf16x8 pf = pack8(st[mt], s);
#pragma unroll
            for (int dt = 0; dt < 2; ++dt) {
              const u16* vp = Vb_ + (32 * dt + lq5) * 72 + 32 * mt + 16 * s + 4 * hf;
              s16x4 lo = ld4(vp), hi = ld4(vp + 8);
              bf16x8 vf = __builtin_shufflevector(lo, hi, 0, 1, 2, 3, 4, 5, 6, 7);
              oacc[dt] = mfma32(vf, pf, oacc[dt]);
            }
          }
      }
      buf ^= 1;
      j = jn;
    }
    const float ltot = lrun + __shfl_xor(lrun, 32);
    const float sc_ = (ltot > 0.f) ? gate[1 + mode] / ltot : 0.f;
#pragma unroll
    for (int i = 0; i < 16; ++i) { ofin[0][i] += sc_ * oacc[0][i]; ofin[1][i] += sc_ * oacc[1][i]; }
    __syncthreads();
  }
#pragma unroll
  for (int dt = 0; dt < 2; ++dt)
#pragma unroll
    for (int g4 = 0; g4 < 4; ++g4)
      *(s16x4*)(PROJ + row * NPJ + C_NQ + head * 64 + 32 * dt + 8 * g4 + 4 * hf) =
          pack4(ofin[dt][4 * g4], ofin[dt][4 * g4 + 1], ofin[dt][4 * g4 + 2], ofin[dt][4 * g4 + 3]);
  __syncthreads();
}

static __device__ __attribute__((always_inline)) inline void phase_merge(const Params& p) {
  char* ws = lsp(p.ws);
  u16* H = (u16*)(ws + OFF_H); u16* WinT = (u16*)(ws + OFF_WBIG); u16* PROJ = (u16*)(ws + OFF_PROJ);
  u16* WbrT = (u16*)(ws + OFF_WBR); u16* M = (u16*)(ws + OFF_SCR);
  const int nM = 64, nN = 4;
  for (int t = blockIdx.x; t < nM * nN; t += gridDim.x) {
    int pm, pn; tile_map(t, nM, nN, pm, pn);
#pragma unroll 1
    for (int i = 0; i < 3; ++i) {
      const int boff = 5120 + i * 1024 + pn * 256;
      gemm_tile(H, 1024, WinT, 1024, 1024, pm * 256, boff, [&](int idx, int row, int col, f32x4 v) {
        *(s16x4*)(PROJ + (size_t)row * NPJ + C_SK + (col - 5120 - i * 1024)) = pack4(sigmoidf_(v[0]), sigmoidf_(v[1]), sigmoidf_(v[2]), sigmoidf_(v[3]));
      });
      const int ycol = (i == 0) ? C_GV : (i == 1 ? C_NQ : C_SQ);
      s16x4 gbuf[2], mbuf[2];
      gemm_tile(PROJ + ycol, NPJ, WbrT + (size_t)i * 1024 * 512, 512, 512, pm * 256, pn * 256, [&](int idx, int row, int col, f32x4 v) {
        const s16x4 gte = gbuf[idx];
        float o0 = bfs(gte[0]) * v[0], o1 = bfs(gte[1]) * v[1], o2 = bfs(gte[2]) * v[2], o3 = bfs(gte[3]) * v[3];
        if (i > 0) { const s16x4 pv = mbuf[idx]; o0 += bfs(pv[0]); o1 += bfs(pv[1]); o2 += bfs(pv[2]); o3 += bfs(pv[3]); }
        *(s16x4*)(M + (unsigned)(row * 1024 + col)) = pack4(o0, o1, o2, o3);
      }, [&](int idx, int row, int col) {
        gbuf[idx] = ld4(PROJ + (unsigned)(row * NPJ + C_SK + col));
        if (i > 0) mbuf[idx] = ld4(M + (unsigned)(row * 1024 + col));
      });
    }
  }
}

template <int MODE>
static __device__ __attribute__((always_inline)) inline void phase_gemm(const u16* A, int lda, const u16* Bt, int ldb, int K, int nM, int nN, u16* C, int ldc) {
  for (int t = blockIdx.x; t < nM * nN; t += gridDim.x) {
    int pm, pn; tile_map(t, nM, nN, pm, pn);
    gemm_tile(A, lda, Bt, ldb, K, pm * 256, pn * 256, [&](int idx, int row, int col, f32x4 v) {
      if (MODE == 1) {
#pragma unroll
        for (int q = 0; q < 4; ++q) { float t = fmaxf(v[q], 0.f); v[q] = t * t; }
      }
      *(s16x4*)(C + (size_t)row * ldc + col) = pack4(v[0], v[1], v[2], v[3]);
    });
  }
}


#define XB_TMO      128
#define XB_XCNT(j)  (256  + 64 * (j))
#define XB_XSUB(j)  (1280 + 64 * (j))
#define XB_XGEN(j)  (2304 + 64 * (j))
#define XB_TOP      3328
#define XB_TOPGEN   3392
#define XCD_BAR_WORDS 3456
#define XB_SPIN_CAP (1u << 18)
#define LAS __attribute__((address_space(3)))
DI unsigned xb_ld(unsigned* q)              { return __hip_atomic_load(q, __ATOMIC_RELAXED, __HIP_MEMORY_SCOPE_AGENT); }
DI unsigned xb_add(unsigned* q, unsigned v) { return __hip_atomic_fetch_add(q, v, __ATOMIC_RELAXED, __HIP_MEMORY_SCOPE_AGENT); }
DI unsigned xb_xcc_id() { return (unsigned)__builtin_amdgcn_s_getreg((3 << 11) | 20) & 0xFu; }
#define XB_SPIN(cond, bar) do { unsigned _sp = 0; while (cond) { __builtin_amdgcn_s_sleep(1); \
    if ((++_sp & 255u) == 0u) { if (xb_ld(&(bar)[XB_TMO])) break; if (_sp > XB_SPIN_CAP) { atomicAdd(&(bar)[XB_TMO], 1u); break; } } } } while (0)
struct XcdBarrier { unsigned* bar; unsigned x; volatile LAS unsigned* st; };
DI XcdBarrier xcd_barrier_post(unsigned* bar, volatile LAS unsigned* st) {
  XcdBarrier b; b.bar = bar; b.x = xb_xcc_id(); b.st = st;
  if (threadIdx.x == 0) (void)xb_add(&bar[XB_XCNT(b.x)], 1u);
  return b;
}
DI void xcd_barrier_complete(unsigned* bar, unsigned x, unsigned& nloc, unsigned& nx) {
  const unsigned G = gridDim.x * gridDim.y * gridDim.z;
  unsigned sum, cnt, mine, sp = 0u;
  for (;;) {
    sum = 0u; cnt = 0u; mine = 0u;
#pragma unroll
    for (unsigned j = 0; j < 16; ++j) { const unsigned c = xb_ld(&bar[XB_XCNT(j)]); sum += c; cnt += (c > 0u) ? 1u : 0u; mine = (j == x) ? c : mine; }
    if (sum == G) break;
    __builtin_amdgcn_s_sleep(1);
    if ((++sp & 255u) == 0u) { if (xb_ld(&bar[XB_TMO])) break; if (sp > XB_SPIN_CAP) { atomicAdd(&bar[XB_TMO], 1u); break; } }
  }
  nloc = mine > 0u ? mine : 1u; nx = cnt > 0u ? cnt : 1u;
}
DI void xcd_barrier(const XcdBarrier& b) {
  asm volatile("s_waitcnt vmcnt(0)" ::: "memory");
  __syncthreads();
  if (threadIdx.x == 0) {
    unsigned* bar = b.bar;
    __builtin_amdgcn_s_waitcnt(0);
    unsigned nloc = b.st[0], nx = b.st[1];
    if (nloc == 0u) { xcd_barrier_complete(bar, b.x, nloc, nx); b.st[0] = nloc; b.st[1] = nx; }
    const unsigned old = xb_add(&bar[XB_XSUB(b.x)], 1u);
    const unsigned gen = old / nloc;
    if (old + 1u == (gen + 1u) * nloc) {
      __builtin_amdgcn_fence(__ATOMIC_RELEASE, "agent");
      asm volatile("s_waitcnt vmcnt(0)" ::: "memory");
      const unsigned og = xb_add(&bar[XB_TOP], 1u);
      const unsigned tg = og / nx;
      if (og + 1u == (tg + 1u) * nx) xb_add(&bar[XB_TOPGEN], 1u);
      else XB_SPIN(xb_ld(&bar[XB_TOPGEN]) == tg, bar);
      __builtin_amdgcn_fence(__ATOMIC_ACQUIRE, "agent");
      xb_add(&bar[XB_XGEN(b.x)], 1u);
      asm volatile("s_waitcnt vmcnt(0)" ::: "memory");
    } else {
      XB_SPIN(xb_ld(&bar[XB_XGEN(b.x)]) == gen, bar);
      __builtin_amdgcn_fence(__ATOMIC_ACQUIRE, "agent");
      asm volatile("s_waitcnt vmcnt(0)" ::: "memory");
    }
  }
  __syncthreads();
}

__global__ void __launch_bounds__(512) fwd_megakernel(Params p_unused) {
#define p (kp())
  cg::grid_group grid = cg::this_grid();
  volatile LAS unsigned* xst = (volatile LAS unsigned*)((LAS char*)g_shm + LDS_XST);
  if (threadIdx.x == 0) { xst[0] = 0u; xst[1] = 0u; }
  __syncthreads();
  (void)xcd_barrier_post((unsigned*)(lsp(p.ws) + OFF_BAR), xst);
#define GSYNC() do { XcdBarrier xb_; xb_.bar = (unsigned*)(lsp(p.ws) + OFF_BAR); unsigned xx_ = xb_xcc_id(); asm volatile("" : "+s"(xx_)); xb_.x = xx_; \
    xb_.st = (volatile LAS unsigned*)((LAS char*)g_shm + LDS_XST); xcd_barrier(xb_); } while (0)
#define WSP(off) ((u16*)(lsp(p.ws) + (off)))
  phase_norm(p.x, nullptr, nullptr, p.g_mix_pre, nullptr, WSP(OFF_H));
  convert_mixer_weights(p, 0);
  if (p.ws == nullptr) grid.sync();
  GSYNC();
#pragma unroll 1
  for (int l = 0; l < 2; ++l) {
    phase_inproj(p);
    GSYNC();
    {
      volatile LAS int* qslot = (volatile LAS int*)((LAS char*)g_shm + LDS_XST + 16);
#pragma unroll 1
      for (;;) {
        if (threadIdx.x == 0) *qslot = (int)atomicAdd((unsigned*)(lsp(p.ws) + OFF_QCTR) + l * 64 + 32, 1u);
        __syncthreads();
        const int it = *qslot;
        __syncthreads();
        if (it >= 1152) break;
        if (it < 128) nsa_compress(p, l, it);
        else gdn_prep(p, l, it - 128);
      }
    }
    GSYNC();
    if (blockIdx.x < 32) gdn_scan(p, l, blockIdx.x);
    {
      volatile LAS int* qslot = (volatile LAS int*)((LAS char*)g_shm + LDS_XST + 16);
#pragma unroll 1
      for (;;) {
        if (threadIdx.x == 0) *qslot = (int)atomicAdd((unsigned*)(lsp(p.ws) + OFF_QCTR) + l * 64, 1u);
        __syncthreads();
        const int it = *qslot;
        __syncthreads();
        if (it >= 768) break;
        if (it < 192) nsa_attn(p, it);
        else if (it < 448) { sb_attn_wave(p, (it - 192) * 8 + (lv(threadIdx.x) >> 6)); __syncthreads(); }
        else nsa_attn(p, it - 256);
      }
    }
    GSYNC();
    phase_merge(p);
    GSYNC();
    phase_gemm<0>(WSP(OFF_SCR), 1024, WSP(OFF_WOUT), 1024, 1024, 64, 4, WSP(OFF_H), 1024);
    GSYNC();
    phase_norm(l == 0 ? p.x : p.out, WSP(OFF_H), p.g_mix_post + l * 1024, p.g_ff_pre + l * 1024, p.out, WSP(OFF_H));
    convert_ffn_weights(p, l);
    GSYNC();
    phase_gemm<1>(WSP(OFF_H), 1024, WSP(OFF_WBIG), 1024, 1024, 64, 16, WSP(OFF_PROJ), 4096);
    GSYNC();
    phase_gemm<0>(WSP(OFF_PROJ), 4096, WSP(OFF_WBIG) + (size_t)4096 * 1024, 4096, 4096, 64, 4, WSP(OFF_SCR), 1024);
    GSYNC();
    phase_norm(p.out, WSP(OFF_SCR), p.g_ff_post + l * 1024, (l == 0) ? p.g_mix_pre + 1024 : nullptr, p.out, WSP(OFF_H));
    if (l == 0) { convert_mixer_weights(p, 1); GSYNC(); }
  }
}
#undef p

extern "C" void kernel_launch(void* const* d_in, const int* in_sizes, int n_in, void* d_out, int out_size, void* d_ws,
                              size_t ws_size, hipStream_t stream) {
  static int grid_blocks = 0;
  if (!grid_blocks) {
    int dev = 0, cus = 0, per_cu = 0;
    (void)hipGetDevice(&dev);
    (void)hipDeviceGetAttribute(&cus, hipDeviceAttributeMultiprocessorCount, dev);
    (void)hipFuncSetAttribute((const void*)fwd_megakernel, hipFuncAttributeMaxDynamicSharedMemorySize, LDS_BYTES);
    (void)hipOccupancyMaxActiveBlocksPerMultiprocessor(&per_cu, (const void*)fwd_megakernel, 512, LDS_BYTES);
    if (per_cu < 1) per_cu = 1;
    grid_blocks = cus * 1;
    if (ws_size < WS_NEED) fprintf(stderr, "workspace too small: %zu < %zu\n", ws_size, (size_t)WS_NEED);
  }
  Params p{};
  p.x = (const float*)d_in[0]; p.g_mix_pre = (const float*)d_in[1]; p.g_mix_post = (const float*)d_in[2];
  p.g_ff_pre = (const float*)d_in[3]; p.g_ff_post = (const float*)d_in[4]; p.w_in = (const float*)d_in[5];
  p.conv_w = (const float*)d_in[6]; p.a_log = (const float*)d_in[7]; p.dt_bias = (const float*)d_in[8];
  p.norm_g = (const float*)d_in[9]; p.cmp_wk = (const float*)d_in[10]; p.cmp_pk = (const float*)d_in[11];
  p.cmp_wv = (const float*)d_in[12]; p.cmp_pv = (const float*)d_in[13]; p.w_br0 = (const float*)d_in[14];
  p.w_br1 = (const float*)d_in[15]; p.w_br2 = (const float*)d_in[16]; p.w_out = (const float*)d_in[17];
  p.w_ff1 = (const float*)d_in[18]; p.w_ff2 = (const float*)d_in[19];
  p.out = (float*)d_out; p.ws = (char*)d_ws;
  (void)hipMemsetAsync((char*)d_ws + OFF_BAR, 0, 16384, stream);
  void* args[] = {&p};
  hipError_t e = hipLaunchCooperativeKernel((const void*)fwd_megakernel, dim3(grid_blocks), dim3(512), args, LDS_BYTES, stream);
  if (e != hipSuccess) fprintf(stderr, "cooperative launch failed: %s (grid %d)\n", hipGetErrorString(e), grid_blocks);
}
```

```cpp
#include <hip/hip_runtime.h>
#include <hip/hip_bf16.h>
#include <hip/hip_cooperative_groups.h>
#include <cstdio>
namespace cg = cooperative_groups;

typedef unsigned short u16;
using bf16x8 = __attribute__((ext_vector_type(8))) short;
using s16x4  = __attribute__((ext_vector_type(4))) short;
using f32x4  = __attribute__((ext_vector_type(4))) float;
using f32x16 = __attribute__((ext_vector_type(16))) float;
#define DI __device__ __forceinline__

constexpr int T_TOK = 16384, SEQL = 2048;
constexpr int NPJ = 4896;
constexpr int N_IN = 7968;
constexpr int C_GQ = 0, C_GK = 512, C_GV = 1024, C_GZ = 1536, C_GA = 2048, C_GB = 2052, C_NQ = 2056, C_NKV = 2568,
              C_NG = 3336, C_SQ = 3360, C_SK = 3872;
constexpr size_t OFF_WBR  = 0;
constexpr size_t OFF_WOUT = 3145728;
constexpr size_t OFF_WBIG = 5242880;
constexpr size_t OFF_PROJ = 22020096;
constexpr size_t OFF_SCR  = OFF_PROJ + 160432128;
constexpr size_t OFF_H    = OFF_SCR + 33554432;
constexpr size_t OFF_HALO = OFF_H + 33554432;
constexpr size_t OFF_KC   = OFF_HALO + 2359296;
constexpr size_t OFF_VCT  = OFF_KC + 262144;
constexpr size_t OFF_EGL  = OFF_VCT + 262144;
constexpr size_t OFF_WT   = OFF_EGL + 4096;
constexpr size_t OFF_CB   = OFF_WT + 524288;
constexpr size_t OFF_BAR  = OFF_CB + 512;
constexpr size_t OFF_QCTR = OFF_BAR + 14336;
constexpr size_t WS_NEED  = OFF_BAR + 16384;
constexpr int LDS_XST = 155648;
constexpr int LDS_BYTES = LDS_XST + 32;

struct Params {
  const float* x; const float* g_mix_pre; const float* g_mix_post; const float* g_ff_pre; const float* g_ff_post;
  const float* w_in; const float* conv_w; const float* a_log; const float* dt_bias; const float* norm_g;
  const float* cmp_wk; const float* cmp_pk; const float* cmp_wv; const float* cmp_pv;
  const float* w_br0; const float* w_br1; const float* w_br2; const float* w_out; const float* w_ff1; const float* w_ff2;
  float* out; char* ws;
};

extern __shared__ __attribute__((aligned(16))) char g_shm[];

typedef __bf16 bf2_t __attribute__((ext_vector_type(2)));
typedef float f2_t __attribute__((ext_vector_type(2)));
typedef unsigned u32x2 __attribute__((ext_vector_type(2)));
typedef unsigned u32x4 __attribute__((ext_vector_type(4)));
DI unsigned cvt2(float a, float b) { f2_t v; v[0] = a; v[1] = b; return __builtin_bit_cast(unsigned, __builtin_convertvector(v, bf2_t)); }
DI u16 f2bf(float x) { return (u16)(cvt2(x, x) & 0xffffu); }
DI float bf2f(u16 b) { return __uint_as_float(((unsigned)b) << 16); }
DI float bfs(short b) { return __uint_as_float(((unsigned)(u16)b) << 16); }
DI bf16x8 ld8(const u16* p) { return *(const bf16x8*)p; }
DI s16x4 ld4(const u16* p) { return *(const s16x4*)p; }
DI f32x4 mfma16(bf16x8 a, bf16x8 b, f32x4 c) { return __builtin_amdgcn_mfma_f32_16x16x32_bf16(a, b, c, 0, 0, 0); }
DI f32x16 mfma32(bf16x8 a, bf16x8 b, f32x16 c) { return __builtin_amdgcn_mfma_f32_32x32x16_bf16(a, b, c, 0, 0, 0); }
DI s16x4 pack4(float a, float b, float c, float d) { u32x2 r; r[0] = cvt2(a, b); r[1] = cvt2(c, d); return __builtin_bit_cast(s16x4, r); }
DI float sigmoidf_(float x) { return 1.f / (1.f + __expf(-x)); }
DI float softplusf_(float x) { return fmaxf(x, 0.f) + log1pf(__expf(-fabsf(x))); }
DI int lv(int v) { asm volatile("" : "+v"(v)); return v; }
DI char* lsp(char* q) { auto g = (__attribute__((address_space(1))) char*)q; asm volatile("" : "+s"(g)); return (char*)g; }
typedef const __attribute__((address_space(4))) Params* kparg_t;
#if defined(__HIP_DEVICE_COMPILE__)
DI Params kp() { kparg_t q = (kparg_t)__builtin_amdgcn_kernarg_segment_ptr(); asm volatile("" : "+s"(q)); return *q; }
#else
DI Params kp() { return Params{}; }
#endif
DI char* lds_base() { auto q = (__attribute__((address_space(3))) char*)g_shm; asm volatile("" : "+v"(q)); return (char*)q; }
DI void lds_barrier() { asm volatile("s_waitcnt lgkmcnt(0)" ::: "memory"); __builtin_amdgcn_s_barrier(); asm volatile("" ::: "memory"); }
DI int crow(int i, int h) { return (i & 3) + 8 * (i >> 2) + 4 * h; }
DI bf16x8 pack8(const f32x16& x, int s) {
  u32x4 r;
  r[0] = cvt2(x[8 * s + 0], x[8 * s + 1]); r[1] = cvt2(x[8 * s + 2], x[8 * s + 3]);
  r[2] = cvt2(x[8 * s + 4], x[8 * s + 5]); r[3] = cvt2(x[8 * s + 6], x[8 * s + 7]);
  return __builtin_bit_cast(bf16x8, r);
}

static __device__ __attribute__((always_inline)) inline void convert_weight(const float* W, int K, int N, u16* out, int ldo, bool winmap) {
  float* lds = (float*)lds_base();
  const int tid = lv(threadIdx.x);
  const int nkt = K / 64, nnt = (N + 127) / 128, ntiles = nkt * nnt;
  f32x4 v[4];
#define CW_LOAD(T) do { const int kt_ = (T) % nkt, nt_ = (T) / nkt; \
    _Pragma("unroll") for (int q = 0; q < 4; ++q) { const int e = tid + q * 512, kk = e >> 5, n = nt_ * 128 + (e & 31) * 4; \
      v[q] = f32x4{0.f, 0.f, 0.f, 0.f}; if (n < N) v[q] = *(const f32x4*)(W + (size_t)(kt_ * 64 + kk) * N + n); } } while (0)
  int t = blockIdx.x;
  if (t < ntiles) CW_LOAD(t);
  for (; t < ntiles; t += gridDim.x) {
    const int kt = t % nkt, nt = t / nkt, k0 = kt * 64, n0 = nt * 128;
#pragma unroll
    for (int q = 0; q < 4; ++q) {
      const int e = tid + q * 512, kk = e >> 5, nn = (e & 31) * 4;
      lds[kk * 129 + nn + 0] = v[q][0]; lds[kk * 129 + nn + 1] = v[q][1]; lds[kk * 129 + nn + 2] = v[q][2]; lds[kk * 129 + nn + 3] = v[q][3];
    }
    lds_barrier();
    if (t + (int)gridDim.x < ntiles) CW_LOAD(t + (int)gridDim.x);
#pragma unroll
    for (int rep = 0; rep < 2; ++rep) {
      const int nn = (tid >> 3) + 64 * rep, ks = tid & 7, n = n0 + nn;
      if (n < N) {
        const int orow = winmap ? (n < NPJ ? n : n + 224) : n;
        u32x4 o;
#pragma unroll
        for (int e = 0; e < 4; ++e) o[e] = cvt2(lds[(ks * 8 + 2 * e) * 129 + nn], lds[(ks * 8 + 2 * e + 1) * 129 + nn]);
        *(u32x4*)(out + (size_t)orow * ldo + k0 + ks * 8) = o;
      }
    }
    lds_barrier();
  }
#undef CW_LOAD
  __syncthreads();
}

static __device__ __attribute__((always_inline)) inline void convert_mixer_weights(const Params& p, int l) {
  char* ws = lsp(p.ws);
  convert_weight(p.w_in + (size_t)l * 1024 * N_IN, 1024, N_IN, (u16*)(ws + OFF_WBIG), 1024, true);
  convert_weight(p.w_br0 + (size_t)l * 512 * 1024, 512, 1024, (u16*)(ws + OFF_WBR), 512, false);
  convert_weight(p.w_br1 + (size_t)l * 512 * 1024, 512, 1024, (u16*)(ws + OFF_WBR) + 1024 * 512, 512, false);
  convert_weight(p.w_br2 + (size_t)l * 512 * 1024, 512, 1024, (u16*)(ws + OFF_WBR) + 2 * 1024 * 512, 512, false);
  convert_weight(p.w_out + (size_t)l * 1024 * 1024, 1024, 1024, (u16*)(ws + OFF_WOUT), 1024, false);
  convert_weight(p.cmp_wk + (size_t)l * 131072, 2048, 64, (u16*)(ws + OFF_WT), 2048, false);
  convert_weight(p.cmp_wv + (size_t)l * 131072, 2048, 64, (u16*)(ws + OFF_WT) + 64 * 2048, 2048, false);
  if (blockIdx.x < 2) {
    const int kv = blockIdx.x, tid = lv(threadIdx.x), e = tid & 63, part = tid >> 6;
    const float* W = (kv ? p.cmp_wv : p.cmp_wk) + (size_t)l * 131072;
    const float* pp = (kv ? p.cmp_pv : p.cmp_pk) + (size_t)l * 2048;
    float* red = (float*)lds_base();
    float sacc = 0.f;
    for (int k = part * 256; k < part * 256 + 256; ++k) sacc += pp[k] * W[k * 64 + e];
    red[part * 64 + e] = sacc;
    __syncthreads();
    if (tid < 64) { float t = 0.f; for (int q = 0; q < 8; ++q) t += red[q * 64 + tid]; ((float*)(ws + OFF_CB))[kv * 64 + tid] = t; }
    __syncthreads();
  }
}
static __device__ __attribute__((always_inline)) inline void convert_ffn_weights(const Params& p, int l) {
  char* ws = lsp(p.ws);
  convert_weight(p.w_ff1 + (size_t)l * 1024 * 4096, 1024, 4096, (u16*)(ws + OFF_WBIG), 1024, false);
  convert_weight(p.w_ff2 + (size_t)l * 4096 * 1024, 4096, 1024, (u16*)(ws + OFF_WBIG) + (size_t)4096 * 1024, 4096, false);
}

DI float wave_sum(float v) {
#pragma unroll
  for (int o = 32; o > 0; o >>= 1) v += __shfl_xor(v, o);
  return v;
}
static __device__ __attribute__((always_inline)) inline void phase_norm(const float* xin, const u16* y, const float* g_post, const float* g_next, float* xout, u16* H) {
  const int tidn = lv(threadIdx.x);
  const int wave = tidn >> 6, lane = tidn & 63;
  for (int row0 = (blockIdx.x * 8 + wave) * 2; row0 < T_TOK; row0 += gridDim.x * 16) {
    float xv[2][16], yv[2][16];
#pragma unroll
    for (int rr = 0; rr < 2; ++rr)
#pragma unroll
      for (int i = 0; i < 4; ++i) {
        f32x4 t = *(const f32x4*)(xin + (size_t)(row0 + rr) * 1024 + i * 256 + lane * 4);
        xv[rr][i * 4 + 0] = t[0]; xv[rr][i * 4 + 1] = t[1]; xv[rr][i * 4 + 2] = t[2]; xv[rr][i * 4 + 3] = t[3];
      }
    if (y) {
      float ss[2] = {0.f, 0.f};
#pragma unroll
      for (int rr = 0; rr < 2; ++rr)
#pragma unroll
        for (int i = 0; i < 4; ++i) {
          s16x4 t = ld4(y + (size_t)(row0 + rr) * 1024 + i * 256 + lane * 4);
#pragma unroll
          for (int e = 0; e < 4; ++e) { yv[rr][i * 4 + e] = bfs(t[e]); ss[rr] += yv[rr][i * 4 + e] * yv[rr][i * 4 + e]; }
        }
#pragma unroll
      for (int o = 32; o > 0; o >>= 1) { float t0 = __shfl_xor(ss[0], o), t1 = __shfl_xor(ss[1], o); ss[0] += t0; ss[1] += t1; }
#pragma unroll
      for (int rr = 0; rr < 2; ++rr) {
        const float r = rsqrtf(ss[rr] * (1.f / 1024.f) + 1e-6f);
#pragma unroll
        for (int i = 0; i < 4; ++i) {
          f32x4 g = *(const f32x4*)(g_post + i * 256 + lane * 4);
          f32x4 o;
#pragma unroll
          for (int e = 0; e < 4; ++e) { xv[rr][i * 4 + e] += yv[rr][i * 4 + e] * r * g[e]; o[e] = xv[rr][i * 4 + e]; }
          *(f32x4*)(xout + (size_t)(row0 + rr) * 1024 + i * 256 + lane * 4) = o;
        }
      }
    }
    if (g_next) {
      float ss[2] = {0.f, 0.f};
#pragma unroll
      for (int rr = 0; rr < 2; ++rr)
#pragma unroll
        for (int i = 0; i < 16; ++i) ss[rr] += xv[rr][i] * xv[rr][i];
#pragma unroll
      for (int o = 32; o > 0; o >>= 1) { float t0 = __shfl_xor(ss[0], o), t1 = __shfl_xor(ss[1], o); ss[0] += t0; ss[1] += t1; }
#pragma unroll
      for (int rr = 0; rr < 2; ++rr) {
        const float r = rsqrtf(ss[rr] * (1.f / 1024.f) + 1e-6f);
#pragma unroll
        for (int i = 0; i < 4; ++i) {
          f32x4 g = *(const f32x4*)(g_next + i * 256 + lane * 4);
          *(s16x4*)(H + (size_t)(row0 + rr) * 1024 + i * 256 + lane * 4) =
              pack4(xv[rr][i * 4] * r * g[0], xv[rr][i * 4 + 1] * r * g[1], xv[rr][i * 4 + 2] * r * g[2], xv[rr][i * 4 + 3] * r * g[3]);
        }
      }
    }
  }
}

constexpr int BM = 256, BK = 64, HALF = 128, HT = HALF * BK;
DI int lds_byte(int r, int c) {
  int st = (r >> 4) * 2 + (c >> 5), rr = r & 15, cc = c & 31, ob = rr * 64 + cc * 2;
  return st * 1024 + (ob ^ (((ob >> 9) & 1) << 5));
}
DI void stage_rc(int b, int& R, int& C) {
  int st = b / 1024, sb = b % 1024, swz = sb ^ (((sb >> 9) & 1) << 5);
  R = (st >> 1) * 16 + swz / 64; C = (st & 1) * 32 + (swz % 64) / 2;
}
DI void tile_map(int wgid, int nM, int nN, int& pm, int& pn) {
  const int NXCD = 8, WGM = 8;
  int nwg = nM * nN;
  { int q = nwg / NXCD, r = nwg % NXCD, xcd = wgid % NXCD, off = wgid / NXCD;
    wgid = (xcd < r ? xcd * (q + 1) : r * (q + 1) + (xcd - r) * q) + off; }
  int nig = WGM * nN, gid = wgid / nig, fm = gid * WGM, gsz = min(nM - fm, WGM);
  pm = fm + ((wgid % nig) % gsz); pn = (wgid % nig) / gsz;
}

struct NoPre { DI void operator()(int, int, int) const {} };
template <class Epi, class Pre = NoPre>
DI void gemm_tile(const u16* A, int lda, const u16* Bt, int ldb, int K, int brow, int bcol, Epi epi, Pre pre = Pre()) {
  u16* shm = (u16*)g_shm;
#define SA(b, h) (shm + ((b) * 2 + (h)) * HT)
#define SB(b, h) (shm + (4 + (b) * 2 + (h)) * HT)
#define STAGE(P, BASE, LD, br, kt) do { const char* _gb = (const char*)((BASE) + (size_t)(br) * (LD) + (size_t)(kt) * BK); \
    for (int _i = 0; _i < 2; ++_i) { int _b = tidx * 16 + _i * 8192; \
      __builtin_amdgcn_global_load_lds((const unsigned*)(_gb + (((LD) == lda) ? offA[_i] : offB[_i])), \
        (__attribute__((address_space(3))) unsigned*)((char*)(P) + _b), 16, 0, 0); } } while (0)
#define LDA(dst, b, h) for (int m = 0; m < 4; ++m) for (int k = 0; k < 2; ++k) \
    dst[m][k] = *reinterpret_cast<const bf16x8*>((char*)SA(b, h) + lds_byte(wr * 64 + m * 16 + fr, k * 32 + fq * 8))
#define LDB(dst, b, h) for (int n = 0; n < 2; ++n) for (int k = 0; k < 2; ++k) \
    dst[n][k] = *reinterpret_cast<const bf16x8*>((char*)SB(b, h) + lds_byte(wc * 32 + n * 16 + fr, k * 32 + fq * 8))
#define MMA(ai, bj, At_, Bt_) do { __builtin_amdgcn_s_setprio(1); \
    for (int m = 0; m < 4; ++m) for (int n = 0; n < 2; ++n) for (int k = 0; k < 2; ++k) \
      acc[ai][bj][m][n] = __builtin_amdgcn_mfma_f32_16x16x32_bf16(Bt_[n][k], At_[m][k], acc[ai][bj][m][n], 0, 0, 0); \
    __builtin_amdgcn_s_setprio(0); } while (0)
#define WAIT_V(n) asm volatile("s_waitcnt vmcnt(" #n ")" ::: "memory")
#define WAIT_L(n) asm volatile("s_waitcnt lgkmcnt(" #n ")" ::: "memory")
#define BAR __builtin_amdgcn_s_barrier()
#define SCHED __builtin_amdgcn_sched_barrier(0)
  int tidx = threadIdx.x; asm volatile("" : "+v"(tidx));
  const int wid = tidx >> 6, lane = tidx & 63, wr = wid >> 2, wc = wid & 3, fr = lane & 15, fq = lane >> 4;
  unsigned offA[2], offB[2];
#pragma unroll
  for (int _i = 0; _i < 2; ++_i) { int _r, _c; stage_rc(tidx * 16 + _i * 8192, _r, _c); offA[_i] = (unsigned)(_r * lda + _c) * 2u; offB[_i] = (unsigned)(_r * ldb + _c) * 2u; }
  f32x4 acc[2][2][4][2] = {};
  bf16x8 At[4][2], B0[2][2], B1[2][2];
  const int nt = K / BK;
  STAGE(SB(0, 0), Bt, ldb, bcol, 0); STAGE(SA(0, 0), A, lda, brow, 0);
  STAGE(SB(0, 1), Bt, ldb, bcol + HALF, 0); STAGE(SA(0, 1), A, lda, brow + HALF, 0);
  if (wr == 1) BAR;
  WAIT_V(4); BAR;
  STAGE(SB(1, 0), Bt, ldb, bcol, 1); STAGE(SA(1, 0), A, lda, brow, 1); STAGE(SB(1, 1), Bt, ldb, bcol + HALF, 1);
  WAIT_V(6); BAR;
  for (int t = 0; t < nt - 2; t += 2) {
    LDB(B0, 0, 0); SCHED; LDA(At, 0, 0); STAGE(SA(1, 1), A, lda, brow + HALF, t + 1);
    WAIT_L(8); BAR; WAIT_L(0); MMA(0, 0, At, B0); BAR; SCHED;
    LDB(B1, 0, 1); STAGE(SB(0, 0), Bt, ldb, bcol, t + 2);
    BAR; WAIT_L(0); MMA(0, 1, At, B1); BAR;
    LDA(At, 0, 1); STAGE(SA(0, 0), A, lda, brow, t + 2);
    BAR; WAIT_L(0); MMA(1, 0, At, B0); BAR; SCHED;
    STAGE(SB(0, 1), Bt, ldb, bcol + HALF, t + 2);
    WAIT_V(6); BAR; MMA(1, 1, At, B1); BAR;
    LDB(B0, 1, 0); SCHED; LDA(At, 1, 0); STAGE(SA(0, 1), A, lda, brow + HALF, t + 2);
    WAIT_L(8); BAR; WAIT_L(0); MMA(0, 0, At, B0); BAR; SCHED;
    LDB(B1, 1, 1); STAGE(SB(1, 0), Bt, ldb, bcol, t + 3);
    BAR; WAIT_L(0); MMA(0, 1, At, B1); BAR;
    LDA(At, 1, 1); STAGE(SA(1, 0), A, lda, brow, t + 3);
    BAR; WAIT_L(0); MMA(1, 0, At, B0); BAR; SCHED;
    STAGE(SB(1, 1), Bt, ldb, bcol + HALF, t + 3);
    WAIT_V(6); BAR; MMA(1, 1, At, B1); BAR;
  }
  { LDB(B0, 0, 0); LDA(At, 0, 0); STAGE(SA(1, 1), A, lda, brow + HALF, nt - 1);
    BAR; WAIT_L(0); MMA(0, 0, At, B0); BAR;
    LDB(B1, 0, 1); BAR; WAIT_L(0); MMA(0, 1, At, B1); BAR;
    LDA(At, 0, 1); WAIT_V(4); BAR; WAIT_L(0); MMA(1, 0, At, B0); MMA(1, 1, At, B1); BAR; }
  { LDB(B0, 1, 0); LDA(At, 1, 0); WAIT_V(2); BAR; WAIT_L(0); MMA(0, 0, At, B0); BAR;
    LDB(B1, 1, 1); WAIT_V(0); BAR; WAIT_L(0); MMA(0, 1, At, B1); BAR;
    LDA(At, 1, 1); BAR; WAIT_L(0); MMA(1, 0, At, B0); MMA(1, 1, At, B1); BAR; }
  if (wr == 0) BAR;
  int tid2 = tidx; asm volatile("" : "+v"(tid2));
  const int wid2 = tid2 >> 6, lane2 = tid2 & 63, wr2 = wid2 >> 2, wc2 = wid2 & 3, fr2 = lane2 & 15, fq2 = lane2 >> 4;
#pragma unroll
  for (int ai = 0; ai < 2; ++ai)
#pragma unroll
    for (int bj = 0; bj < 2; ++bj)
#pragma unroll
      for (int m = 0; m < 4; ++m) {
#pragma unroll
        for (int n = 0; n < 2; ++n)
          pre(n, brow + ai * HALF + wr2 * 64 + m * 16 + fr2, bcol + bj * HALF + wc2 * 32 + n * 16 + fq2 * 4);
#pragma unroll
        for (int n = 0; n < 2; ++n)
          epi(n, brow + ai * HALF + wr2 * 64 + m * 16 + fr2, bcol + bj * HALF + wc2 * 32 + n * 16 + fq2 * 4, acc[ai][bj][m][n]);
      }
  __syncthreads();
#undef SA
#undef SB
#undef STAGE
#undef LDA
#undef LDB
#undef MMA
}

static __device__ __attribute__((always_inline)) inline void phase_inproj(const Params& p) {
  char* ws = lsp(p.ws);
  u16* H = (u16*)(ws + OFF_H); u16* WinT = (u16*)(ws + OFF_WBIG); u16* PROJ = (u16*)(ws + OFF_PROJ);
  u16* HALO = (u16*)(ws + OFF_HALO);
  const int nM = 64, nN = 20;
  for (int t = blockIdx.x; t < nM * nN; t += gridDim.x) {
    int pm, pn; tile_map(t, nM, nN, pm, pn);
    gemm_tile(H, 1024, WinT, 1024, 1024, pm * 256, pn * 256, [&](int idx, int row, int col, f32x4 v) {
      if (col < NPJ) {
        s16x4 b = pack4(v[0], v[1], v[2], v[3]);
        *(s16x4*)(PROJ + (size_t)row * NPJ + col) = b;
        if (col < 1536 && (row & 63) >= 61) *(s16x4*)(HALO + ((size_t)(row >> 6) * 3 + ((row & 63) - 61)) * 1536 + col) = b;
      }
    });
  }
}

static __device__ __attribute__((always_inline)) inline void sb_attn_wave(const Params& p, int witem) {
  u16* PROJ = (u16*)(lsp(p.ws) + OFF_PROJ);
  const int tid = lv(threadIdx.x), lane = tid & 63, w = tid >> 6, lq5 = lane & 31, hf = lane >> 5;
  u16* VT = (u16*)lds_base() + w * (64 * 40);
  const int b = witem >> 8, h = (witem >> 5) & 7, qt = witem & 31;
  const int t0 = qt * 64;
  bf16x8 qf[2][4];
#pragma unroll
  for (int qi = 0; qi < 2; ++qi)
#pragma unroll
    for (int s = 0; s < 4; ++s) {
      bf16x8 raw = ld8(PROJ + ((size_t)b * SEQL + t0 + 32 * qi + lq5) * NPJ + C_SQ + h * 64 + 16 * s + 8 * hf);
#pragma unroll
      for (int e = 0; e < 8; ++e) raw[e] = (short)f2bf(bfs(raw[e]) * 0.125f);
      qf[qi][s] = raw;
    }
  f32x16 oacc[2][2];
#pragma unroll
  for (int i = 0; i < 16; ++i) { oacc[0][0][i] = 0.f; oacc[0][1][i] = 0.f; oacc[1][0][i] = 0.f; oacc[1][1][i] = 0.f; }
  float carry[2] = {1.f, 1.f};
#pragma unroll 1
  for (int k0 = t0 + 32; k0 >= 0; k0 -= 32) {
    const size_t krow = ((size_t)b * SEQL + k0 + lq5) * NPJ + C_SK + h * 64;
    {
      bf16x8 v0 = ld8(PROJ + krow + 512 + hf * 32), v1 = ld8(PROJ + krow + 512 + hf * 32 + 8);
      bf16x8 v2 = ld8(PROJ + krow + 512 + hf * 32 + 16), v3 = ld8(PROJ + krow + 512 + hf * 32 + 24);
#pragma unroll
      for (int e = 0; e < 8; ++e) {
        VT[(hf * 32 + e) * 40 + lq5] = (u16)v0[e]; VT[(hf * 32 + 8 + e) * 40 + lq5] = (u16)v1[e];
        VT[(hf * 32 + 16 + e) * 40 + lq5] = (u16)v2[e]; VT[(hf * 32 + 24 + e) * 40 + lq5] = (u16)v3[e];
      }
    }
    bf16x8 kf[4];
#pragma unroll
    for (int s = 0; s < 4; ++s) kf[s] = ld8(PROJ + krow + 16 * s + 8 * hf);
#pragma unroll
    for (int qi = 0; qi < 2; ++qi) {
      if (k0 >= t0 + 32 * qi + 31) continue;
      f32x16 st;
#pragma unroll
      for (int i = 0; i < 16; ++i) st[i] = 0.f;
#pragma unroll
      for (int s = 0; s < 4; ++s) st = mfma32(kf[s], qf[qi][s], st);
      const int t = t0 + 32 * qi + lq5;
      float m[16];
#pragma unroll
      for (int i = 0; i < 16; ++i) {
        const float z = fminf(fmaxf(st[i], -80.f), 80.f);
        const float e = __expf(z);
        const float r = __builtin_amdgcn_rcpf(1.f + e);
        const bool c = (k0 + crow(i, hf)) < t;
        m[i] = c ? r : 1.f;
        st[i] = c ? e * r : 0.f;
      }
      float T[4], P[4];
#pragma unroll
      for (int gi = 0; gi < 4; ++gi) { T[gi] = (m[4 * gi] * m[4 * gi + 1]) * (m[4 * gi + 2] * m[4 * gi + 3]); P[gi] = __shfl_xor(T[gi], 32); }
      float aft[4];
      aft[3] = (hf == 0) ? P[3] : 1.f;
      aft[2] = T[3] * P[3] * ((hf == 0) ? P[2] : 1.f);
      aft[1] = T[3] * P[3] * T[2] * P[2] * ((hf == 0) ? P[1] : 1.f);
      aft[0] = T[3] * P[3] * T[2] * P[2] * T[1] * P[1] * ((hf == 0) ? P[0] : 1.f);
      const float cin = carry[qi];
#pragma unroll
      for (int gi = 0; gi < 4; ++gi) {
        const float base = cin * aft[gi];
        const float w2 = m[4 * gi + 3], w1 = w2 * m[4 * gi + 2], w0 = w1 * m[4 * gi + 1];
        st[4 * gi + 0] *= base * w0;
        st[4 * gi + 1] *= base * w1;
        st[4 * gi + 2] *= base * w2;
        st[4 * gi + 3] *= base;
      }
      carry[qi] = cin * ((T[0] * P[0]) * (T[1] * P[1])) * ((T[2] * P[2]) * (T[3] * P[3]));
#pragma unroll
      for (int s = 0; s < 2; ++s) {
        bf16x8 pf = pack8(st, s);
#pragma unroll
        for (int dt = 0; dt < 2; ++dt) {
          const u16* vp = VT + (32 * dt + lq5) * 40 + 16 * s + 4 * hf;
          s16x4 lo = ld4(vp), hi = ld4(vp + 8);
          bf16x8 vf = __builtin_shufflevector(lo, hi, 0, 1, 2, 3, 4, 5, 6, 7);
          oacc[qi][dt] = mfma32(vf, pf, oacc[qi][dt]);
        }
      }
    }
    if (k0 <= t0 && __all(carry[0] < 1.2e-38f && carry[1] < 1.2e-38f)) break;
  }
#pragma unroll
  for (int qi = 0; qi < 2; ++qi)
#pragma unroll
    for (int dt = 0; dt < 2; ++dt)
#pragma unroll
      for (int g4 = 0; g4 < 4; ++g4)
        *(s16x4*)(PROJ + ((size_t)b * SEQL + t0 + 32 * qi + lq5) * NPJ + C_SQ + h * 64 + 32 * dt + 8 * g4 + 4 * hf) =
            pack4(oacc[qi][dt][4 * g4], oacc[qi][dt][4 * g4 + 1], oacc[qi][dt][4 * g4 + 2], oacc[qi][dt][4 * g4 + 3]);
}

static __device__ __attribute__((always_inline)) inline void nsa_compress(const Params& p, int l, int item) {
  char* ws = lsp(p.ws);
  const u16* PROJ = (const u16*)(ws + OFF_PROJ);
  u16* KC = (u16*)(ws + OFF_KC); u16* VCT = (u16*)(ws + OFF_VCT);
  const u16* WT = (const u16*)(ws + OFF_WT); const float* CB = (const float*)(ws + OFF_CB);
  float* red = (float*)lds_base();
  const int tid = lv(threadIdx.x), lane = tid & 63, w = tid >> 6, lq5 = lane & 31, hf = lane >> 5;
  const int nt4 = item & 3, kv = (item >> 2) & 1, g = (item >> 3) & 1, b = item >> 4;
  const int n = 32 * nt4 + lq5;
  f32x16 acc[2];
#pragma unroll
  for (int i = 0; i < 16; ++i) { acc[0][i] = 0.f; acc[1][i] = 0.f; }
#pragma unroll 4
  for (int ks = 0; ks < 16; ++ks) {
    const int ll = 4 * w + (ks >> 2), d0 = (ks & 3) * 16 + 8 * hf;
    bf16x8 a;
#pragma unroll
    for (int e = 0; e < 8; ++e) a[e] = 0;
    if (n < 127) a = ld8(PROJ + ((size_t)b * SEQL + 16 * n + ll) * NPJ + C_NKV + kv * 128 + g * 64 + d0);
#pragma unroll
    for (int et = 0; et < 2; ++et)
      acc[et] = mfma32(a, ld8(WT + ((size_t)(kv * 64 + 32 * et + lq5)) * 2048 + ll * 64 + d0), acc[et]);
  }
#pragma unroll
  for (int et = 0; et < 2; ++et)
#pragma unroll
    for (int i = 0; i < 16; ++i) red[(w * 32 + crow(i, hf)) * 64 + 32 * et + lq5] = acc[et][i];
  __syncthreads();
  {
    const int nl = tid >> 4, e0 = (tid & 15) * 4;
    float v[4];
#pragma unroll
    for (int q = 0; q < 4; ++q) v[q] = CB[kv * 64 + e0 + q];
#pragma unroll
    for (int ww = 0; ww < 8; ++ww)
#pragma unroll
      for (int q = 0; q < 4; ++q) v[q] += red[(ww * 32 + nl) * 64 + e0 + q];
    const int nn = 32 * nt4 + nl;
    if (nn >= 127) { v[0] = 0.f; v[1] = 0.f; v[2] = 0.f; v[3] = 0.f; }
    if (kv == 0) *(s16x4*)(KC + ((size_t)(b * 2 + g) * 128 + nn) * 64 + e0) = pack4(v[0], v[1], v[2], v[3]);
    else {
#pragma unroll
      for (int q = 0; q < 4; ++q) VCT[((size_t)(b * 2 + g) * 64 + e0 + q) * 128 + nn] = f2bf(v[q]);
    }
  }
  __syncthreads();
}

static __device__ __attribute__((always_inline)) inline void gdn_prep(const Params& p, int l, int item) {
  char* ws = lsp(p.ws);
  u16* PROJ = (u16*)(ws + OFF_PROJ); u16* HALO = (u16*)(ws + OFF_HALO);
  u16* WG = (u16*)(ws + OFF_SCR); u16* ATT = (u16*)(ws + OFF_SCR + 16777216);
  float* EGL = (float*)(ws + OFF_EGL);
  u16* Qb = (u16*)lds_base();
  u16* Kb = Qb + 64 * 136;
  u16* vbT = Kb + 64 * 136;
  u16* kbT = vbT + 128 * 72;
  float* As = (float*)(kbT + 128 * 72);
  u16* Tb = (u16*)(As + 64 * 65);
  float* sg = (float*)(Tb + 64 * 72);
  float* sbeta = sg + 64; float* sgc = sbeta + 64;
  const int tid = lv(threadIdx.x), lane = tid & 63, w = tid >> 6, lr = lane & 15, lq = lane >> 4;
  const int c = item & 31, h = (item >> 5) & 3, b = item >> 7;
  const int t0 = b * SEQL + c * 64;
  const int i = tid & 63, cgp = tid >> 6;
  const float* cw = p.conv_w + (size_t)l * 4 * 1536;
  if (tid < 64) {
    float a = bf2f(PROJ[(size_t)(t0 + tid) * NPJ + C_GA + h]);
    float bt = bf2f(PROJ[(size_t)(t0 + tid) * NPJ + C_GB + h]);
    sg[tid] = -__expf(p.a_log[l * 4 + h]) * softplusf_(a + p.dt_bias[l * 4 + h]);
    sbeta[tid] = sigmoidf_(bt);
  }
  float qkv[3][16];
  {
    bf16x8 xr[3][4][2];
#pragma unroll
    for (int sec = 0; sec < 3; ++sec)
#pragma unroll
      for (int j = 0; j < 4; ++j) {
        const int colb = sec * 512 + h * 128 + cgp * 16;
        const int ii = i - 3 + j;
        const u16* src = (ii >= 0) ? PROJ + (size_t)(t0 + ii) * NPJ + colb
                                   : HALO + ((size_t)(max(t0 >> 6, 1) - 1) * 3 + (3 + ii)) * 1536 + colb;
        xr[sec][j][0] = ld8(src); xr[sec][j][1] = ld8(src + 8);
      }
#pragma unroll
    for (int sec = 0; sec < 3; ++sec) {
      const int colb = sec * 512 + h * 128 + cgp * 16;
#pragma unroll
      for (int e = 0; e < 16; ++e) qkv[sec][e] = 0.f;
#pragma unroll
      for (int j = 0; j < 4; ++j) {
        const int ii = i - 3 + j;
        const float keep = (ii >= 0 || c > 0) ? 1.f : 0.f;
#pragma unroll
        for (int e = 0; e < 8; ++e) {
          qkv[sec][e] += (keep * cw[j * 1536 + colb + e]) * bfs(xr[sec][j][0][e]);
          qkv[sec][8 + e] += (keep * cw[j * 1536 + colb + 8 + e]) * bfs(xr[sec][j][1][e]);
        }
      }
#pragma unroll
      for (int e = 0; e < 16; ++e) { float x = qkv[sec][e]; qkv[sec][e] = x * __builtin_amdgcn_rcpf(1.f + __expf(-x)); }
    }
  }
  {
    float sq = 0.f, sk = 0.f;
#pragma unroll
    for (int e = 0; e < 16; ++e) { sq += qkv[0][e] * qkv[0][e]; sk += qkv[1][e] * qkv[1][e]; }
    float* rdn = As;
    rdn[(0 * 8 + cgp) * 64 + i] = sq; rdn[(1 * 8 + cgp) * 64 + i] = sk;
    __syncthreads();
    sq = 0.f; sk = 0.f;
#pragma unroll
    for (int cc = 0; cc < 8; ++cc) { sq += rdn[(0 * 8 + cc) * 64 + i]; sk += rdn[(1 * 8 + cc) * 64 + i]; }
    float rq = rsqrtf(sq + 1e-6f) * 0.08838834764831845f, rk = rsqrtf(sk + 1e-6f);
#pragma unroll
    for (int e = 0; e < 16; ++e) { qkv[0][e] *= rq; qkv[1][e] *= rk; }
  }
  if (tid < 64) {
    float sc_ = sg[tid];
#pragma unroll
    for (int o = 1; o < 64; o <<= 1) { float t = __shfl_up(sc_, o); if (lane >= o) sc_ += t; }
    sgc[tid] = sc_;
    if (tid == 63) EGL[item] = __expf(sc_);
  }
  __syncthreads();
  {
    const float gci = sgc[i], gl = sgc[63], bi = sbeta[i];
    const float eg = __expf(gci), ekd = __expf(gl - gci);
    bf16x8 a0, a1, b0, b1, c0, c1, d0, d1;
#pragma unroll
    for (int e = 0; e < 8; ++e) {
      a0[e] = (short)f2bf(qkv[0][e]); a1[e] = (short)f2bf(qkv[0][8 + e]);
      b0[e] = (short)f2bf(qkv[1][e]); b1[e] = (short)f2bf(qkv[1][8 + e]);
      c0[e] = (short)f2bf(qkv[0][e] * eg); c1[e] = (short)f2bf(qkv[0][8 + e] * eg);
      d0[e] = (short)f2bf(qkv[1][e] * ekd); d1[e] = (short)f2bf(qkv[1][8 + e] * ekd);
    }
    *(bf16x8*)(Qb + i * 136 + cgp * 16) = a0; *(bf16x8*)(Qb + i * 136 + cgp * 16 + 8) = a1;
    *(bf16x8*)(Kb + i * 136 + cgp * 16) = b0; *(bf16x8*)(Kb + i * 136 + cgp * 16 + 8) = b1;
    u16* gq = PROJ + (size_t)(t0 + i) * NPJ + C_GQ + h * 128 + cgp * 16;
    u16* gk = PROJ + (size_t)(t0 + i) * NPJ + C_GK + h * 128 + cgp * 16;
    *(bf16x8*)gq = c0; *(bf16x8*)(gq + 8) = c1;
    *(bf16x8*)gk = d0; *(bf16x8*)(gk + 8) = d1;
#pragma unroll
    for (int e = 0; e < 16; ++e) {
      vbT[(cgp * 16 + e) * 72 + i] = f2bf(qkv[2][e] * bi);
      kbT[(cgp * 16 + e) * 72 + i] = f2bf(qkv[1][e] * bi * eg);
    }
  }
  __syncthreads();
#pragma unroll 1
  for (int jj = 0; jj < 2; ++jj) {
    const int tile = w * 2 + jj, ti = tile >> 2, tj = tile & 3;
    f32x4 acc = {0.f, 0.f, 0.f, 0.f};
    if (tj <= ti) {
#pragma unroll
      for (int ks = 0; ks < 4; ++ks)
        acc = mfma16(ld8(Kb + (ti * 16 + lr) * 136 + ks * 32 + lq * 8), ld8(Kb + (tj * 16 + lr) * 136 + ks * 32 + lq * 8), acc);
    }
    const int j = tj * 16 + lr;
#pragma unroll
    for (int r = 0; r < 4; ++r) {
      const int ir = ti * 16 + lq * 4 + r;
      As[ir * 65 + j] = (j < ir) ? sbeta[ir] * acc[r] * __expf(sgc[ir] - sgc[j]) : 0.f;
    }
  }
  __syncthreads();
  if (w != 0) {
#pragma unroll 1
    for (int tile = w - 1; tile < 16; tile += 7) {
      const int ti = tile >> 2, tj = tile & 3;
      f32x4 acc = {0.f, 0.f, 0.f, 0.f};
      if (tj <= ti) {
#pragma unroll
        for (int ks = 0; ks < 4; ++ks)
          acc = mfma16(ld8(Qb + (ti * 16 + lr) * 136 + ks * 32 + lq * 8), ld8(Kb + (tj * 16 + lr) * 136 + ks * 32 + lq * 8), acc);
      }
      const int j = tj * 16 + lr;
#pragma unroll
      for (int r = 0; r < 4; ++r) {
        const int ir = ti * 16 + lq * 4 + r;
        const float dec = (j <= ir) ? __expf(sgc[ir] - sgc[j]) : 0.f;
        ATT[(size_t)item * 4096 + ir * 64 + j] = f2bf(acc[r] * dec);
      }
    }
  }
  if (w == 0) {
    float Ar[64], Tc[64];
#pragma unroll
    for (int ir = 0; ir < 64; ++ir) Ar[ir] = As[ir * 65 + lane];
#pragma unroll
    for (int ir = 0; ir < 64; ++ir) {
      float sacc = (ir == lane) ? 1.f : 0.f;
#pragma unroll
      for (int j = 0; j < ir; ++j) sacc -= __uint_as_float(__builtin_amdgcn_readlane(__float_as_uint(Ar[ir]), j)) * Tc[j];
      Tc[ir] = sacc;
    }
#pragma unroll
    for (int ir = 0; ir < 64; ++ir) Tb[ir * 72 + lane] = f2bf(Tc[ir]);
  }
  __syncthreads();
#pragma unroll 1
  for (int jj = 0; jj < 8; ++jj) {
    const int job = w * 8 + jj, which = job >> 5, tile = job & 31, ti = tile >> 3, tn = tile & 7;
    const u16* BT = which ? kbT : vbT;
    f32x4 acc = {0.f, 0.f, 0.f, 0.f};
#pragma unroll
    for (int ks = 0; ks < 2; ++ks)
      acc = mfma16(ld8(Tb + (ti * 16 + lr) * 72 + ks * 32 + lq * 8), ld8(BT + (tn * 16 + lr) * 72 + ks * 32 + lq * 8), acc);
    const int d = tn * 16 + lr;
#pragma unroll
    for (int r = 0; r < 4; ++r) {
      const int ir = ti * 16 + lq * 4 + r;
      if (which == 0) PROJ[(size_t)(t0 + ir) * NPJ + C_GV + h * 128 + d] = f2bf(acc[r]);
      else WG[(size_t)(t0 + ir) * 512 + h * 128 + d] = f2bf(acc[r]);
    }
  }
  __syncthreads();
}

static __device__ __attribute__((always_inline)) inline void gdn_scan(const Params& p, int l, int bh) {
  char* ws = lsp(p.ws);
  u16* PROJ = (u16*)(ws + OFF_PROJ);
  const u16* WG = (const u16*)(ws + OFF_SCR); const u16* ATT = (const u16*)(ws + OFF_SCR + 16777216);
  const float* EGL = (const float*)(ws + OFF_EGL);
  u16* St = (u16*)lds_base();
  u16* Wl = St + 128 * 136;
  u16* Ql = Wl + 64 * 136;
  u16* KdT = Ql + 64 * 136;
  u16* VnT = KdT + 128 * 72;
  u16* At = VnT + 128 * 72;
  float* red = (float*)(At + 64 * 72);
  float* egls = red + 128;
  const int tid = lv(threadIdx.x), lane = tid & 63, w = tid >> 6, lr = lane & 15, lq = lane >> 4;
  const int b = bh >> 2, h = bh & 3;
  const float* ng = p.norm_g + l * 128;
  f32x4 S[8];
#pragma unroll
  for (int v = 0; v < 8; ++v) S[v] = f32x4{0.f, 0.f, 0.f, 0.f};
  for (int idx = tid; idx < 128 * 136; idx += 512) St[idx] = 0;
  const int it = w >> 1, vb = (w & 1) * 4;
  float ngv[4];
#pragma unroll
  for (int n = 0; n < 4; ++n) ngv[n] = ng[(vb + n) * 16 + lr];
  const int r0 = tid >> 4, seg0 = tid & 15;
  const int ra = tid >> 3, sega = tid & 7;
  bf16x8 pw[2], pq[2], pk[2], pa;
  u16 un[16];
  {
    const int t0 = b * SEQL;
#pragma unroll
    for (int rep = 0; rep < 2; ++rep) {
      const int r = r0 + rep * 32;
      pw[rep] = ld8(WG + (size_t)(t0 + r) * 512 + h * 128 + seg0 * 8);
      pq[rep] = ld8(PROJ + (size_t)(t0 + r) * NPJ + C_GQ + h * 128 + seg0 * 8);
      pk[rep] = ld8(PROJ + (size_t)(t0 + r) * NPJ + C_GK + h * 128 + seg0 * 8);
    }
    pa = ld8(ATT + (size_t)(bh * 32) * 4096 + ra * 64 + sega * 8);
#pragma unroll
    for (int n = 0; n < 4; ++n)
#pragma unroll
      for (int r = 0; r < 4; ++r)
        un[n * 4 + r] = PROJ[(size_t)(t0 + it * 16 + lq * 4 + r) * NPJ + C_GV + h * 128 + (vb + n) * 16 + lr];
    if (tid < 32) egls[tid] = EGL[bh * 32 + tid];
  }
#pragma unroll 1
  for (int c = 0; c < 32; ++c) {
    const int t0 = b * SEQL + c * 64;
#pragma unroll
    for (int rep = 0; rep < 2; ++rep) {
      const int r = r0 + rep * 32;
      *(bf16x8*)(Wl + r * 136 + seg0 * 8) = pw[rep];
      *(bf16x8*)(Ql + r * 136 + seg0 * 8) = pq[rep];
#pragma unroll
      for (int e = 0; e < 8; ++e) KdT[(seg0 * 8 + e) * 72 + r] = (u16)pk[rep][e];
    }
    *(bf16x8*)(At + ra * 72 + sega * 8) = pa;
    u16 uc[16], zc[16];
#pragma unroll
    for (int q = 0; q < 16; ++q) uc[q] = un[q];
#pragma unroll
    for (int n = 0; n < 4; ++n)
#pragma unroll
      for (int r = 0; r < 4; ++r)
        zc[n * 4 + r] = PROJ[(size_t)(t0 + it * 16 + lq * 4 + r) * NPJ + C_GZ + h * 128 + (vb + n) * 16 + lr];
    lds_barrier();
    if (c + 1 < 32) {
      const int t1 = t0 + 64;
#pragma unroll
      for (int rep = 0; rep < 2; ++rep) {
        const int r = r0 + rep * 32;
        pw[rep] = ld8(WG + (size_t)(t1 + r) * 512 + h * 128 + seg0 * 8);
        pq[rep] = ld8(PROJ + (size_t)(t1 + r) * NPJ + C_GQ + h * 128 + seg0 * 8);
        pk[rep] = ld8(PROJ + (size_t)(t1 + r) * NPJ + C_GK + h * 128 + seg0 * 8);
      }
      pa = ld8(ATT + (size_t)(bh * 32 + c + 1) * 4096 + ra * 64 + sega * 8);
#pragma unroll
      for (int n = 0; n < 4; ++n)
#pragma unroll
        for (int r = 0; r < 4; ++r)
          un[n * 4 + r] = PROJ[(size_t)(t1 + it * 16 + lq * 4 + r) * NPJ + C_GV + h * 128 + (vb + n) * 16 + lr];
    }
    f32x4 vacc[4], oacc[4];
#pragma unroll
    for (int n = 0; n < 4; ++n) { vacc[n] = f32x4{0.f, 0.f, 0.f, 0.f}; oacc[n] = f32x4{0.f, 0.f, 0.f, 0.f}; }
#pragma unroll
    for (int ks = 0; ks < 4; ++ks) {
      bf16x8 aw = ld8(Wl + (it * 16 + lr) * 136 + ks * 32 + lq * 8);
      bf16x8 aq = ld8(Ql + (it * 16 + lr) * 136 + ks * 32 + lq * 8);
#pragma unroll
      for (int n = 0; n < 4; ++n) {
        bf16x8 bs = ld8(St + ((vb + n) * 16 + lr) * 136 + ks * 32 + lq * 8);
        vacc[n] = mfma16(aw, bs, vacc[n]);
        oacc[n] = mfma16(aq, bs, oacc[n]);
      }
    }
#pragma unroll
    for (int n = 0; n < 4; ++n) {
      const int v = (vb + n) * 16 + lr;
      *(s16x4*)(VnT + v * 72 + it * 16 + lq * 4) =
          pack4(bf2f(uc[n * 4 + 0]) - vacc[n][0], bf2f(uc[n * 4 + 1]) - vacc[n][1], bf2f(uc[n * 4 + 2]) - vacc[n][2], bf2f(uc[n * 4 + 3]) - vacc[n][3]);
    }
    lds_barrier();
#pragma unroll
    for (int ks = 0; ks < 2; ++ks) {
      bf16x8 aa = ld8(At + (it * 16 + lr) * 72 + ks * 32 + lq * 8);
#pragma unroll
      for (int n = 0; n < 4; ++n)
        oacc[n] = mfma16(aa, ld8(VnT + ((vb + n) * 16 + lr) * 72 + ks * 32 + lq * 8), oacc[n]);
    }
    {
      bf16x8 ak0 = ld8(KdT + (w * 16 + lr) * 72 + lq * 8), ak1 = ld8(KdT + (w * 16 + lr) * 72 + 32 + lq * 8);
#pragma unroll
      for (int vt = 0; vt < 8; ++vt) {
        f32x4 a = S[vt] * egls[c];
        a = mfma16(ak0, ld8(VnT + (vt * 16 + lr) * 72 + lq * 8), a);
        a = mfma16(ak1, ld8(VnT + (vt * 16 + lr) * 72 + 32 + lq * 8), a);
        S[vt] = a;
        *(s16x4*)(St + (vt * 16 + lr) * 136 + w * 16 + lq * 4) = pack4(a[0], a[1], a[2], a[3]);
      }
    }
    {
      float ssr[4];
#pragma unroll
      for (int r = 0; r < 4; ++r) {
        float sq = 0.f;
#pragma unroll
        for (int n = 0; n < 4; ++n) sq += oacc[n][r] * oacc[n][r];
        sq += __shfl_xor(sq, 1); sq += __shfl_xor(sq, 2); sq += __shfl_xor(sq, 4); sq += __shfl_xor(sq, 8);
        ssr[r] = sq;
      }
      if (lr == 0) {
#pragma unroll
        for (int r = 0; r < 4; ++r) red[(it * 16 + lq * 4 + r) * 2 + (w & 1)] = ssr[r];
      }
    }
    lds_barrier();
#pragma unroll
    for (int r = 0; r < 4; ++r) {
      const int ir = it * 16 + lq * 4 + r;
      const float rs = rsqrtf((red[ir * 2] + red[ir * 2 + 1]) * (1.f / 128.f) + 1e-6f);
#pragma unroll
      for (int n = 0; n < 4; ++n) {
        const int v = (vb + n) * 16 + lr;
        const float z = bf2f(zc[n * 4 + r]);
        const float y = oacc[n][r] * rs * ngv[n] * z * __builtin_amdgcn_rcpf(1.f + __expf(-z));
        PROJ[(size_t)(t0 + ir) * NPJ + C_GV + h * 128 + v] = f2bf(y);
      }
    }
  }
  __syncthreads();
}


static __device__ __attribute__((always_inline)) inline void nsa_attn(const Params& p, int item) {
  char* ws = lsp(p.ws);
  u16* PROJ = (u16*)(ws + OFF_PROJ);
  const u16* KC = (const u16*)(ws + OFF_KC); const u16* VCT = (const u16*)(ws + OFF_VCT);
  u16* Ks = (u16*)lds_base();
  float* impw = (float*)(Ks + 4 * 64 * 72);
  unsigned* selm = (unsigned*)(impw + 4 * 64 * 32);
  unsigned* uni = selm + 64;
  const int tid = lv(threadIdx.x), lane = tid & 63, w = tid >> 6;
  const int hh = w & 3, qhalf = w >> 2, lq5 = lane & 31, hf = lane >> 5;
  const int qb = 31 - (item >> 4), bg = item & 15, b = bg >> 1, g = bg & 1;
  const int ql = qhalf * 32 + lq5, tpos = qb * 64 + ql;
  const size_t row = (size_t)b * SEQL + tpos;
  const int head = g * 4 + hh;
  bf16x8 qf[4];
#pragma unroll
  for (int s = 0; s < 4; ++s) {
    bf16x8 raw = ld8(PROJ + row * NPJ + C_NQ + head * 64 + 16 * s + 8 * hf);
#pragma unroll
    for (int e = 0; e < 8; ++e) raw[e] = (short)f2bf(bfs(raw[e]) * 0.125f);
    qf[s] = raw;
  }
  if (tid == 0) *uni = 0u;
  float gate[3];
#pragma unroll
  for (int i = 0; i < 3; ++i) gate[i] = sigmoidf_(bf2f(PROJ[row * NPJ + C_NG + head * 3 + i]));
  f32x16 ofin[2];
  {
    f32x16 sc[4];
    const u16* kcb = KC + (size_t)(b * 2 + g) * 128 * 64;
#pragma unroll
    for (int mt = 0; mt < 4; ++mt) {
#pragma unroll
      for (int i = 0; i < 16; ++i) sc[mt][i] = 0.f;
#pragma unroll
      for (int s = 0; s < 4; ++s) sc[mt] = mfma32(ld8(kcb + (32 * mt + lq5) * 64 + 16 * s + 8 * hf), qf[s], sc[mt]);
    }
    const int nlim = (tpos >= 31) ? min(126, (tpos - 31) >> 4) : -1;
    float mx = -1e30f;
#pragma unroll
    for (int mt = 0; mt < 4; ++mt)
#pragma unroll
      for (int i = 0; i < 16; ++i) { int n = 32 * mt + crow(i, hf); if (n <= nlim) mx = fmaxf(mx, sc[mt][i]); }
    mx = fmaxf(mx, __shfl_xor(mx, 32));
    float ls = 0.f;
#pragma unroll
    for (int mt = 0; mt < 4; ++mt)
#pragma unroll
      for (int i = 0; i < 16; ++i) {
        int n = 32 * mt + crow(i, hf);
        float pv = (n <= nlim) ? __expf(sc[mt][i] - mx) : 0.f;
        sc[mt][i] = pv; ls += pv;
      }
    ls += __shfl_xor(ls, 32);
    const float inv = ls > 0.f ? 1.f / ls : 0.f;
#pragma unroll
    for (int mt = 0; mt < 4; ++mt)
#pragma unroll
      for (int i = 0; i < 16; ++i) sc[mt][i] *= inv;
    f32x16 oc[2];
#pragma unroll
    for (int i = 0; i < 16; ++i) { oc[0][i] = 0.f; oc[1][i] = 0.f; }
    const u16* vcb = VCT + (size_t)(b * 2 + g) * 64 * 128;
#pragma unroll
    for (int mt = 0; mt < 4; ++mt)
#pragma unroll
      for (int s = 0; s < 2; ++s) {
        bf16x8 pf = pack8(sc[mt], s);
#pragma unroll
        for (int dt = 0; dt < 2; ++dt) {
          const u16* vp = vcb + (32 * dt + lq5) * 128 + 32 * mt + 16 * s + 4 * hf;
          s16x4 lo = ld4(vp), hi = ld4(vp + 8);
          bf16x8 vf = __builtin_shufflevector(lo, hi, 0, 1, 2, 3, 4, 5, 6, 7);
          oc[dt] = mfma32(vf, pf, oc[dt]);
        }
      }
#pragma unroll
    for (int i = 0; i < 16; ++i) { ofin[0][i] = gate[0] * oc[0][i]; ofin[1][i] = gate[0] * oc[1][i]; }
    float G[4][4], rl[4][4];
#pragma unroll
    for (int mt = 0; mt < 4; ++mt)
#pragma unroll
      for (int gi = 0; gi < 4; ++gi) {
        G[mt][gi] = sc[mt][4 * gi] + sc[mt][4 * gi + 1] + sc[mt][4 * gi + 2] + sc[mt][4 * gi + 3];
        rl[mt][gi] = __shfl_xor(sc[mt][4 * gi + 3], 32);
      }
#pragma unroll
    for (int mt = 0; mt < 4; ++mt)
#pragma unroll
      for (int gi = 0; gi < 4; ++gi) {
        float prev;
        if (hf == 1) prev = rl[mt][gi];
        else prev = (gi > 0) ? rl[mt][gi > 0 ? gi - 1 : 0] : (mt > 0 ? rl[mt > 0 ? mt - 1 : 0][3] : 0.f);
        impw[(hh * 64 + ql) * 32 + 8 * mt + 2 * gi + hf] = G[mt][gi] + prev;
      }
  }
  __syncthreads();
  if (tid < 64) {
    float scv[32];
#pragma unroll
    for (int j = 0; j < 32; ++j) {
      float v = impw[(0 * 64 + tid) * 32 + j] + impw[(1 * 64 + tid) * 32 + j] + impw[(2 * 64 + tid) * 32 + j] + impw[(3 * 64 + tid) * 32 + j];
      if (j == 0 || j == qb || j == qb - 1) v += 1000.f;
      scv[j] = (j <= qb) ? v : -1e30f;
    }
    unsigned m = 0u;
#pragma unroll 1
    for (int k = 0; k < 8; ++k) {
      float bv = -1e29f; int best = -1;
#pragma unroll
      for (int j = 0; j < 32; ++j) { bool take = !((m >> j) & 1u) && scv[j] > bv; bv = take ? scv[j] : bv; best = take ? j : best; }
      if (best >= 0) m |= 1u << best;
    }
    selm[tid] = m;
    atomicOr(uni, m);
  }
  __syncthreads();
  const unsigned U = *uni;
  const unsigned sm = selm[ql];
#pragma unroll 1
  for (int mode = 0; mode < 2; ++mode) {
    float mrun = -1e30f, lrun = 0.f;
    f32x16 oacc[2];
#pragma unroll
    for (int i = 0; i < 16; ++i) { oacc[0][i] = 0.f; oacc[1][i] = 0.f; }
    const unsigned tmask = mode ? ((2u << qb) - 1u) & ~((1u << max(0, qb - 8)) - 1u) : U;
    const int r_ld = 32 * (w & 1) + (lane & 31), seg_ld = (w >> 1) * 2 + (lane >> 5);
    const int kcol = C_NKV + (mode ? 4 : 2) * 128 + g * 64 + seg_ld * 8;
    unsigned rem = tmask;
    int j = __ffs(rem) - 1;
    rem &= rem - 1u;
    bf16x8 kreg = ld8(PROJ + ((size_t)b * SEQL + 64 * j + r_ld) * NPJ + kcol);
    bf16x8 vreg = ld8(PROJ + ((size_t)b * SEQL + 64 * j + r_ld) * NPJ + kcol + 128);
    int buf = 0;
#pragma unroll 1
    while (j >= 0) {
      u16* Kb_ = Ks + buf * (2 * 64 * 72);
      u16* Vb_ = Kb_ + 64 * 72;
      *(bf16x8*)(Kb_ + r_ld * 72 + seg_ld * 8) = kreg;
#pragma unroll
      for (int e = 0; e < 8; ++e) Vb_[(seg_ld * 8 + e) * 72 + r_ld] = (u16)vreg[e];
      __syncthreads();
      const int jn = rem ? (__ffs(rem) - 1) : -1;
      rem &= rem - 1u;
      if (jn >= 0) {
        kreg = ld8(PROJ + ((size_t)b * SEQL + 64 * jn + r_ld) * NPJ + kcol);
        vreg = ld8(PROJ + ((size_t)b * SEQL + 64 * jn + r_ld) * NPJ + kcol + 128);
      }
      const bool selj = mode ? true : (((sm >> j) & 1u) != 0u);
      if (mode || __any(selj)) {
        f32x16 st[2];
#pragma unroll
        for (int mt = 0; mt < 2; ++mt) {
#pragma unroll
          for (int i = 0; i < 16; ++i) st[mt][i] = 0.f;
#pragma unroll
          for (int s = 0; s < 4; ++s) st[mt] = mfma32(ld8(Kb_ + (32 * mt + lq5) * 72 + 16 * s + 8 * hf), qf[s], st[mt]);
        }
        const bool need_mask = (j == qb) || (mode && j == qb - 8);
        float mloc = -1e30f;
        if (need_mask) {
#pragma unroll
          for (int mt = 0; mt < 2; ++mt)
#pragma unroll
            for (int i = 0; i < 16; ++i) {
              const int dist = tpos - (64 * j + 32 * mt + crow(i, hf));
              const bool ok = selj && dist >= 0 && dist < 512;
              st[mt][i] = ok ? st[mt][i] : -1e30f;
              mloc = fmaxf(mloc, st[mt][i]);
            }
        } else {
#pragma unroll
          for (int mt = 0; mt < 2; ++mt)
#pragma unroll
            for (int i = 0; i < 16; ++i) mloc = fmaxf(mloc, st[mt][i]);
          mloc = selj ? mloc : -1e30f;
        }
        mloc = fmaxf(mloc, __shfl_xor(mloc, 32));
        const float mnew = fmaxf(mrun, mloc);
        const float alpha = __expf(mrun - mnew);
        const bool live = selj && (mnew > -1e29f);
        float psum = 0.f;
#pragma unroll
        for (int mt = 0; mt < 2; ++mt)
#pragma unroll
          for (int i = 0; i < 16; ++i) {
            float pv = __expf(st[mt][i] - mnew);
            pv = live ? pv : 0.f;
            st[mt][i] = pv; psum += pv;
          }
        lrun = lrun * alpha + psum;
        mrun = mnew;
#pragma unroll
        for (int i = 0; i < 16; ++i) { oacc[0][i] *= alpha; oacc[1][i] *= alpha; }
#pragma unroll
        for (int mt = 0; mt < 2; ++mt)
#pragma unroll
          for (int s = 0; s < 2; ++s) {
            bf16x8 pf = pack8(st[mt], s);
#pragma unroll
            for (int dt = 0; dt < 2; ++dt) {
              const u16* vp = Vb_ + (32 * dt + lq5) * 72 + 32 * mt + 16 * s + 4 * hf;
              s16x4 lo = ld4(vp), hi = ld4(vp + 8);
              bf16x8 vf = __builtin_shufflevector(lo, hi, 0, 1, 2, 3, 4, 5, 6, 7);
              oacc[dt] = mfma32(vf, pf, oacc[dt]);
            }
          }
      }
      buf ^= 1;
      j = jn;
    }
    const float ltot = lrun + __shfl_xor(lrun, 32);
    const float sc_ = (ltot > 0.f) ? gate[1 + mode] / ltot : 0.f;
#pragma unroll
    for (int i = 0; i < 16; ++i) { ofin[0][i] += sc_ * oacc[0][i]; ofin[1][i] += sc_ * oacc[1][i]; }
    __syncthreads();
  }
#pragma unroll
  for (int dt = 0; dt < 2; ++dt)
#pragma unroll
    for (int g4 = 0; g4 < 4; ++g4)
      *(s16x4*)(PROJ + row * NPJ + C_NQ + head * 64 + 32 * dt + 8 * g4 + 4 * hf) =
          pack4(ofin[dt][4 * g4], ofin[dt][4 * g4 + 1], ofin[dt][4 * g4 + 2], ofin[dt][4 * g4 + 3]);
  __syncthreads();
}

static __device__ __attribute__((always_inline)) inline void phase_merge(const Params& p) {
  char* ws = lsp(p.ws);
  u16* H = (u16*)(ws + OFF_H); u16* WinT = (u16*)(ws + OFF_WBIG); u16* PROJ = (u16*)(ws + OFF_PROJ);
  u16* WbrT = (u16*)(ws + OFF_WBR); u16* M = (u16*)(ws + OFF_SCR);
  const int nM = 64, nN = 4;
  for (int t = blockIdx.x; t < nM * nN; t += gridDim.x) {
    int pm, pn; tile_map(t, nM, nN, pm, pn);
#pragma unroll 1
    for (int i = 0; i < 3; ++i) {
      const int boff = 5120 + i * 1024 + pn * 256;
      gemm_tile(H, 1024, WinT, 1024, 1024, pm * 256, boff, [&](int idx, int row, int col, f32x4 v) {
        *(s16x4*)(PROJ + (size_t)row * NPJ + C_SK + (col - 5120 - i * 1024)) = pack4(sigmoidf_(v[0]), sigmoidf_(v[1]), sigmoidf_(v[2]), sigmoidf_(v[3]));
      });
      const int ycol = (i == 0) ? C_GV : (i == 1 ? C_NQ : C_SQ);
      s16x4 gbuf[2], mbuf[2];
      gemm_tile(PROJ + ycol, NPJ, WbrT + (size_t)i * 1024 * 512, 512, 512, pm * 256, pn * 256, [&](int idx, int row, int col, f32x4 v) {
        const s16x4 gte = gbuf[idx];
        float o0 = bfs(gte[0]) * v[0], o1 = bfs(gte[1]) * v[1], o2 = bfs(gte[2]) * v[2], o3 = bfs(gte[3]) * v[3];
        if (i > 0) { const s16x4 pv = mbuf[idx]; o0 += bfs(pv[0]); o1 += bfs(pv[1]); o2 += bfs(pv[2]); o3 += bfs(pv[3]); }
        *(s16x4*)(M + (unsigned)(row * 1024 + col)) = pack4(o0, o1, o2, o3);
      }, [&](int idx, int row, int col) {
        gbuf[idx] = ld4(PROJ + (unsigned)(row * NPJ + C_SK + col));
        if (i > 0) mbuf[idx] = ld4(M + (unsigned)(row * 1024 + col));
      });
    }
  }
}

template <int MODE>
static __device__ __attribute__((always_inline)) inline void phase_gemm(const u16* A, int lda, const u16* Bt, int ldb, int K, int nM, int nN, u16* C, int ldc) {
  for (int t = blockIdx.x; t < nM * nN; t += gridDim.x) {
    int pm, pn; tile_map(t, nM, nN, pm, pn);
    gemm_tile(A, lda, Bt, ldb, K, pm * 256, pn * 256, [&](int idx, int row, int col, f32x4 v) {
      if (MODE == 1) {
#pragma unroll
        for (int q = 0; q < 4; ++q) { float t = fmaxf(v[q], 0.f); v[q] = t * t; }
      }
      *(s16x4*)(C + (size_t)row * ldc + col) = pack4(v[0], v[1], v[2], v[3]);
    });
  }
}


#define XB_TMO      128
#define XB_XCNT(j)  (256  + 64 * (j))
#define XB_XSUB(j)  (1280 + 64 * (j))
#define XB_XGEN(j)  (2304 + 64 * (j))
#define XB_TOP      3328
#define XB_TOPGEN   3392
#define XCD_BAR_WORDS 3456
#define XB_SPIN_CAP (1u << 18)
#define LAS __attribute__((address_space(3)))
DI unsigned xb_ld(unsigned* q)              { return __hip_atomic_load(q, __ATOMIC_RELAXED, __HIP_MEMORY_SCOPE_AGENT); }
DI unsigned xb_add(unsigned* q, unsigned v) { return __hip_atomic_fetch_add(q, v, __ATOMIC_RELAXED, __HIP_MEMORY_SCOPE_AGENT); }
DI unsigned xb_xcc_id() { return (unsigned)__builtin_amdgcn_s_getreg((3 << 11) | 20) & 0xFu; }
#define XB_SPIN(cond, bar) do { unsigned _sp = 0; while (cond) { __builtin_amdgcn_s_sleep(1); \
    if ((++_sp & 255u) == 0u) { if (xb_ld(&(bar)[XB_TMO])) break; if (_sp > XB_SPIN_CAP) { atomicAdd(&(bar)[XB_TMO], 1u); break; } } } } while (0)
struct XcdBarrier { unsigned* bar; unsigned x; volatile LAS unsigned* st; };
DI XcdBarrier xcd_barrier_post(unsigned* bar, volatile LAS unsigned* st) {
  XcdBarrier b; b.bar = bar; b.x = xb_xcc_id(); b.st = st;
  if (threadIdx.x == 0) (void)xb_add(&bar[XB_XCNT(b.x)], 1u);
  return b;
}
DI void xcd_barrier_complete(unsigned* bar, unsigned x, unsigned& nloc, unsigned& nx) {
  const unsigned G = gridDim.x * gridDim.y * gridDim.z;
  unsigned sum, cnt, mine, sp = 0u;
  for (;;) {
    sum = 0u; cnt = 0u; mine = 0u;
#pragma unroll
    for (unsigned j = 0; j < 16; ++j) { const unsigned c = xb_ld(&bar[XB_XCNT(j)]); sum += c; cnt += (c > 0u) ? 1u : 0u; mine = (j == x) ? c : mine; }
    if (sum == G) break;
    __builtin_amdgcn_s_sleep(1);
    if ((++sp & 255u) == 0u) { if (xb_ld(&bar[XB_TMO])) break; if (sp > XB_SPIN_CAP) { atomicAdd(&bar[XB_TMO], 1u); break; } }
  }
  nloc = mine > 0u ? mine : 1u; nx = cnt > 0u ? cnt : 1u;
}
DI void xcd_barrier(const XcdBarrier& b) {
  asm volatile("s_waitcnt vmcnt(0)" ::: "memory");
  __syncthreads();
  if (threadIdx.x == 0) {
    unsigned* bar = b.bar;
    __builtin_amdgcn_s_waitcnt(0);
    unsigned nloc = b.st[0], nx = b.st[1];
    if (nloc == 0u) { xcd_barrier_complete(bar, b.x, nloc, nx); b.st[0] = nloc; b.st[1] = nx; }
    const unsigned old = xb_add(&bar[XB_XSUB(b.x)], 1u);
    const unsigned gen = old / nloc;
    if (old + 1u == (gen + 1u) * nloc) {
      __builtin_amdgcn_fence(__ATOMIC_RELEASE, "agent");
      asm volatile("s_waitcnt vmcnt(0)" ::: "memory");
      const unsigned og = xb_add(&bar[XB_TOP], 1u);
      const unsigned tg = og / nx;
      if (og + 1u == (tg + 1u) * nx) xb_add(&bar[XB_TOPGEN], 1u);
      else XB_SPIN(xb_ld(&bar[XB_TOPGEN]) == tg, bar);
      __builtin_amdgcn_fence(__ATOMIC_ACQUIRE, "agent");
      xb_add(&bar[XB_XGEN(b.x)], 1u);
      asm volatile("s_waitcnt vmcnt(0)" ::: "memory");
    } else {
      XB_SPIN(xb_ld(&bar[XB_XGEN(b.x)]) == gen, bar);
      __builtin_amdgcn_fence(__ATOMIC_ACQUIRE, "agent");
      asm volatile("s_waitcnt vmcnt(0)" ::: "memory");
    }
  }
  __syncthreads();
}

__global__ void __launch_bounds__(512) fwd_megakernel(Params p_unused) {
#define p (kp())
  cg::grid_group grid = cg::this_grid();
  volatile LAS unsigned* xst = (volatile LAS unsigned*)((LAS char*)g_shm + LDS_XST);
  if (threadIdx.x == 0) { xst[0] = 0u; xst[1] = 0u; }
  __syncthreads();
  (void)xcd_barrier_post((unsigned*)(lsp(p.ws) + OFF_BAR), xst);
#define GSYNC() do { XcdBarrier xb_; xb_.bar = (unsigned*)(lsp(p.ws) + OFF_BAR); unsigned xx_ = xb_xcc_id(); asm volatile("" : "+s"(xx_)); xb_.x = xx_; \
    xb_.st = (volatile LAS unsigned*)((LAS char*)g_shm + LDS_XST); xcd_barrier(xb_); } while (0)
#define WSP(off) ((u16*)(lsp(p.ws) + (off)))
  phase_norm(p.x, nullptr, nullptr, p.g_mix_pre, nullptr, WSP(OFF_H));
  convert_mixer_weights(p, 0);
  if (p.ws == nullptr) grid.sync();
  GSYNC();
#pragma unroll 1
  for (int l = 0; l < 2; ++l) {
    phase_inproj(p);
    GSYNC();
    {
      volatile LAS int* qslot = (volatile LAS int*)((LAS char*)g_shm + LDS_XST + 16);
#pragma unroll 1
      for (;;) {
        if (threadIdx.x == 0) *qslot = (int)atomicAdd((unsigned*)(lsp(p.ws) + OFF_QCTR) + l * 64 + 32, 1u);
        __syncthreads();
        const int it = *qslot;
        __syncthreads();
        if (it >= 1152) break;
        if (it < 128) nsa_compress(p, l, it);
        else gdn_prep(p, l, it - 128);
      }
    }
    GSYNC();
    if (blockIdx.x < 32) gdn_scan(p, l, blockIdx.x);
    {
      volatile LAS int* qslot = (volatile LAS int*)((LAS char*)g_shm + LDS_XST + 16);
#pragma unroll 1
      for (;;) {
        if (threadIdx.x == 0) *qslot = (int)atomicAdd((unsigned*)(lsp(p.ws) + OFF_QCTR) + l * 64, 1u);
        __syncthreads();
        const int it = *qslot;
        __syncthreads();
        if (it >= 768) break;
        if (it < 192) nsa_attn(p, it);
        else if (it < 448) { sb_attn_wave(p, (it - 192) * 8 + (lv(threadIdx.x) >> 6)); __syncthreads(); }
        else nsa_attn(p, it - 256);
      }
    }
    GSYNC();
    phase_merge(p);
    GSYNC();
    phase_gemm<0>(WSP(OFF_SCR), 1024, WSP(OFF_WOUT), 1024, 1024, 64, 4, WSP(OFF_H), 1024);
    GSYNC();
    phase_norm(l == 0 ? p.x : p.out, WSP(OFF_H), p.g_mix_post + l * 1024, p.g_ff_pre + l * 1024, p.out, WSP(OFF_H));
    convert_ffn_weights(p, l);
    GSYNC();
    phase_gemm<1>(WSP(OFF_H), 1024, WSP(OFF_WBIG), 1024, 1024, 64, 16, WSP(OFF_PROJ), 4096);
    GSYNC();
    phase_gemm<0>(WSP(OFF_PROJ), 4096, WSP(OFF_WBIG) + (size_t)4096 * 1024, 4096, 4096, 64, 4, WSP(OFF_SCR), 1024);
    GSYNC();
    phase_norm(p.out, WSP(OFF_SCR), p.g_ff_post + l * 1024, (l == 0) ? p.g_mix_pre + 1024 : nullptr, p.out, WSP(OFF_H));
    if (l == 0) { convert_mixer_weights(p, 1); GSYNC(); }
  }
}
#undef p

extern "C" void kernel_launch(void* const* d_in, const int* in_sizes, int n_in, void* d_out, int out_size, void* d_ws,
                              size_t ws_size, hipStream_t stream) {
  static int grid_blocks = 0;
  if (!grid_blocks) {
    int dev = 0, cus = 0, per_cu = 0;
    (void)hipGetDevice(&dev);
    (void)hipDeviceGetAttribute(&cus, hipDeviceAttributeMultiprocessorCount, dev);
    (void)hipFuncSetAttribute((const void*)fwd_megakernel, hipFuncAttributeMaxDynamicSharedMemorySize, LDS_BYTES);
    (void)hipOccupancyMaxActiveBlocksPerMultiprocessor(&per_cu, (const void*)fwd_megakernel, 512, LDS_BYTES);
    if (per_cu < 1) per_cu = 1;
    grid_blocks = cus * 1;
    if (ws_size < WS_NEED) fprintf(stderr, "workspace too small: %zu < %zu\n", ws_size, (size_t)WS_NEED);
  }
  Params p{};
  p.x = (const float*)d_in[0]; p.g_mix_pre = (const float*)d_in[1]; p.g_mix_post = (const float*)d_in[2];
  p.g_ff_pre = (const float*)d_in[3]; p.g_ff_post = (const float*)d_in[4]; p.w_in = (const float*)d_in[5];
  p.conv_w = (const float*)d_in[6]; p.a_log = (const float*)d_in[7]; p.dt_bias = (const float*)d_in[8];
  p.norm_g = (const float*)d_in[9]; p.cmp_wk = (const float*)d_in[10]; p.cmp_pk = (const float*)d_in[11];
  p.cmp_wv = (const float*)d_in[12]; p.cmp_pv = (const float*)d_in[13]; p.w_br0 = (const float*)d_in[14];
  p.w_br1 = (const float*)d_in[15]; p.w_br2 = (const float*)d_in[16]; p.w_out = (const float*)d_in[17];
  p.w_ff1 = (const float*)d_in[18]; p.w_ff2 = (const float*)d_in[19];
  p.out = (float*)d_out; p.ws = (char*)d_ws;
  (void)hipMemsetAsync((char*)d_ws + OFF_BAR, 0, 16384, stream);
  void* args[] = {&p};
  hipError_t e = hipLaunchCooperativeKernel((const void*)fwd_megakernel, dim3(grid_blocks), dim3(512), args, LDS_BYTES, stream);
  if (e != hipSuccess) fprintf(stderr, "cooperative launch failed: %s (grid %d)\n", hipGetErrorString(e), grid_blocks);
}
```

```cpp
#include <hip/hip_runtime.h>
#include <hip/hip_bf16.h>
#include <hip/hip_cooperative_groups.h>
#include <cstdio>
namespace cg = cooperative_groups;

typedef unsigned short u16;
using bf16x8 = __attribute__((ext_vector_type(8))) short;
using s16x4  = __attribute__((ext_vector_type(4))) short;
using f32x4  = __attribute__((ext_vector_type(4))) float;
using f32x16 = __attribute__((ext_vector_type(16))) float;
#define DI __device__ __forceinline__

constexpr int T_TOK = 16384, SEQL = 2048;
constexpr int NPJ = 4896;
constexpr int N_IN = 7968;
constexpr int C_GQ = 0, C_GK = 512, C_GV = 1024, C_GZ = 1536, C_GA = 2048, C_GB = 2052, C_NQ = 2056, C_NKV = 2568,
              C_NG = 3336, C_SQ = 3360, C_SK = 3872;
constexpr size_t OFF_WBR  = 0;
constexpr size_t OFF_WOUT = 3145728;
constexpr size_t OFF_WBIG = 5242880;
constexpr size_t OFF_PROJ = 22020096;
constexpr size_t OFF_SCR  = OFF_PROJ + 160432128;
constexpr size_t OFF_H    = OFF_SCR + 33554432;
constexpr size_t OFF_HALO = OFF_H + 33554432;
constexpr size_t OFF_KC   = OFF_HALO + 2359296;
constexpr size_t OFF_VCT  = OFF_KC + 262144;
constexpr size_t OFF_EGL  = OFF_VCT + 262144;
constexpr size_t OFF_WT   = OFF_EGL + 4096;
constexpr size_t OFF_CB   = OFF_WT + 524288;
constexpr size_t OFF_BAR  = OFF_CB + 512;
constexpr size_t OFF_QCTR = OFF_BAR + 14336;
constexpr size_t WS_NEED  = OFF_BAR + 16384;
constexpr int LDS_XST = 155648;
constexpr int LDS_BYTES = LDS_XST + 32;

struct Params {
  const float* x; const float* g_mix_pre; const float* g_mix_post; const float* g_ff_pre; const float* g_ff_post;
  const float* w_in; const float* conv_w; const float* a_log; const float* dt_bias; const float* norm_g;
  const float* cmp_wk; const float* cmp_pk; const float* cmp_wv; const float* cmp_pv;
  const float* w_br0; const float* w_br1; const float* w_br2; const float* w_out; const float* w_ff1; const float* w_ff2;
  float* out; char* ws;
};

extern __shared__ __attribute__((aligned(16))) char g_shm[];

typedef __bf16 bf2_t __attribute__((ext_vector_type(2)));
typedef float f2_t __attribute__((ext_vector_type(2)));
typedef unsigned u32x2 __attribute__((ext_vector_type(2)));
typedef unsigned u32x4 __attribute__((ext_vector_type(4)));
DI unsigned cvt2(float a, float b) { f2_t v; v[0] = a; v[1] = b; return __builtin_bit_cast(unsigned, __builtin_convertvector(v, bf2_t)); }
DI u16 f2bf(float x) { return (u16)(cvt2(x, x) & 0xffffu); }
DI float bf2f(u16 b) { return __uint_as_float(((unsigned)b) << 16); }
DI float bfs(short b) { return __uint_as_float(((unsigned)(u16)b) << 16); }
DI bf16x8 ld8(const u16* p) { return *(const bf16x8*)p; }
DI s16x4 ld4(const u16* p) { return *(const s16x4*)p; }
DI f32x4 mfma16(bf16x8 a, bf16x8 b, f32x4 c) { return __builtin_amdgcn_mfma_f32_16x16x32_bf16(a, b, c, 0, 0, 0); }
DI f32x16 mfma32(bf16x8 a, bf16x8 b, f32x16 c) { return __builtin_amdgcn_mfma_f32_32x32x16_bf16(a, b, c, 0, 0, 0); }
DI s16x4 pack4(float a, float b, float c, float d) { u32x2 r; r[0] = cvt2(a, b); r[1] = cvt2(c, d); return __builtin_bit_cast(s16x4, r); }
DI float sigmoidf_(float x) { return 1.f / (1.f + __expf(-x)); }
DI float softplusf_(float x) { return fmaxf(x, 0.f) + log1pf(__expf(-fabsf(x))); }
DI int lv(int v) { asm volatile("" : "+v"(v)); return v; }
DI char* lsp(char* q) { auto g = (__attribute__((address_space(1))) char*)q; asm volatile("" : "+s"(g)); return (char*)g; }
typedef const __attribute__((address_space(4))) Params* kparg_t;
#if defined(__HIP_DEVICE_COMPILE__)
DI Params kp() { kparg_t q = (kparg_t)__builtin_amdgcn_kernarg_segment_ptr(); asm volatile("" : "+s"(q)); return *q; }
#else
DI Params kp() { return Params{}; }
#endif
DI char* lds_base() { auto q = (__attribute__((address_space(3))) char*)g_shm; asm volatile("" : "+v"(q)); return (char*)q; }
DI void lds_barrier() { asm volatile("s_waitcnt lgkmcnt(0)" ::: "memory"); __builtin_amdgcn_s_barrier(); asm volatile("" ::: "memory"); }
DI int crow(int i, int h) { return (i & 3) + 8 * (i >> 2) + 4 * h; }
DI bf16x8 pack8(const f32x16& x, int s) {
  u32x4 r;
  r[0] = cvt2(x[8 * s + 0], x[8 * s + 1]); r[1] = cvt2(x[8 * s + 2], x[8 * s + 3]);
  r[2] = cvt2(x[8 * s + 4], x[8 * s + 5]); r[3] = cvt2(x[8 * s + 6], x[8 * s + 7]);
  return __builtin_bit_cast(bf16x8, r);
}

static __device__ __attribute__((always_inline)) inline void convert_weight(const float* W, int K, int N, u16* out, int ldo, bool winmap, int boff = 0) {
  float* lds = (float*)lds_base();
  const int tid = lv(threadIdx.x);
  const int nkt = K / 64, nnt = (N + 127) / 128, ntiles = nkt * nnt;
  f32x4 v[4];
#define CW_LOAD(T) do { const int kt_ = (T) % nkt, nt_ = (T) / nkt; \
    _Pragma("unroll") for (int q = 0; q < 4; ++q) { const int e = tid + q * 512, kk = e >> 5, n = nt_ * 128 + (e & 31) * 4; \
      v[q] = f32x4{0.f, 0.f, 0.f, 0.f}; if (n < N) v[q] = *(const f32x4*)(W + (size_t)(kt_ * 64 + kk) * N + n); } } while (0)
  int t = (int)((blockIdx.x + gridDim.x - (unsigned)boff) % gridDim.x);
  if (t < ntiles) CW_LOAD(t);
  for (; t < ntiles; t += gridDim.x) {
    const int kt = t % nkt, nt = t / nkt, k0 = kt * 64, n0 = nt * 128;
#pragma unroll
    for (int q = 0; q < 4; ++q) {
      const int e = tid + q * 512, kk = e >> 5, nn = (e & 31) * 4;
      lds[kk * 129 + nn + 0] = v[q][0]; lds[kk * 129 + nn + 1] = v[q][1]; lds[kk * 129 + nn + 2] = v[q][2]; lds[kk * 129 + nn + 3] = v[q][3];
    }
    lds_barrier();
    if (t + (int)gridDim.x < ntiles) CW_LOAD(t + (int)gridDim.x);
#pragma unroll
    for (int rep = 0; rep < 2; ++rep) {
      const int nn = (tid >> 3) + 64 * rep, ks = tid & 7, n = n0 + nn;
      if (n < N) {
        const int orow = winmap ? (n < NPJ ? n : n + 224) : n;
        u32x4 o;
#pragma unroll
        for (int e = 0; e < 4; ++e) o[e] = cvt2(lds[(ks * 8 + 2 * e) * 129 + nn], lds[(ks * 8 + 2 * e + 1) * 129 + nn]);
        *(u32x4*)(out + (size_t)orow * ldo + k0 + ks * 8) = o;
      }
    }
    lds_barrier();
  }
#undef CW_LOAD
  __syncthreads();
}

static __device__ __attribute__((always_inline)) inline void convert_mixer_weights(const Params& p, int l) {
  char* ws = lsp(p.ws);
  convert_weight(p.w_in + (size_t)l * 1024 * N_IN, 1024, N_IN, (u16*)(ws + OFF_WBIG), 1024, true);
  convert_weight(p.w_br0 + (size_t)l * 512 * 1024, 512, 1024, (u16*)(ws + OFF_WBR), 512, false);
  convert_weight(p.w_br1 + (size_t)l * 512 * 1024, 512, 1024, (u16*)(ws + OFF_WBR) + 1024 * 512, 512, false, 64);
  convert_weight(p.w_br2 + (size_t)l * 512 * 1024, 512, 1024, (u16*)(ws + OFF_WBR) + 2 * 1024 * 512, 512, false, 128);
  convert_weight(p.w_out + (size_t)l * 1024 * 1024, 1024, 1024, (u16*)(ws + OFF_WOUT), 1024, false, 192);
  convert_weight(p.cmp_wk + (size_t)l * 131072, 2048, 64, (u16*)(ws + OFF_WT), 2048, false, 64);
  convert_weight(p.cmp_wv + (size_t)l * 131072, 2048, 64, (u16*)(ws + OFF_WT) + 64 * 2048, 2048, false, 96);
  if (blockIdx.x >= 160 && blockIdx.x < 162) {
    const int kv = blockIdx.x - 160, tid = lv(threadIdx.x), e = tid & 63, part = tid >> 6;
    const float* W = (kv ? p.cmp_wv : p.cmp_wk) + (size_t)l * 131072;
    const float* pp = (kv ? p.cmp_pv : p.cmp_pk) + (size_t)l * 2048;
    float* red = (float*)lds_base();
    float sacc = 0.f;
    for (int k = part * 256; k < part * 256 + 256; ++k) sacc += pp[k] * W[k * 64 + e];
    red[part * 64 + e] = sacc;
    __syncthreads();
    if (tid < 64) { float t = 0.f; for (int q = 0; q < 8; ++q) t += red[q * 64 + tid]; ((float*)(ws + OFF_CB))[kv * 64 + tid] = t; }
    __syncthreads();
  }
}
static __device__ __attribute__((always_inline)) inline void convert_ffn_weights(const Params& p, int l) {
  char* ws = lsp(p.ws);
  convert_weight(p.w_ff1 + (size_t)l * 1024 * 4096, 1024, 4096, (u16*)(ws + OFF_WBIG), 1024, false);
  convert_weight(p.w_ff2 + (size_t)l * 4096 * 1024, 4096, 1024, (u16*)(ws + OFF_WBIG) + (size_t)4096 * 1024, 4096, false);
}

DI float wave_sum(float v) {
#pragma unroll
  for (int o = 32; o > 0; o >>= 1) v += __shfl_xor(v, o);
  return v;
}
static __device__ __attribute__((always_inline)) inline void phase_norm(const float* xin, const u16* y, const float* g_post, const float* g_next, float* xout, u16* H) {
  const int tidn = lv(threadIdx.x);
  const int wave = tidn >> 6, lane = tidn & 63;
  for (int row0 = (blockIdx.x * 8 + wave) * 2; row0 < T_TOK; row0 += gridDim.x * 16) {
    float xv[2][16], yv[2][16];
#pragma unroll
    for (int rr = 0; rr < 2; ++rr)
#pragma unroll
      for (int i = 0; i < 4; ++i) {
        f32x4 t = *(const f32x4*)(xin + (size_t)(row0 + rr) * 1024 + i * 256 + lane * 4);
        xv[rr][i * 4 + 0] = t[0]; xv[rr][i * 4 + 1] = t[1]; xv[rr][i * 4 + 2] = t[2]; xv[rr][i * 4 + 3] = t[3];
      }
    if (y) {
      float ss[2] = {0.f, 0.f};
#pragma unroll
      for (int rr = 0; rr < 2; ++rr)
#pragma unroll
        for (int i = 0; i < 4; ++i) {
          s16x4 t = ld4(y + (size_t)(row0 + rr) * 1024 + i * 256 + lane * 4);
#pragma unroll
          for (int e = 0; e < 4; ++e) { yv[rr][i * 4 + e] = bfs(t[e]); ss[rr] += yv[rr][i * 4 + e] * yv[rr][i * 4 + e]; }
        }
#pragma unroll
      for (int o = 32; o > 0; o >>= 1) { float t0 = __shfl_xor(ss[0], o), t1 = __shfl_xor(ss[1], o); ss[0] += t0; ss[1] += t1; }
#pragma unroll
      for (int rr = 0; rr < 2; ++rr) {
        const float r = rsqrtf(ss[rr] * (1.f / 1024.f) + 1e-6f);
#pragma unroll
        for (int i = 0; i < 4; ++i) {
          f32x4 g = *(const f32x4*)(g_post + i * 256 + lane * 4);
          f32x4 o;
#pragma unroll
          for (int e = 0; e < 4; ++e) { xv[rr][i * 4 + e] += yv[rr][i * 4 + e] * r * g[e]; o[e] = xv[rr][i * 4 + e]; }
          *(f32x4*)(xout + (size_t)(row0 + rr) * 1024 + i * 256 + lane * 4) = o;
        }
      }
    }
    if (g_next) {
      float ss[2] = {0.f, 0.f};
#pragma unroll
      for (int rr = 0; rr < 2; ++rr)
#pragma unroll
        for (int i = 0; i < 16; ++i) ss[rr] += xv[rr][i] * xv[rr][i];
#pragma unroll
      for (int o = 32; o > 0; o >>= 1) { float t0 = __shfl_xor(ss[0], o), t1 = __shfl_xor(ss[1], o); ss[0] += t0; ss[1] += t1; }
#pragma unroll
      for (int rr = 0; rr < 2; ++rr) {
        const float r = rsqrtf(ss[rr] * (1.f / 1024.f) + 1e-6f);
#pragma unroll
        for (int i = 0; i < 4; ++i) {
          f32x4 g = *(const f32x4*)(g_next + i * 256 + lane * 4);
          *(s16x4*)(H + (size_t)(row0 + rr) * 1024 + i * 256 + lane * 4) =
              pack4(xv[rr][i * 4] * r * g[0], xv[rr][i * 4 + 1] * r * g[1], xv[rr][i * 4 + 2] * r * g[2], xv[rr][i * 4 + 3] * r * g[3]);
        }
      }
    }
  }
}

constexpr int BM = 256, BK = 64, HALF = 128, HT = HALF * BK;
DI int lds_byte(int r, int c) {
  int st = (r >> 4) * 2 + (c >> 5), rr = r & 15, cc = c & 31, ob = rr * 64 + cc * 2;
  return st * 1024 + (ob ^ (((ob >> 9) & 1) << 5));
}
DI void stage_rc(int b, int& R, int& C) {
  int st = b / 1024, sb = b % 1024, swz = sb ^ (((sb >> 9) & 1) << 5);
  R = (st >> 1) * 16 + swz / 64; C = (st & 1) * 32 + (swz % 64) / 2;
}
DI void tile_map(int wgid, int nM, int nN, int& pm, int& pn) {
  const int NXCD = 8, WGM = 8;
  int nwg = nM * nN;
  { int q = nwg / NXCD, r = nwg % NXCD, xcd = wgid % NXCD, off = wgid / NXCD;
    wgid = (xcd < r ? xcd * (q + 1) : r * (q + 1) + (xcd - r) * q) + off; }
  int nig = WGM * nN, gid = wgid / nig, fm = gid * WGM, gsz = min(nM - fm, WGM);
  pm = fm + ((wgid % nig) % gsz); pn = (wgid % nig) / gsz;
}

struct NoPre { DI void operator()(int, int, int) const {} };
template <class Epi, class Pre = NoPre>
DI void gemm_tile(const u16* A, int lda, const u16* Bt, int ldb, int K, int brow, int bcol, Epi epi, Pre pre = Pre()) {
  u16* shm = (u16*)g_shm;
#define SA(b, h) (shm + ((b) * 2 + (h)) * HT)
#define SB(b, h) (shm + (4 + (b) * 2 + (h)) * HT)
#define STAGE(P, BASE, LD, br, kt) do { const char* _gb = (const char*)((BASE) + (size_t)(br) * (LD) + (size_t)(kt) * BK); \
    for (int _i = 0; _i < 2; ++_i) { int _b = tidx * 16 + _i * 8192; \
      __builtin_amdgcn_global_load_lds((const unsigned*)(_gb + (((LD) == lda) ? offA[_i] : offB[_i])), \
        (__attribute__((address_space(3))) unsigned*)((char*)(P) + _b), 16, 0, 0); } } while (0)
#define LDA(dst, b, h) for (int m = 0; m < 4; ++m) for (int k = 0; k < 2; ++k) \
    dst[m][k] = *reinterpret_cast<const bf16x8*>((char*)SA(b, h) + lds_byte(wr * 64 + m * 16 + fr, k * 32 + fq * 8))
#define LDB(dst, b, h) for (int n = 0; n < 2; ++n) for (int k = 0; k < 2; ++k) \
    dst[n][k] = *reinterpret_cast<const bf16x8*>((char*)SB(b, h) + lds_byte(wc * 32 + n * 16 + fr, k * 32 + fq * 8))
#define MMA(ai, bj, At_, Bt_) do { __builtin_amdgcn_s_setprio(1); \
    for (int m = 0; m < 4; ++m) for (int n = 0; n < 2; ++n) for (int k = 0; k < 2; ++k) \
      acc[ai][bj][m][n] = __builtin_amdgcn_mfma_f32_16x16x32_bf16(Bt_[n][k], At_[m][k], acc[ai][bj][m][n], 0, 0, 0); \
    __builtin_amdgcn_s_setprio(0); } while (0)
#define WAIT_V(n) asm volatile("s_waitcnt vmcnt(" #n ")" ::: "memory")
#define WAIT_L(n) asm volatile("s_waitcnt lgkmcnt(" #n ")" ::: "memory")
#define BAR __builtin_amdgcn_s_barrier()
#define SCHED __builtin_amdgcn_sched_barrier(0)
  int tidx = threadIdx.x; asm volatile("" : "+v"(tidx));
  const int wid = tidx >> 6, lane = tidx & 63, wr = wid >> 2, wc = wid & 3, fr = lane & 15, fq = lane >> 4;
  unsigned offA[2], offB[2];
#pragma unroll
  for (int _i = 0; _i < 2; ++_i) { int _r, _c; stage_rc(tidx * 16 + _i * 8192, _r, _c); offA[_i] = (unsigned)(_r * lda + _c) * 2u; offB[_i] = (unsigned)(_r * ldb + _c) * 2u; }
  f32x4 acc[2][2][4][2] = {};
  bf16x8 At[4][2], B0[2][2], B1[2][2];
  const int nt = K / BK;
  STAGE(SB(0, 0), Bt, ldb, bcol, 0); STAGE(SA(0, 0), A, lda, brow, 0);
  STAGE(SB(0, 1), Bt, ldb, bcol + HALF, 0); STAGE(SA(0, 1), A, lda, brow + HALF, 0);
  if (wr == 1) BAR;
  WAIT_V(4); BAR;
  STAGE(SB(1, 0), Bt, ldb, bcol, 1); STAGE(SA(1, 0), A, lda, brow, 1); STAGE(SB(1, 1), Bt, ldb, bcol + HALF, 1);
  WAIT_V(6); BAR;
  for (int t = 0; t < nt - 2; t += 2) {
    LDB(B0, 0, 0); SCHED; LDA(At, 0, 0); STAGE(SA(1, 1), A, lda, brow + HALF, t + 1);
    WAIT_L(8); BAR; WAIT_L(0); MMA(0, 0, At, B0); BAR; SCHED;
    LDB(B1, 0, 1); STAGE(SB(0, 0), Bt, ldb, bcol, t + 2);
    BAR; WAIT_L(0); MMA(0, 1, At, B1); BAR;
    LDA(At, 0, 1); STAGE(SA(0, 0), A, lda, brow, t + 2);
    BAR; WAIT_L(0); MMA(1, 0, At, B0); BAR; SCHED;
    STAGE(SB(0, 1), Bt, ldb, bcol + HALF, t + 2);
    WAIT_V(6); BAR; MMA(1, 1, At, B1); BAR;
    LDB(B0, 1, 0); SCHED; LDA(At, 1, 0); STAGE(SA(0, 1), A, lda, brow + HALF, t + 2);
    WAIT_L(8); BAR; WAIT_L(0); MMA(0, 0, At, B0); BAR; SCHED;
    LDB(B1, 1, 1); STAGE(SB(1, 0), Bt, ldb, bcol, t + 3);
    BAR; WAIT_L(0); MMA(0, 1, At, B1); BAR;
    LDA(At, 1, 1); STAGE(SA(1, 0), A, lda, brow, t + 3);
    BAR; WAIT_L(0); MMA(1, 0, At, B0); BAR; SCHED;
    STAGE(SB(1, 1), Bt, ldb, bcol + HALF, t + 3);
    WAIT_V(6); BAR; MMA(1, 1, At, B1); BAR;
  }
  { LDB(B0, 0, 0); LDA(At, 0, 0); STAGE(SA(1, 1), A, lda, brow + HALF, nt - 1);
    BAR; WAIT_L(0); MMA(0, 0, At, B0); BAR;
    LDB(B1, 0, 1); BAR; WAIT_L(0); MMA(0, 1, At, B1); BAR;
    LDA(At, 0, 1); WAIT_V(4); BAR; WAIT_L(0); MMA(1, 0, At, B0); MMA(1, 1, At, B1); BAR; }
  { LDB(B0, 1, 0); LDA(At, 1, 0); WAIT_V(2); BAR; WAIT_L(0); MMA(0, 0, At, B0); BAR;
    LDB(B1, 1, 1); WAIT_V(0); BAR; WAIT_L(0); MMA(0, 1, At, B1); BAR;
    LDA(At, 1, 1); BAR; WAIT_L(0); MMA(1, 0, At, B0); MMA(1, 1, At, B1); BAR; }
  if (wr == 0) BAR;
  int tid2 = tidx; asm volatile("" : "+v"(tid2));
  const int wid2 = tid2 >> 6, lane2 = tid2 & 63, wr2 = wid2 >> 2, wc2 = wid2 & 3, fr2 = lane2 & 15, fq2 = lane2 >> 4;
#pragma unroll
  for (int ai = 0; ai < 2; ++ai)
#pragma unroll
    for (int bj = 0; bj < 2; ++bj)
#pragma unroll
      for (int m = 0; m < 4; ++m) {
#pragma unroll
        for (int n = 0; n < 2; ++n)
          pre(n, brow + ai * HALF + wr2 * 64 + m * 16 + fr2, bcol + bj * HALF + wc2 * 32 + n * 16 + fq2 * 4);
#pragma unroll
        for (int n = 0; n < 2; ++n)
          epi(n, brow + ai * HALF + wr2 * 64 + m * 16 + fr2, bcol + bj * HALF + wc2 * 32 + n * 16 + fq2 * 4, acc[ai][bj][m][n]);
      }
  __syncthreads();
#undef SA
#undef SB
#undef STAGE
#undef LDA
#undef LDB
#undef MMA
}

static __device__ __attribute__((always_inline)) inline void phase_inproj(const Params& p) {
  char* ws = lsp(p.ws);
  u16* H = (u16*)(ws + OFF_H); u16* WinT = (u16*)(ws + OFF_WBIG); u16* PROJ = (u16*)(ws + OFF_PROJ);
  u16* HALO = (u16*)(ws + OFF_HALO);
  const int nM = 64, nN = 20;
  for (int t = blockIdx.x; t < nM * nN; t += gridDim.x) {
    int pm, pn; tile_map(t, nM, nN, pm, pn);
    gemm_tile(H, 1024, WinT, 1024, 1024, pm * 256, pn * 256, [&](int idx, int row, int col, f32x4 v) {
      if (col < NPJ) {
        s16x4 b = pack4(v[0], v[1], v[2], v[3]);
        *(s16x4*)(PROJ + (size_t)row * NPJ + col) = b;
        if (col < 1536 && (row & 63) >= 61) *(s16x4*)(HALO + ((size_t)(row >> 6) * 3 + ((row & 63) - 61)) * 1536 + col) = b;
      }
    });
  }
}

static __device__ __attribute__((always_inline)) inline void sb_attn_wave(const Params& p, int witem) {
  u16* PROJ = (u16*)(lsp(p.ws) + OFF_PROJ);
  const int tid = lv(threadIdx.x), lane = tid & 63, w = tid >> 6, lq5 = lane & 31, hf = lane >> 5;
  u16* VT = (u16*)lds_base() + w * (64 * 40);
  const int b = witem >> 8, h = (witem >> 5) & 7, qt = witem & 31;
  const int t0 = qt * 64;
  bf16x8 qf[2][4];
#pragma unroll
  for (int qi = 0; qi < 2; ++qi)
#pragma unroll
    for (int s = 0; s < 4; ++s) {
      bf16x8 raw = ld8(PROJ + ((size_t)b * SEQL + t0 + 32 * qi + lq5) * NPJ + C_SQ + h * 64 + 16 * s + 8 * hf);
#pragma unroll
      for (int e = 0; e < 8; ++e) raw[e] = (short)f2bf(bfs(raw[e]) * 0.125f);
      qf[qi][s] = raw;
    }
  f32x16 oacc[2][2];
#pragma unroll
  for (int i = 0; i < 16; ++i) { oacc[0][0][i] = 0.f; oacc[0][1][i] = 0.f; oacc[1][0][i] = 0.f; oacc[1][1][i] = 0.f; }
  float carry[2] = {1.f, 1.f};
#pragma unroll 1
  for (int k0 = t0 + 32; k0 >= 0; k0 -= 32) {
    const size_t krow = ((size_t)b * SEQL + k0 + lq5) * NPJ + C_SK + h * 64;
    {
      bf16x8 v0 = ld8(PROJ + krow + 512 + hf * 32), v1 = ld8(PROJ + krow + 512 + hf * 32 + 8);
      bf16x8 v2 = ld8(PROJ + krow + 512 + hf * 32 + 16), v3 = ld8(PROJ + krow + 512 + hf * 32 + 24);
#pragma unroll
      for (int e = 0; e < 8; ++e) {
        VT[(hf * 32 + e) * 40 + lq5] = (u16)v0[e]; VT[(hf * 32 + 8 + e) * 40 + lq5] = (u16)v1[e];
        VT[(hf * 32 + 16 + e) * 40 + lq5] = (u16)v2[e]; VT[(hf * 32 + 24 + e) * 40 + lq5] = (u16)v3[e];
      }
    }
    bf16x8 kf[4];
#pragma unroll
    for (int s = 0; s < 4; ++s) kf[s] = ld8(PROJ + krow + 16 * s + 8 * hf);
#pragma unroll
    for (int qi = 0; qi < 2; ++qi) {
      if (k0 >= t0 + 32 * qi + 31) continue;
      f32x16 st;
#pragma unroll
      for (int i = 0; i < 16; ++i) st[i] = 0.f;
#pragma unroll
      for (int s = 0; s < 4; ++s) st = mfma32(kf[s], qf[qi][s], st);
      const int t = t0 + 32 * qi + lq5;
      float m[16];
#pragma unroll
      for (int i = 0; i < 16; ++i) {
        const float z = fminf(fmaxf(st[i], -80.f), 80.f);
        const float e = __expf(z);
        const float r = __builtin_amdgcn_rcpf(1.f + e);
        const bool c = (k0 + crow(i, hf)) < t;
        m[i] = c ? r : 1.f;
        st[i] = c ? e * r : 0.f;
      }
      float T[4], P[4];
#pragma unroll
      for (int gi = 0; gi < 4; ++gi) { T[gi] = (m[4 * gi] * m[4 * gi + 1]) * (m[4 * gi + 2] * m[4 * gi + 3]); P[gi] = __shfl_xor(T[gi], 32); }
      float aft[4];
      aft[3] = (hf == 0) ? P[3] : 1.f;
      aft[2] = T[3] * P[3] * ((hf == 0) ? P[2] : 1.f);
      aft[1] = T[3] * P[3] * T[2] * P[2] * ((hf == 0) ? P[1] : 1.f);
      aft[0] = T[3] * P[3] * T[2] * P[2] * T[1] * P[1] * ((hf == 0) ? P[0] : 1.f);
      const float cin = carry[qi];
#pragma unroll
      for (int gi = 0; gi < 4; ++gi) {
        const float base = cin * aft[gi];
        const float w2 = m[4 * gi + 3], w1 = w2 * m[4 * gi + 2], w0 = w1 * m[4 * gi + 1];
        st[4 * gi + 0] *= base * w0;
        st[4 * gi + 1] *= base * w1;
        st[4 * gi + 2] *= base * w2;
        st[4 * gi + 3] *= base;
      }
      carry[qi] = cin * ((T[0] * P[0]) * (T[1] * P[1])) * ((T[2] * P[2]) * (T[3] * P[3]));
#pragma unroll
      for (int s = 0; s < 2; ++s) {
        bf16x8 pf = pack8(st, s);
#pragma unroll
        for (int dt = 0; dt < 2; ++dt) {
          const u16* vp = VT + (32 * dt + lq5) * 40 + 16 * s + 4 * hf;
          s16x4 lo = ld4(vp), hi = ld4(vp + 8);
          bf16x8 vf = __builtin_shufflevector(lo, hi, 0, 1, 2, 3, 4, 5, 6, 7);
          oacc[qi][dt] = mfma32(vf, pf, oacc[qi][dt]);
        }
      }
    }
    if (k0 <= t0 && __all(carry[0] < 1.2e-38f && carry[1] < 1.2e-38f)) break;
  }
#pragma unroll
  for (int qi = 0; qi < 2; ++qi)
#pragma unroll
    for (int dt = 0; dt < 2; ++dt)
#pragma unroll
      for (int g4 = 0; g4 < 4; ++g4)
        *(s16x4*)(PROJ + ((size_t)b * SEQL + t0 + 32 * qi + lq5) * NPJ + C_SQ + h * 64 + 32 * dt + 8 * g4 + 4 * hf) =
            pack4(oacc[qi][dt][4 * g4], oacc[qi][dt][4 * g4 + 1], oacc[qi][dt][4 * g4 + 2], oacc[qi][dt][4 * g4 + 3]);
}

static __device__ __attribute__((always_inline)) inline void nsa_compress(const Params& p, int l, int item) {
  char* ws = lsp(p.ws);
  const u16* PROJ = (const u16*)(ws + OFF_PROJ);
  u16* KC = (u16*)(ws + OFF_KC); u16* VCT = (u16*)(ws + OFF_VCT);
  const u16* WT = (const u16*)(ws + OFF_WT); const float* CB = (const float*)(ws + OFF_CB);
  float* red = (float*)lds_base();
  const int tid = lv(threadIdx.x), lane = tid & 63, w = tid >> 6, lq5 = lane & 31, hf = lane >> 5;
  const int nt4 = item & 3, kv = (item >> 2) & 1, g = (item >> 3) & 1, b = item >> 4;
  const int n = 32 * nt4 + lq5;
  f32x16 acc[2];
#pragma unroll
  for (int i = 0; i < 16; ++i) { acc[0][i] = 0.f; acc[1][i] = 0.f; }
#pragma unroll 4
  for (int ks = 0; ks < 16; ++ks) {
    const int ll = 4 * w + (ks >> 2), d0 = (ks & 3) * 16 + 8 * hf;
    bf16x8 a;
#pragma unroll
    for (int e = 0; e < 8; ++e) a[e] = 0;
    if (n < 127) a = ld8(PROJ + ((size_t)b * SEQL + 16 * n + ll) * NPJ + C_NKV + kv * 128 + g * 64 + d0);
#pragma unroll
    for (int et = 0; et < 2; ++et)
      acc[et] = mfma32(a, ld8(WT + ((size_t)(kv * 64 + 32 * et + lq5)) * 2048 + ll * 64 + d0), acc[et]);
  }
#pragma unroll
  for (int et = 0; et < 2; ++et)
#pragma unroll
    for (int i = 0; i < 16; ++i) red[(w * 32 + crow(i, hf)) * 64 + 32 * et + lq5] = acc[et][i];
  __syncthreads();
  {
    const int nl = tid >> 4, e0 = (tid & 15) * 4;
    float v[4];
#pragma unroll
    for (int q = 0; q < 4; ++q) v[q] = CB[kv * 64 + e0 + q];
#pragma unroll
    for (int ww = 0; ww < 8; ++ww)
#pragma unroll
      for (int q = 0; q < 4; ++q) v[q] += red[(ww * 32 + nl) * 64 + e0 + q];
    const int nn = 32 * nt4 + nl;
    if (nn >= 127) { v[0] = 0.f; v[1] = 0.f; v[2] = 0.f; v[3] = 0.f; }
    if (kv == 0) *(s16x4*)(KC + ((size_t)(b * 2 + g) * 128 + nn) * 64 + e0) = pack4(v[0], v[1], v[2], v[3]);
    else {
#pragma unroll
      for (int q = 0; q < 4; ++q) VCT[((size_t)(b * 2 + g) * 64 + e0 + q) * 128 + nn] = f2bf(v[q]);
    }
  }
  __syncthreads();
}

static __device__ __attribute__((always_inline)) inline void gdn_prep(const Params& p, int l, int item) {
  char* ws = lsp(p.ws);
  u16* PROJ = (u16*)(ws + OFF_PROJ); u16* HALO = (u16*)(ws + OFF_HALO);
  u16* WG = (u16*)(ws + OFF_SCR); u16* ATT = (u16*)(ws + OFF_SCR + 16777216);
  float* EGL = (float*)(ws + OFF_EGL);
  u16* Qb = (u16*)lds_base();
  u16* Kb = Qb + 64 * 136;
  u16* vbT = Kb + 64 * 136;
  u16* kbT = vbT + 128 * 72;
  float* As = (float*)(kbT + 128 * 72);
  u16* Tb = (u16*)(As + 64 * 65);
  float* sg = (float*)(Tb + 64 * 72);
  float* sbeta = sg + 64; float* sgc = sbeta + 64;
  const int tid = lv(threadIdx.x), lane = tid & 63, w = tid >> 6, lr = lane & 15, lq = lane >> 4;
  const int c = item & 31, h = (item >> 5) & 3, b = item >> 7;
  const int t0 = b * SEQL + c * 64;
  const int i = tid & 63, cgp = tid >> 6;
  const float* cw = p.conv_w + (size_t)l * 4 * 1536;
  if (tid < 64) {
    float a = bf2f(PROJ[(size_t)(t0 + tid) * NPJ + C_GA + h]);
    float bt = bf2f(PROJ[(size_t)(t0 + tid) * NPJ + C_GB + h]);
    sg[tid] = -__expf(p.a_log[l * 4 + h]) * softplusf_(a + p.dt_bias[l * 4 + h]);
    sbeta[tid] = sigmoidf_(bt);
  }
  float qkv[3][16];
  {
    bf16x8 xr[3][4][2];
#pragma unroll
    for (int sec = 0; sec < 3; ++sec)
#pragma unroll
      for (int j = 0; j < 4; ++j) {
        const int colb = sec * 512 + h * 128 + cgp * 16;
        const int ii = i - 3 + j;
        const u16* src = (ii >= 0) ? PROJ + (size_t)(t0 + ii) * NPJ + colb
                                   : HALO + ((size_t)(max(t0 >> 6, 1) - 1) * 3 + (3 + ii)) * 1536 + colb;
        xr[sec][j][0] = ld8(src); xr[sec][j][1] = ld8(src + 8);
      }
#pragma unroll
    for (int sec = 0; sec < 3; ++sec) {
      const int colb = sec * 512 + h * 128 + cgp * 16;
#pragma unroll
      for (int e = 0; e < 16; ++e) qkv[sec][e] = 0.f;
#pragma unroll
      for (int j = 0; j < 4; ++j) {
        const int ii = i - 3 + j;
        const float keep = (ii >= 0 || c > 0) ? 1.f : 0.f;
#pragma unroll
        for (int e = 0; e < 8; ++e) {
          qkv[sec][e] += (keep * cw[j * 1536 + colb + e]) * bfs(xr[sec][j][0][e]);
          qkv[sec][8 + e] += (keep * cw[j * 1536 + colb + 8 + e]) * bfs(xr[sec][j][1][e]);
        }
      }
#pragma unroll
      for (int e = 0; e < 16; ++e) { float x = qkv[sec][e]; qkv[sec][e] = x * __builtin_amdgcn_rcpf(1.f + __expf(-x)); }
    }
  }
  {
    float sq = 0.f, sk = 0.f;
#pragma unroll
    for (int e = 0; e < 16; ++e) { sq += qkv[0][e] * qkv[0][e]; sk += qkv[1][e] * qkv[1][e]; }
    float* rdn = As;
    rdn[(0 * 8 + cgp) * 64 + i] = sq; rdn[(1 * 8 + cgp) * 64 + i] = sk;
    __syncthreads();
    sq = 0.f; sk = 0.f;
#pragma unroll
    for (int cc = 0; cc < 8; ++cc) { sq += rdn[(0 * 8 + cc) * 64 + i]; sk += rdn[(1 * 8 + cc) * 64 + i]; }
    float rq = rsqrtf(sq + 1e-6f) * 0.08838834764831845f, rk = rsqrtf(sk + 1e-6f);
#pragma unroll
    for (int e = 0; e < 16; ++e) { qkv[0][e] *= rq; qkv[1][e] *= rk; }
  }
  if (tid < 64) {
    float sc_ = sg[tid];
#pragma unroll
    for (int o = 1; o < 64; o <<= 1) { float t = __shfl_up(sc_, o); if (lane >= o) sc_ += t; }
    sgc[tid] = sc_;
    if (tid == 63) EGL[item] = __expf(sc_);
  }
  __syncthreads();
  {
    const float gci = sgc[i], gl = sgc[63], bi = sbeta[i];
    const float eg = __expf(gci), ekd = __expf(gl - gci);
    bf16x8 a0, a1, b0, b1, c0, c1, d0, d1;
#pragma unroll
    for (int e = 0; e < 8; ++e) {
      a0[e] = (short)f2bf(qkv[0][e]); a1[e] = (short)f2bf(qkv[0][8 + e]);
      b0[e] = (short)f2bf(qkv[1][e]); b1[e] = (short)f2bf(qkv[1][8 + e]);
      c0[e] = (short)f2bf(qkv[0][e] * eg); c1[e] = (short)f2bf(qkv[0][8 + e] * eg);
      d0[e] = (short)f2bf(qkv[1][e] * ekd); d1[e] = (short)f2bf(qkv[1][8 + e] * ekd);
    }
    *(bf16x8*)(Qb + i * 136 + cgp * 16) = a0; *(bf16x8*)(Qb + i * 136 + cgp * 16 + 8) = a1;
    *(bf16x8*)(Kb + i * 136 + cgp * 16) = b0; *(bf16x8*)(Kb + i * 136 + cgp * 16 + 8) = b1;
    u16* gq = PROJ + (size_t)(t0 + i) * NPJ + C_GQ + h * 128 + cgp * 16;
    u16* gk = PROJ + (size_t)(t0 + i) * NPJ + C_GK + h * 128 + cgp * 16;
    *(bf16x8*)gq = c0; *(bf16x8*)(gq + 8) = c1;
    *(bf16x8*)gk = d0; *(bf16x8*)(gk + 8) = d1;
#pragma unroll
    for (int e = 0; e < 16; ++e) {
      vbT[(cgp * 16 + e) * 72 + i] = f2bf(qkv[2][e] * bi);
      kbT[(cgp * 16 + e) * 72 + i] = f2bf(qkv[1][e] * bi * eg);
    }
  }
  __syncthreads();
#pragma unroll 1
  for (int jj = 0; jj < 2; ++jj) {
    const int tile = w * 2 + jj, ti = tile >> 2, tj = tile & 3;
    f32x4 acc = {0.f, 0.f, 0.f, 0.f};
    if (tj <= ti) {
#pragma unroll
      for (int ks = 0; ks < 4; ++ks)
        acc = mfma16(ld8(Kb + (ti * 16 + lr) * 136 + ks * 32 + lq * 8), ld8(Kb + (tj * 16 + lr) * 136 + ks * 32 + lq * 8), acc);
    }
    const int j = tj * 16 + lr;
#pragma unroll
    for (int r = 0; r < 4; ++r) {
      const int ir = ti * 16 + lq * 4 + r;
      As[ir * 65 + j] = (j < ir) ? sbeta[ir] * acc[r] * __expf(sgc[ir] - sgc[j]) : 0.f;
    }
  }
  __syncthreads();
  if (w != 0) {
#pragma unroll 1
    for (int tile = w - 1; tile < 16; tile += 7) {
      const int ti = tile >> 2, tj = tile & 3;
      f32x4 acc = {0.f, 0.f, 0.f, 0.f};
      if (tj <= ti) {
#pragma unroll
        for (int ks = 0; ks < 4; ++ks)
          acc = mfma16(ld8(Qb + (ti * 16 + lr) * 136 + ks * 32 + lq * 8), ld8(Kb + (tj * 16 + lr) * 136 + ks * 32 + lq * 8), acc);
      }
      const int j = tj * 16 + lr;
#pragma unroll
      for (int r = 0; r < 4; ++r) {
        const int ir = ti * 16 + lq * 4 + r;
        const float dec = (j <= ir) ? __expf(sgc[ir] - sgc[j]) : 0.f;
        ATT[(size_t)item * 4096 + ir * 64 + j] = f2bf(acc[r] * dec);
      }
    }
  }
  if (w == 0) {
    float Ar[64], Tc[64];
#pragma unroll
    for (int ir = 0; ir < 64; ++ir) Ar[ir] = As[ir * 65 + lane];
#pragma unroll
    for (int ir = 0; ir < 64; ++ir) {
      float sacc = (ir == lane) ? 1.f : 0.f;
#pragma unroll
      for (int j = 0; j < ir; ++j) sacc -= __uint_as_float(__builtin_amdgcn_readlane(__float_as_uint(Ar[ir]), j)) * Tc[j];
      Tc[ir] = sacc;
    }
#pragma unroll
    for (int ir = 0; ir < 64; ++ir) Tb[ir * 72 + lane] = f2bf(Tc[ir]);
  }
  __syncthreads();
#pragma unroll 1
  for (int jj = 0; jj < 8; ++jj) {
    const int job = w * 8 + jj, which = job >> 5, tile = job & 31, ti = tile >> 3, tn = tile & 7;
    const u16* BT = which ? kbT : vbT;
    f32x4 acc = {0.f, 0.f, 0.f, 0.f};
#pragma unroll
    for (int ks = 0; ks < 2; ++ks)
      acc = mfma16(ld8(Tb + (ti * 16 + lr) * 72 + ks * 32 + lq * 8), ld8(BT + (tn * 16 + lr) * 72 + ks * 32 + lq * 8), acc);
    const int d = tn * 16 + lr;
#pragma unroll
    for (int r = 0; r < 4; ++r) {
      const int ir = ti * 16 + lq * 4 + r;
      if (which == 0) PROJ[(size_t)(t0 + ir) * NPJ + C_GV + h * 128 + d] = f2bf(acc[r]);
      else WG[(size_t)(t0 + ir) * 512 + h * 128 + d] = f2bf(acc[r]);
    }
  }
  __syncthreads();
}

static __device__ __attribute__((always_inline)) inline void gdn_scan(const Params& p, int l, int bh) {
  char* ws = lsp(p.ws);
  u16* PROJ = (u16*)(ws + OFF_PROJ);
  const u16* WG = (const u16*)(ws + OFF_SCR); const u16* ATT = (const u16*)(ws + OFF_SCR + 16777216);
  const float* EGL = (const float*)(ws + OFF_EGL);
  u16* St = (u16*)lds_base();
  u16* Wl = St + 128 * 136;
  u16* Ql = Wl + 64 * 136;
  u16* KdT = Ql + 64 * 136;
  u16* VnT = KdT + 128 * 72;
  u16* At = VnT + 128 * 72;
  float* red = (float*)(At + 64 * 72);
  float* egls = red + 128;
  const int tid = lv(threadIdx.x), lane = tid & 63, w = tid >> 6, lr = lane & 15, lq = lane >> 4;
  const int b = bh >> 2, h = bh & 3;
  const float* ng = p.norm_g + l * 128;
  f32x4 S[8];
#pragma unroll
  for (int v = 0; v < 8; ++v) S[v] = f32x4{0.f, 0.f, 0.f, 0.f};
  for (int idx = tid; idx < 128 * 136; idx += 512) St[idx] = 0;
  const int it = w >> 1, vb = (w & 1) * 4;
  float ngv[4];
#pragma unroll
  for (int n = 0; n < 4; ++n) ngv[n] = ng[(vb + n) * 16 + lr];
  const int r0 = tid >> 4, seg0 = tid & 15;
  const int ra = tid >> 3, sega = tid & 7;
  bf16x8 pw[2], pq[2], pk[2], pa;
  u16 un[16];
  {
    const int t0 = b * SEQL;
#pragma unroll
    for (int rep = 0; rep < 2; ++rep) {
      const int r = r0 + rep * 32;
      pw[rep] = ld8(WG + (size_t)(t0 + r) * 512 + h * 128 + seg0 * 8);
      pq[rep] = ld8(PROJ + (size_t)(t0 + r) * NPJ + C_GQ + h * 128 + seg0 * 8);
      pk[rep] = ld8(PROJ + (size_t)(t0 + r) * NPJ + C_GK + h * 128 + seg0 * 8);
    }
    pa = ld8(ATT + (size_t)(bh * 32) * 4096 + ra * 64 + sega * 8);
#pragma unroll
    for (int n = 0; n < 4; ++n)
#pragma unroll
      for (int r = 0; r < 4; ++r)
        un[n * 4 + r] = PROJ[(size_t)(t0 + it * 16 + lq * 4 + r) * NPJ + C_GV + h * 128 + (vb + n) * 16 + lr];
    if (tid < 32) egls[tid] = EGL[bh * 32 + tid];
  }
#pragma unroll 1
  for (int c = 0; c < 32; ++c) {
    const int t0 = b * SEQL + c * 64;
#pragma unroll
    for (int rep = 0; rep < 2; ++rep) {
      const int r = r0 + rep * 32;
      *(bf16x8*)(Wl + r * 136 + seg0 * 8) = pw[rep];
      *(bf16x8*)(Ql + r * 136 + seg0 * 8) = pq[rep];
#pragma unroll
      for (int e = 0; e < 8; ++e) KdT[(seg0 * 8 + e) * 72 + r] = (u16)pk[rep][e];
    }
    *(bf16x8*)(At + ra * 72 + sega * 8) = pa;
    u16 uc[16], zc[16];
#pragma unroll
    for (int q = 0; q < 16; ++q) uc[q] = un[q];
#pragma unroll
    for (int n = 0; n < 4; ++n)
#pragma unroll
      for (int r = 0; r < 4; ++r)
        zc[n * 4 + r] = PROJ[(size_t)(t0 + it * 16 + lq * 4 + r) * NPJ + C_GZ + h * 128 + (vb + n) * 16 + lr];
    lds_barrier();
    if (c + 1 < 32) {
      const int t1 = t0 + 64;
#pragma unroll
      for (int rep = 0; rep < 2; ++rep) {
        const int r = r0 + rep * 32;
        pw[rep] = ld8(WG + (size_t)(t1 + r) * 512 + h * 128 + seg0 * 8);
        pq[rep] = ld8(PROJ + (size_t)(t1 + r) * NPJ + C_GQ + h * 128 + seg0 * 8);
        pk[rep] = ld8(PROJ + (size_t)(t1 + r) * NPJ + C_GK + h * 128 + seg0 * 8);
      }
      pa = ld8(ATT + (size_t)(bh * 32 + c + 1) * 4096 + ra * 64 + sega * 8);
#pragma unroll
      for (int n = 0; n < 4; ++n)
#pragma unroll
        for (int r = 0; r < 4; ++r)
          un[n * 4 + r] = PROJ[(size_t)(t1 + it * 16 + lq * 4 + r) * NPJ + C_GV + h * 128 + (vb + n) * 16 + lr];
    }
    f32x4 vacc[4], oacc[4];
#pragma unroll
    for (int n = 0; n < 4; ++n) { vacc[n] = f32x4{0.f, 0.f, 0.f, 0.f}; oacc[n] = f32x4{0.f, 0.f, 0.f, 0.f}; }
#pragma unroll
    for (int ks = 0; ks < 4; ++ks) {
      bf16x8 aw = ld8(Wl + (it * 16 + lr) * 136 + ks * 32 + lq * 8);
      bf16x8 aq = ld8(Ql + (it * 16 + lr) * 136 + ks * 32 + lq * 8);
#pragma unroll
      for (int n = 0; n < 4; ++n) {
        bf16x8 bs = ld8(St + ((vb + n) * 16 + lr) * 136 + ks * 32 + lq * 8);
        vacc[n] = mfma16(aw, bs, vacc[n]);
        oacc[n] = mfma16(aq, bs, oacc[n]);
      }
    }
#pragma unroll
    for (int n = 0; n < 4; ++n) {
      const int v = (vb + n) * 16 + lr;
      *(s16x4*)(VnT + v * 72 + it * 16 + lq * 4) =
          pack4(bf2f(uc[n * 4 + 0]) - vacc[n][0], bf2f(uc[n * 4 + 1]) - vacc[n][1], bf2f(uc[n * 4 + 2]) - vacc[n][2], bf2f(uc[n * 4 + 3]) - vacc[n][3]);
    }
    lds_barrier();
#pragma unroll
    for (int ks = 0; ks < 2; ++ks) {
      bf16x8 aa = ld8(At + (it * 16 + lr) * 72 + ks * 32 + lq * 8);
#pragma unroll
      for (int n = 0; n < 4; ++n)
        oacc[n] = mfma16(aa, ld8(VnT + ((vb + n) * 16 + lr) * 72 + ks * 32 + lq * 8), oacc[n]);
    }
    {
      bf16x8 ak0 = ld8(KdT + (w * 16 + lr) * 72 + lq * 8), ak1 = ld8(KdT + (w * 16 + lr) * 72 + 32 + lq * 8);
#pragma unroll
      for (int vt = 0; vt < 8; ++vt) {
        f32x4 a = S[vt] * egls[c];
        a = mfma16(ak0, ld8(VnT + (vt * 16 + lr) * 72 + lq * 8), a);
        a = mfma16(ak1, ld8(VnT + (vt * 16 + lr) * 72 + 32 + lq * 8), a);
        S[vt] = a;
        *(s16x4*)(St + (vt * 16 + lr) * 136 + w * 16 + lq * 4) = pack4(a[0], a[1], a[2], a[3]);
      }
    }
    {
      float ssr[4];
#pragma unroll
      for (int r = 0; r < 4; ++r) {
        float sq = 0.f;
#pragma unroll
        for (int n = 0; n < 4; ++n) sq += oacc[n][r] * oacc[n][r];
        sq += __shfl_xor(sq, 1); sq += __shfl_xor(sq, 2); sq += __shfl_xor(sq, 4); sq += __shfl_xor(sq, 8);
        ssr[r] = sq;
      }
      if (lr == 0) {
#pragma unroll
        for (int r = 0; r < 4; ++r) red[(it * 16 + lq * 4 + r) * 2 + (w & 1)] = ssr[r];
      }
    }
    lds_barrier();
#pragma unroll
    for (int r = 0; r < 4; ++r) {
      const int ir = it * 16 + lq * 4 + r;
      const float rs = rsqrtf((red[ir * 2] + red[ir * 2 + 1]) * (1.f / 128.f) + 1e-6f);
#pragma unroll
      for (int n = 0; n < 4; ++n) {
        const int v = (vb + n) * 16 + lr;
        const float z = bf2f(zc[n * 4 + r]);
        const float y = oacc[n][r] * rs * ngv[n] * z * __builtin_amdgcn_rcpf(1.f + __expf(-z));
        PROJ[(size_t)(t0 + ir) * NPJ + C_GV + h * 128 + v] = f2bf(y);
      }
    }
  }
  __syncthreads();
}


static __device__ __attribute__((always_inline)) inline void nsa_attn(const Params& p, int item) {
  char* ws = lsp(p.ws);
  u16* PROJ = (u16*)(ws + OFF_PROJ);
  const u16* KC = (const u16*)(ws + OFF_KC); const u16* VCT = (const u16*)(ws + OFF_VCT);
  u16* Ks = (u16*)lds_base();
  float* impw = (float*)(Ks + 4 * 64 * 72);
  unsigned* selm = (unsigned*)(impw + 4 * 64 * 32);
  unsigned* uni = selm + 64;
  const int tid = lv(threadIdx.x), lane = tid & 63, w = tid >> 6;
  const int hh = w & 3, qhalf = w >> 2, lq5 = lane & 31, hf = lane >> 5;
  const int qb = 31 - (item >> 4), bg = item & 15, b = bg >> 1, g = bg & 1;
  const int ql = qhalf * 32 + lq5, tpos = qb * 64 + ql;
  const size_t row = (size_t)b * SEQL + tpos;
  const int head = g * 4 + hh;
  bf16x8 qf[4];
#pragma unroll
  for (int s = 0; s < 4; ++s) {
    bf16x8 raw = ld8(PROJ + row * NPJ + C_NQ + head * 64 + 16 * s + 8 * hf);
#pragma unroll
    for (int e = 0; e < 8; ++e) raw[e] = (short)f2bf(bfs(raw[e]) * 0.125f);
    qf[s] = raw;
  }
  if (tid == 0) *uni = 0u;
  float gate[3];
#pragma unroll
  for (int i = 0; i < 3; ++i) gate[i] = sigmoidf_(bf2f(PROJ[row * NPJ + C_NG + head * 3 + i]));
  f32x16 ofin[2];
  {
    f32x16 sc[4];
    const u16* kcb = KC + (size_t)(b * 2 + g) * 128 * 64;
#pragma unroll
    for (int mt = 0; mt < 4; ++mt) {
#pragma unroll
      for (int i = 0; i < 16; ++i) sc[mt][i] = 0.f;
#pragma unroll
      for (int s = 0; s < 4; ++s) sc[mt] = mfma32(ld8(kcb + (32 * mt + lq5) * 64 + 16 * s + 8 * hf), qf[s], sc[mt]);
    }
    const int nlim = (tpos >= 31) ? min(126, (tpos - 31) >> 4) : -1;
    float mx = -1e30f;
#pragma unroll
    for (int mt = 0; mt < 4; ++mt)
#pragma unroll
      for (int i = 0; i < 16; ++i) { int n = 32 * mt + crow(i, hf); if (n <= nlim) mx = fmaxf(mx, sc[mt][i]); }
    mx = fmaxf(mx, __shfl_xor(mx, 32));
    float ls = 0.f;
#pragma unroll
    for (int mt = 0; mt < 4; ++mt)
#pragma unroll
      for (int i = 0; i < 16; ++i) {
        int n = 32 * mt + crow(i, hf);
        float pv = (n <= nlim) ? __expf(sc[mt][i] - mx) : 0.f;
        sc[mt][i] = pv; ls += pv;
      }
    ls += __shfl_xor(ls, 32);
    const float inv = ls > 0.f ? 1.f / ls : 0.f;
#pragma unroll
    for (int mt = 0; mt < 4; ++mt)
#pragma unroll
      for (int i = 0; i < 16; ++i) sc[mt][i] *= inv;
    f32x16 oc[2];
#pragma unroll
    for (int i = 0; i < 16; ++i) { oc[0][i] = 0.f; oc[1][i] = 0.f; }
    const u16* vcb = VCT + (size_t)(b * 2 + g) * 64 * 128;
#pragma unroll
    for (int mt = 0; mt < 4; ++mt)
#pragma unroll
      for (int s = 0; s < 2; ++s) {
        bf16x8 pf = pack8(sc[mt], s);
#pragma unroll
        for (int dt = 0; dt < 2; ++dt) {
          const u16* vp = vcb + (32 * dt + lq5) * 128 + 32 * mt + 16 * s + 4 * hf;
          s16x4 lo = ld4(vp), hi = ld4(vp + 8);
          bf16x8 vf = __builtin_shufflevector(lo, hi, 0, 1, 2, 3, 4, 5, 6, 7);
          oc[dt] = mfma32(vf, pf, oc[dt]);
        }
      }
#pragma unroll
    for (int i = 0; i < 16; ++i) { ofin[0][i] = gate[0] * oc[0][i]; ofin[1][i] = gate[0] * oc[1][i]; }
    float G[4][4], rl[4][4];
#pragma unroll
    for (int mt = 0; mt < 4; ++mt)
#pragma unroll
      for (int gi = 0; gi < 4; ++gi) {
        G[mt][gi] = sc[mt][4 * gi] + sc[mt][4 * gi + 1] + sc[mt][4 * gi + 2] + sc[mt][4 * gi + 3];
        rl[mt][gi] = __shfl_xor(sc[mt][4 * gi + 3], 32);
      }
#pragma unroll
    for (int mt = 0; mt < 4; ++mt)
#pragma unroll
      for (int gi = 0; gi < 4; ++gi) {
        float prev;
        if (hf == 1) prev = rl[mt][gi];
        else prev = (gi > 0) ? rl[mt][gi > 0 ? gi - 1 : 0] : (mt > 0 ? rl[mt > 0 ? mt - 1 : 0][3] : 0.f);
        impw[(hh * 64 + ql) * 32 + 8 * mt + 2 * gi + hf] = G[mt][gi] + prev;
      }
  }
  __syncthreads();
  if (tid < 64) {
    float scv[32];
#pragma unroll
    for (int j = 0; j < 32; ++j) {
      float v = impw[(0 * 64 + tid) * 32 + j] + impw[(1 * 64 + tid) * 32 + j] + impw[(2 * 64 + tid) * 32 + j] + impw[(3 * 64 + tid) * 32 + j];
      if (j == 0 || j == qb || j == qb - 1) v += 1000.f;
      scv[j] = (j <= qb) ? v : -1e30f;
    }
    unsigned m = 0u;
#pragma unroll 1
    for (int k = 0; k < 8; ++k) {
      float bv = -1e29f; int best = -1;
#pragma unroll
      for (int j = 0; j < 32; ++j) { bool take = !((m >> j) & 1u) && scv[j] > bv; bv = take ? scv[j] : bv; best = take ? j : best; }
      if (best >= 0) m |= 1u << best;
    }
    selm[tid] = m;
    atomicOr(uni, m);
  }
  __syncthreads();
  const unsigned U = *uni;
  const unsigned sm = selm[ql];
#pragma unroll 1
  for (int mode = 0; mode < 2; ++mode) {
    float mrun = -1e30f, lrun = 0.f;
    f32x16 oacc[2];
#pragma unroll
    for (int i = 0; i < 16; ++i) { oacc[0][i] = 0.f; oacc[1][i] = 0.f; }
    const unsigned tmask = mode ? ((2u << qb) - 1u) & ~((1u << max(0, qb - 8)) - 1u) : U;
    const int r_ld = 32 * (w & 1) + (lane & 31), seg_ld = (w >> 1) * 2 + (lane >> 5);
    const int kcol = C_NKV + (mode ? 4 : 2) * 128 + g * 64 + seg_ld * 8;
    unsigned rem = tmask;
    int j = __ffs(rem) - 1;
    rem &= rem - 1u;
    bf16x8 kreg = ld8(PROJ + ((size_t)b * SEQL + 64 * j + r_ld) * NPJ + kcol);
    bf16x8 vreg = ld8(PROJ + ((size_t)b * SEQL + 64 * j + r_ld) * NPJ + kcol + 128);
    int buf = 0;
#pragma unroll 1
    while (j >= 0) {
      u16* Kb_ = Ks + buf * (2 * 64 * 72);
      u16* Vb_ = Kb_ + 64 * 72;
      *(bf16x8*)(Kb_ + r_ld * 72 + seg_ld * 8) = kreg;
#pragma unroll
      for (int e = 0; e < 8; ++e) Vb_[(seg_ld * 8 + e) * 72 + r_ld] = (u16)vreg[e];
      __syncthreads();
      const int jn = rem ? (__ffs(rem) - 1) : -1;
      rem &= rem - 1u;
      if (jn >= 0) {
        kreg = ld8(PROJ + ((size_t)b * SEQL + 64 * jn + r_ld) * NPJ + kcol);
        vreg = ld8(PROJ + ((size_t)b * SEQL + 64 * jn + r_ld) * NPJ + kcol + 128);
      }
      const bool selj = mode ? true : (((sm >> j) & 1u) != 0u);
      if (mode || __any(selj)) {
        f32x16 st[2];
#pragma unroll
        for (int mt = 0; mt < 2; ++mt) {
#pragma unroll
          for (int i = 0; i < 16; ++i) st[mt][i] = 0.f;
#pragma unroll
          for (int s = 0; s < 4; ++s) st[mt] = mfma32(ld8(Kb_ + (32 * mt + lq5) * 72 + 16 * s + 8 * hf), qf[s], st[mt]);
        }
        const bool need_mask = (j == qb) || (mode && j == qb - 8);
        float mloc = -1e30f;
        if (need_mask) {
#pragma unroll
          for (int mt = 0; mt < 2; ++mt)
#pragma unroll
            for (int i = 0; i < 16; ++i) {
              const int dist = tpos - (64 * j + 32 * mt + crow(i, hf));
              const bool ok = selj && dist >= 0 && dist < 512;
              st[mt][i] = ok ? st[mt][i] : -1e30f;
              mloc = fmaxf(mloc, st[mt][i]);
            }
        } else {
#pragma unroll
          for (int mt = 0; mt < 2; ++mt)
#pragma unroll
            for (int i = 0; i < 16; ++i) mloc = fmaxf(mloc, st[mt][i]);
          mloc = selj ? mloc : -1e30f;
        }
        mloc = fmaxf(mloc, __shfl_xor(mloc, 32));
        const float mnew = fmaxf(mrun, mloc);
        const float alpha = __expf(mrun - mnew);
        const bool live = selj && (mnew > -1e29f);
        float psum = 0.f;
#pragma unroll
        for (int mt = 0; mt < 2; ++mt)
#pragma unroll
          for (int i = 0; i < 16; ++i) {
            float pv = __expf(st[mt][i] - mnew);
            pv = live ? pv : 0.f;
            st[mt][i] = pv; psum += pv;
          }
        lrun = lrun * alpha + psum;
        mrun = mnew;
#pragma unroll
        for (int i = 0; i < 16; ++i) { oacc[0][i] *= alpha; oacc[1][i] *= alpha; }
#pragma unroll
        for (int mt = 0; mt < 2; ++mt)
#pragma unroll
          for (int s = 0; s < 2; ++s) {
            bf16x8 pf = pack8(st[mt], s);
#pragma unroll
            for (int dt = 0; dt < 2; ++dt) {
              const u16* vp = Vb_ + (32 * dt + lq5) * 72 + 32 * mt + 16 * s + 4 * hf;
              s16x4 lo = ld4(vp), hi = ld4(vp + 8);
              bf16x8 vf = __builtin_shufflevector(lo, hi, 0, 1, 2, 3, 4, 5, 6, 7);
              oacc[dt] = mfma32(vf, pf, oacc[dt]);
            }
          }
      }
      buf ^= 1;
      j = jn;
    }
    const float ltot = lrun + __shfl_xor(lrun, 32);
    const float sc_ = (ltot > 0.f) ? gate[1 + mode] / ltot : 0.f;
#pragma unroll
    for (int i = 0; i < 16; ++i) { ofin[0][i] += sc_ * oacc[0][i]; ofin[1][i] += sc_ * oacc[1][i]; }
    __syncthreads();
  }
#pragma unroll
  for (int dt = 0; dt < 2; ++dt)
#pragma unroll
    for (int g4 = 0; g4 < 4; ++g4)
      *(s16x4*)(PROJ + row * NPJ + C_NQ + head * 64 + 32 * dt + 8 * g4 + 4 * hf) =
          pack4(ofin[dt][4 * g4], ofin[dt][4 * g4 + 1], ofin[dt][4 * g4 + 2], ofin[dt][4 * g4 + 3]);
  __syncthreads();
}

static __device__ __attribute__((always_inline)) inline void phase_merge(const Params& p) {
  char* ws = lsp(p.ws);
  u16* H = (u16*)(ws + OFF_H); u16* WinT = (u16*)(ws + OFF_WBIG); u16* PROJ = (u16*)(ws + OFF_PROJ);
  u16* WbrT = (u16*)(ws + OFF_WBR); u16* M = (u16*)(ws + OFF_SCR);
  const int nM = 64, nN = 4;
  for (int t = blockIdx.x; t < nM * nN; t += gridDim.x) {
    int pm, pn; tile_map(t, nM, nN, pm, pn);
#pragma unroll 1
    for (int i = 0; i < 3; ++i) {
      const int boff = 5120 + i * 1024 + pn * 256;
      gemm_tile(H, 1024, WinT, 1024, 1024, pm * 256, boff, [&](int idx, int row, int col, f32x4 v) {
        *(s16x4*)(PROJ + (size_t)row * NPJ + C_SK + (col - 5120 - i * 1024)) = pack4(sigmoidf_(v[0]), sigmoidf_(v[1]), sigmoidf_(v[2]), sigmoidf_(v[3]));
      });
      const int ycol = (i == 0) ? C_GV : (i == 1 ? C_NQ : C_SQ);
      s16x4 gbuf[2], mbuf[2];
      gemm_tile(PROJ + ycol, NPJ, WbrT + (size_t)i * 1024 * 512, 512, 512, pm * 256, pn * 256, [&](int idx, int row, int col, f32x4 v) {
        const s16x4 gte = gbuf[idx];
        float o0 = bfs(gte[0]) * v[0], o1 = bfs(gte[1]) * v[1], o2 = bfs(gte[2]) * v[2], o3 = bfs(gte[3]) * v[3];
        if (i > 0) { const s16x4 pv = mbuf[idx]; o0 += bfs(pv[0]); o1 += bfs(pv[1]); o2 += bfs(pv[2]); o3 += bfs(pv[3]); }
        *(s16x4*)(M + (unsigned)(row * 1024 + col)) = pack4(o0, o1, o2, o3);
      }, [&](int idx, int row, int col) {
        gbuf[idx] = ld4(PROJ + (unsigned)(row * NPJ + C_SK + col));
        if (i > 0) mbuf[idx] = ld4(M + (unsigned)(row * 1024 + col));
      });
    }
  }
}

template <int MODE>
static __device__ __attribute__((always_inline)) inline void phase_gemm(const u16* A, int lda, const u16* Bt, int ldb, int K, int nM, int nN, u16* C, int ldc) {
  for (int t = blockIdx.x; t < nM * nN; t += gridDim.x) {
    int pm, pn; tile_map(t, nM, nN, pm, pn);
    gemm_tile(A, lda, Bt, ldb, K, pm * 256, pn * 256, [&](int idx, int row, int col, f32x4 v) {
      if (MODE == 1) {
#pragma unroll
        for (int q = 0; q < 4; ++q) { float t = fmaxf(v[q], 0.f); v[q] = t * t; }
      }
      *(s16x4*)(C + (size_t)row * ldc + col) = pack4(v[0], v[1], v[2], v[3]);
    });
  }
}


#define XB_TMO      128
#define XB_XCNT(j)  (256  + 64 * (j))
#define XB_XSUB(j)  (1280 + 64 * (j))
#define XB_XGEN(j)  (2304 + 64 * (j))
#define XB_TOP      3328
#define XB_TOPGEN   3392
#define XCD_BAR_WORDS 3456
#define XB_SPIN_CAP (1u << 18)
#define LAS __attribute__((address_space(3)))
DI unsigned xb_ld(unsigned* q)              { return __hip_atomic_load(q, __ATOMIC_RELAXED, __HIP_MEMORY_SCOPE_AGENT); }
DI unsigned xb_add(unsigned* q, unsigned v) { return __hip_atomic_fetch_add(q, v, __ATOMIC_RELAXED, __HIP_MEMORY_SCOPE_AGENT); }
DI unsigned xb_xcc_id() { return (unsigned)__builtin_amdgcn_s_getreg((3 << 11) | 20) & 0xFu; }
#define XB_SPIN(cond, bar) do { unsigned _sp = 0; while (cond) { __builtin_amdgcn_s_sleep(1); \
    if ((++_sp & 255u) == 0u) { if (xb_ld(&(bar)[XB_TMO])) break; if (_sp > XB_SPIN_CAP) { atomicAdd(&(bar)[XB_TMO], 1u); break; } } } } while (0)
struct XcdBarrier { unsigned* bar; unsigned x; volatile LAS unsigned* st; };
DI XcdBarrier xcd_barrier_post(unsigned* bar, volatile LAS unsigned* st) {
  XcdBarrier b; b.bar = bar; b.x = xb_xcc_id(); b.st = st;
  if (threadIdx.x == 0) (void)xb_add(&bar[XB_XCNT(b.x)], 1u);
  return b;
}
DI void xcd_barrier_complete(unsigned* bar, unsigned x, unsigned& nloc, unsigned& nx) {
  const unsigned G = gridDim.x * gridDim.y * gridDim.z;
  unsigned sum, cnt, mine, sp = 0u;
  for (;;) {
    sum = 0u; cnt = 0u; mine = 0u;
#pragma unroll
    for (unsigned j = 0; j < 16; ++j) { const unsigned c = xb_ld(&bar[XB_XCNT(j)]); sum += c; cnt += (c > 0u) ? 1u : 0u; mine = (j == x) ? c : mine; }
    if (sum == G) break;
    __builtin_amdgcn_s_sleep(1);
    if ((++sp & 255u) == 0u) { if (xb_ld(&bar[XB_TMO])) break; if (sp > XB_SPIN_CAP) { atomicAdd(&bar[XB_TMO], 1u); break; } }
  }
  nloc = mine > 0u ? mine : 1u; nx = cnt > 0u ? cnt : 1u;
}
DI void xcd_barrier(const XcdBarrier& b) {
  asm volatile("s_waitcnt vmcnt(0)" ::: "memory");
  __syncthreads();
  if (threadIdx.x == 0) {
    unsigned* bar = b.bar;
    __builtin_amdgcn_s_waitcnt(0);
    unsigned nloc = b.st[0], nx = b.st[1];
    if (nloc == 0u) { xcd_barrier_complete(bar, b.x, nloc, nx); b.st[0] = nloc; b.st[1] = nx; }
    const unsigned old = xb_add(&bar[XB_XSUB(b.x)], 1u);
    const unsigned gen = old / nloc;
    if (old + 1u == (gen + 1u) * nloc) {
      __builtin_amdgcn_fence(__ATOMIC_RELEASE, "agent");
      asm volatile("s_waitcnt vmcnt(0)" ::: "memory");
      const unsigned og = xb_add(&bar[XB_TOP], 1u);
      const unsigned tg = og / nx;
      if (og + 1u == (tg + 1u) * nx) xb_add(&bar[XB_TOPGEN], 1u);
      else XB_SPIN(xb_ld(&bar[XB_TOPGEN]) == tg, bar);
      __builtin_amdgcn_fence(__ATOMIC_ACQUIRE, "agent");
      xb_add(&bar[XB_XGEN(b.x)], 1u);
      asm volatile("s_waitcnt vmcnt(0)" ::: "memory");
    } else {
      XB_SPIN(xb_ld(&bar[XB_XGEN(b.x)]) == gen, bar);
      __builtin_amdgcn_fence(__ATOMIC_ACQUIRE, "agent");
      asm volatile("s_waitcnt vmcnt(0)" ::: "memory");
    }
  }
  __syncthreads();
}

__global__ void __launch_bounds__(512) fwd_megakernel(Params p_unused) {
#define p (kp())
  cg::grid_group grid = cg::this_grid();
  volatile LAS unsigned* xst = (volatile LAS unsigned*)((LAS char*)g_shm + LDS_XST);
  if (threadIdx.x == 0) { xst[0] = 0u; xst[1] = 0u; }
  __syncthreads();
  (void)xcd_barrier_post((unsigned*)(lsp(p.ws) + OFF_BAR), xst);
#define GSYNC() do { XcdBarrier xb_; xb_.bar = (unsigned*)(lsp(p.ws) + OFF_BAR); unsigned xx_ = xb_xcc_id(); asm volatile("" : "+s"(xx_)); xb_.x = xx_; \
    xb_.st = (volatile LAS unsigned*)((LAS char*)g_shm + LDS_XST); xcd_barrier(xb_); } while (0)
#define WSP(off) ((u16*)(lsp(p.ws) + (off)))
  phase_norm(p.x, nullptr, nullptr, p.g_mix_pre, nullptr, WSP(OFF_H));
  convert_mixer_weights(p, 0);
  if (p.ws == nullptr) grid.sync();
  GSYNC();
#pragma unroll 1
  for (int l = 0; l < 2; ++l) {
    phase_inproj(p);
    GSYNC();
    {
      volatile LAS int* qslot = (volatile LAS int*)((LAS char*)g_shm + LDS_XST + 16);
#pragma unroll 1
      for (;;) {
        if (threadIdx.x == 0) *qslot = (int)atomicAdd((unsigned*)(lsp(p.ws) + OFF_QCTR) + l * 64 + 32, 1u);
        __syncthreads();
        const int it = *qslot;
        __syncthreads();
        if (it >= 1152) break;
        if (it < 128) nsa_compress(p, l, it);
        else gdn_prep(p, l, it - 128);
      }
    }
    GSYNC();
    if (blockIdx.x < 32) gdn_scan(p, l, blockIdx.x);
    {
      volatile LAS int* qslot = (volatile LAS int*)((LAS char*)g_shm + LDS_XST + 16);
#pragma unroll 1
      for (;;) {
        if (threadIdx.x == 0) *qslot = (int)atomicAdd((unsigned*)(lsp(p.ws) + OFF_QCTR) + l * 64, 1u);
        __syncthreads();
        const int it = *qslot;
        __syncthreads();
        if (it >= 768) break;
        if (it < 192) nsa_attn(p, it);
        else if (it < 448) { sb_attn_wave(p, (it - 192) * 8 + (lv(threadIdx.x) >> 6)); __syncthreads(); }
        else nsa_attn(p, it - 256);
      }
    }
    GSYNC();
    phase_merge(p);
    GSYNC();
    phase_gemm<0>(WSP(OFF_SCR), 1024, WSP(OFF_WOUT), 1024, 1024, 64, 4, WSP(OFF_H), 1024);
    GSYNC();
    phase_norm(l == 0 ? p.x : p.out, WSP(OFF_H), p.g_mix_post + l * 1024, p.g_ff_pre + l * 1024, p.out, WSP(OFF_H));
    convert_ffn_weights(p, l);
    GSYNC();
    phase_gemm<1>(WSP(OFF_H), 1024, WSP(OFF_WBIG), 1024, 1024, 64, 16, WSP(OFF_PROJ), 4096);
    GSYNC();
    phase_gemm<0>(WSP(OFF_PROJ), 4096, WSP(OFF_WBIG) + (size_t)4096 * 1024, 4096, 4096, 64, 4, WSP(OFF_SCR), 1024);
    GSYNC();
    phase_norm(p.out, WSP(OFF_SCR), p.g_ff_post + l * 1024, (l == 0) ? p.g_mix_pre + 1024 : nullptr, p.out, WSP(OFF_H));
    if (l == 0) { convert_mixer_weights(p, 1); GSYNC(); }
  }
}
#undef p

extern "C" void kernel_launch(void* const* d_in, const int* in_sizes, int n_in, void* d_out, int out_size, void* d_ws,
                              size_t ws_size, hipStream_t stream) {
  static int grid_blocks = 0;
  if (!grid_blocks) {
    int dev = 0, cus = 0, per_cu = 0;
    (void)hipGetDevice(&dev);
    (void)hipDeviceGetAttribute(&cus, hipDeviceAttributeMultiprocessorCount, dev);
    (void)hipFuncSetAttribute((const void*)fwd_megakernel, hipFuncAttributeMaxDynamicSharedMemorySize, LDS_BYTES);
    (void)hipOccupancyMaxActiveBlocksPerMultiprocessor(&per_cu, (const void*)fwd_megakernel, 512, LDS_BYTES);
    if (per_cu < 1) per_cu = 1;
    grid_blocks = cus * 1;
    if (ws_size < WS_NEED) fprintf(stderr, "workspace too small: %zu < %zu\n", ws_size, (size_t)WS_NEED);
  }
  Params p{};
  p.x = (const float*)d_in[0]; p.g_mix_pre = (const float*)d_in[1]; p.g_mix_post = (const float*)d_in[2];
  p.g_ff_pre = (const float*)d_in[3]; p.g_ff_post = (const float*)d_in[4]; p.w_in = (const float*)d_in[5];
  p.conv_w = (const float*)d_in[6]; p.a_log = (const float*)d_in[7]; p.dt_bias = (const float*)d_in[8];
  p.norm_g = (const float*)d_in[9]; p.cmp_wk = (const float*)d_in[10]; p.cmp_pk = (const float*)d_in[11];
  p.cmp_wv = (const float*)d_in[12]; p.cmp_pv = (const float*)d_in[13]; p.w_br0 = (const float*)d_in[14];
  p.w_br1 = (const float*)d_in[15]; p.w_br2 = (const float*)d_in[16]; p.w_out = (const float*)d_in[17];
  p.w_ff1 = (const float*)d_in[18]; p.w_ff2 = (const float*)d_in[19];
  p.out = (float*)d_out; p.ws = (char*)d_ws;
  (void)hipMemsetAsync((char*)d_ws + OFF_BAR, 0, 16384, stream);
  void* args[] = {&p};
  hipError_t e = hipLaunchCooperativeKernel((const void*)fwd_megakernel, dim3(grid_blocks), dim3(512), args, LDS_BYTES, stream);
  if (e != hipSuccess) fprintf(stderr, "cooperative launch failed: %s (grid %d)\n", hipGetErrorString(e), grid_blocks);
}
```

```cpp
#include <hip/hip_runtime.h>
#include <hip/hip_bf16.h>
#include <hip/hip_cooperative_groups.h>
#include <cstdio>
namespace cg = cooperative_groups;

typedef unsigned short u16;
using bf16x8 = __attribute__((ext_vector_type(8))) short;
using s16x4  = __attribute__((ext_vector_type(4))) short;
using f32x4  = __attribute__((ext_vector_type(4))) float;
using f32x16 = __attribute__((ext_vector_type(16))) float;
#define DI __device__ __forceinline__

constexpr int T_TOK = 16384, SEQL = 2048;
constexpr int NPJ = 4896;
constexpr int N_IN = 7968;
constexpr int C_GQ = 0, C_GK = 512, C_GV = 1024, C_GZ = 1536, C_GA = 2048, C_GB = 2052, C_NQ = 2056, C_NKV = 2568,
              C_NG = 3336, C_SQ = 3360, C_SK = 3872;
constexpr size_t OFF_WBR  = 0;
constexpr size_t OFF_WOUT = 3145728;
constexpr size_t OFF_WBIG = 5242880;
constexpr size_t OFF_PROJ = 22020096;
constexpr size_t OFF_SCR  = OFF_PROJ + 160432128;
constexpr size_t OFF_H    = OFF_SCR + 33554432;
constexpr size_t OFF_HALO = OFF_H + 33554432;
constexpr size_t OFF_KC   = OFF_HALO + 2359296;
constexpr size_t OFF_VCT  = OFF_KC + 262144;
constexpr size_t OFF_EGL  = OFF_VCT + 262144;
constexpr size_t OFF_WT   = OFF_EGL + 4096;
constexpr size_t OFF_CB   = OFF_WT + 524288;
constexpr size_t OFF_BAR  = OFF_CB + 512;
constexpr size_t OFF_QCTR = OFF_BAR + 14336;
constexpr size_t WS_NEED  = OFF_BAR + 16384;
constexpr int LDS_XST = 155648;
constexpr int LDS_BYTES = LDS_XST + 32;

struct Params {
  const float* x; const float* g_mix_pre; const float* g_mix_post; const float* g_ff_pre; const float* g_ff_post;
  const float* w_in; const float* conv_w; const float* a_log; const float* dt_bias; const float* norm_g;
  const float* cmp_wk; const float* cmp_pk; const float* cmp_wv; const float* cmp_pv;
  const float* w_br0; const float* w_br1; const float* w_br2; const float* w_out; const float* w_ff1; const float* w_ff2;
  float* out; char* ws;
};

extern __shared__ __attribute__((aligned(16))) char g_shm[];

typedef __bf16 bf2_t __attribute__((ext_vector_type(2)));
typedef float f2_t __attribute__((ext_vector_type(2)));
typedef unsigned u32x2 __attribute__((ext_vector_type(2)));
typedef unsigned u32x4 __attribute__((ext_vector_type(4)));
DI unsigned cvt2(float a, float b) { f2_t v; v[0] = a; v[1] = b; return __builtin_bit_cast(unsigned, __builtin_convertvector(v, bf2_t)); }
DI u16 f2bf(float x) { return (u16)(cvt2(x, x) & 0xffffu); }
DI float bf2f(u16 b) { return __uint_as_float(((unsigned)b) << 16); }
DI float bfs(short b) { return __uint_as_float(((unsigned)(u16)b) << 16); }
DI bf16x8 ld8(const u16* p) { return *(const bf16x8*)p; }
DI s16x4 ld4(const u16* p) { return *(const s16x4*)p; }
DI f32x4 mfma16(bf16x8 a, bf16x8 b, f32x4 c) { return __builtin_amdgcn_mfma_f32_16x16x32_bf16(a, b, c, 0, 0, 0); }
DI f32x16 mfma32(bf16x8 a, bf16x8 b, f32x16 c) { return __builtin_amdgcn_mfma_f32_32x32x16_bf16(a, b, c, 0, 0, 0); }
DI s16x4 pack4(float a, float b, float c, float d) { u32x2 r; r[0] = cvt2(a, b); r[1] = cvt2(c, d); return __builtin_bit_cast(s16x4, r); }
DI float sigmoidf_(float x) { return __builtin_amdgcn_rcpf(1.f + __expf(-x)); }
DI float softplusf_(float x) { return fmaxf(x, 0.f) + log1pf(__expf(-fabsf(x))); }
DI int lv(int v) { asm volatile("" : "+v"(v)); return v; }
DI char* lsp(char* q) { auto g = (__attribute__((address_space(1))) char*)q; asm volatile("" : "+s"(g)); return (char*)g; }
typedef const __attribute__((address_space(4))) Params* kparg_t;
#if defined(__HIP_DEVICE_COMPILE__)
DI Params kp() { kparg_t q = (kparg_t)__builtin_amdgcn_kernarg_segment_ptr(); asm volatile("" : "+s"(q)); return *q; }
#else
DI Params kp() { return Params{}; }
#endif
DI char* lds_base() { auto q = (__attribute__((address_space(3))) char*)g_shm; asm volatile("" : "+v"(q)); return (char*)q; }
DI void lds_barrier() { asm volatile("s_waitcnt lgkmcnt(0)" ::: "memory"); __builtin_amdgcn_s_barrier(); asm volatile("" ::: "memory"); }
DI int crow(int i, int h) { return (i & 3) + 8 * (i >> 2) + 4 * h; }
DI bf16x8 pack8(const f32x16& x, int s) {
  u32x4 r;
  r[0] = cvt2(x[8 * s + 0], x[8 * s + 1]); r[1] = cvt2(x[8 * s + 2], x[8 * s + 3]);
  r[2] = cvt2(x[8 * s + 4], x[8 * s + 5]); r[3] = cvt2(x[8 * s + 6], x[8 * s + 7]);
  return __builtin_bit_cast(bf16x8, r);
}

static __device__ __attribute__((always_inline)) inline void convert_weight(const float* W, int K, int N, u16* out, int ldo, bool winmap, int boff = 0) {
  float* lds = (float*)lds_base();
  const int tid = lv(threadIdx.x);
  const int nkt = K / 64, nnt = (N + 127) / 128, ntiles = nkt * nnt;
  f32x4 v[4];
#define CW_LOAD(T) do { const int kt_ = (T) % nkt, nt_ = (T) / nkt; \
    _Pragma("unroll") for (int q = 0; q < 4; ++q) { const int e = tid + q * 512, kk = e >> 5, n = nt_ * 128 + (e & 31) * 4; \
      v[q] = f32x4{0.f, 0.f, 0.f, 0.f}; if (n < N) v[q] = *(const f32x4*)(W + (size_t)(kt_ * 64 + kk) * N + n); } } while (0)
  int t = (int)((blockIdx.x + gridDim.x - (unsigned)boff) % gridDim.x);
  if (t < ntiles) CW_LOAD(t);
  for (; t < ntiles; t += gridDim.x) {
    const int kt = t % nkt, nt = t / nkt, k0 = kt * 64, n0 = nt * 128;
#pragma unroll
    for (int q = 0; q < 4; ++q) {
      const int e = tid + q * 512, kk = e >> 5, nn = (e & 31) * 4;
      lds[kk * 129 + nn + 0] = v[q][0]; lds[kk * 129 + nn + 1] = v[q][1]; lds[kk * 129 + nn + 2] = v[q][2]; lds[kk * 129 + nn + 3] = v[q][3];
    }
    lds_barrier();
    if (t + (int)gridDim.x < ntiles) CW_LOAD(t + (int)gridDim.x);
#pragma unroll
    for (int rep = 0; rep < 2; ++rep) {
      const int nn = (tid >> 3) + 64 * rep, ks = tid & 7, n = n0 + nn;
      if (n < N) {
        const int orow = winmap ? (n < NPJ ? n : n + 224) : n;
        u32x4 o;
#pragma unroll
        for (int e = 0; e < 4; ++e) o[e] = cvt2(lds[(ks * 8 + 2 * e) * 129 + nn], lds[(ks * 8 + 2 * e + 1) * 129 + nn]);
        *(u32x4*)(out + (size_t)orow * ldo + k0 + ks * 8) = o;
      }
    }
    lds_barrier();
  }
#undef CW_LOAD
  __syncthreads();
}

static __device__ __attribute__((always_inline)) inline void convert_mixer_weights(const Params& p, int l) {
  char* ws = lsp(p.ws);
  convert_weight(p.w_in + (size_t)l * 1024 * N_IN, 1024, N_IN, (u16*)(ws + OFF_WBIG), 1024, true);
  convert_weight(p.w_br0 + (size_t)l * 512 * 1024, 512, 1024, (u16*)(ws + OFF_WBR), 512, false);
  convert_weight(p.w_br1 + (size_t)l * 512 * 1024, 512, 1024, (u16*)(ws + OFF_WBR) + 1024 * 512, 512, false, 64);
  convert_weight(p.w_br2 + (size_t)l * 512 * 1024, 512, 1024, (u16*)(ws + OFF_WBR) + 2 * 1024 * 512, 512, false, 128);
  convert_weight(p.w_out + (size_t)l * 1024 * 1024, 1024, 1024, (u16*)(ws + OFF_WOUT), 1024, false, 192);
  convert_weight(p.cmp_wk + (size_t)l * 131072, 2048, 64, (u16*)(ws + OFF_WT), 2048, false, 64);
  convert_weight(p.cmp_wv + (size_t)l * 131072, 2048, 64, (u16*)(ws + OFF_WT) + 64 * 2048, 2048, false, 96);
  if (blockIdx.x >= 160 && blockIdx.x < 162) {
    const int kv = blockIdx.x - 160, tid = lv(threadIdx.x), e = tid & 63, part = tid >> 6;
    const float* W = (kv ? p.cmp_wv : p.cmp_wk) + (size_t)l * 131072;
    const float* pp = (kv ? p.cmp_pv : p.cmp_pk) + (size_t)l * 2048;
    float* red = (float*)lds_base();
    float sacc = 0.f;
    for (int k = part * 256; k < part * 256 + 256; ++k) sacc += pp[k] * W[k * 64 + e];
    red[part * 64 + e] = sacc;
    __syncthreads();
    if (tid < 64) { float t = 0.f; for (int q = 0; q < 8; ++q) t += red[q * 64 + tid]; ((float*)(ws + OFF_CB))[kv * 64 + tid] = t; }
    __syncthreads();
  }
}
static __device__ __attribute__((always_inline)) inline void convert_ffn_weights(const Params& p, int l) {
  char* ws = lsp(p.ws);
  convert_weight(p.w_ff1 + (size_t)l * 1024 * 4096, 1024, 4096, (u16*)(ws + OFF_WBIG), 1024, false);
  convert_weight(p.w_ff2 + (size_t)l * 4096 * 1024, 4096, 1024, (u16*)(ws + OFF_WBIG) + (size_t)4096 * 1024, 4096, false);
}

DI float wave_sum(float v) {
#pragma unroll
  for (int o = 32; o > 0; o >>= 1) v += __shfl_xor(v, o);
  return v;
}
static __device__ __attribute__((always_inline)) inline void phase_norm(const float* xin, const u16* y, const float* g_post, const float* g_next, float* xout, u16* H) {
  const int tidn = lv(threadIdx.x);
  const int wave = tidn >> 6, lane = tidn & 63;
  for (int row0 = (blockIdx.x * 8 + wave) * 2; row0 < T_TOK; row0 += gridDim.x * 16) {
    float xv[2][16], yv[2][16];
#pragma unroll
    for (int rr = 0; rr < 2; ++rr)
#pragma unroll
      for (int i = 0; i < 4; ++i) {
        f32x4 t = *(const f32x4*)(xin + (size_t)(row0 + rr) * 1024 + i * 256 + lane * 4);
        xv[rr][i * 4 + 0] = t[0]; xv[rr][i * 4 + 1] = t[1]; xv[rr][i * 4 + 2] = t[2]; xv[rr][i * 4 + 3] = t[3];
      }
    if (y) {
      float ss[2] = {0.f, 0.f};
#pragma unroll
      for (int rr = 0; rr < 2; ++rr)
#pragma unroll
        for (int i = 0; i < 4; ++i) {
          s16x4 t = ld4(y + (size_t)(row0 + rr) * 1024 + i * 256 + lane * 4);
#pragma unroll
          for (int e = 0; e < 4; ++e) { yv[rr][i * 4 + e] = bfs(t[e]); ss[rr] += yv[rr][i * 4 + e] * yv[rr][i * 4 + e]; }
        }
#pragma unroll
      for (int o = 32; o > 0; o >>= 1) { float t0 = __shfl_xor(ss[0], o), t1 = __shfl_xor(ss[1], o); ss[0] += t0; ss[1] += t1; }
#pragma unroll
      for (int rr = 0; rr < 2; ++rr) {
        const float r = rsqrtf(ss[rr] * (1.f / 1024.f) + 1e-6f);
#pragma unroll
        for (int i = 0; i < 4; ++i) {
          f32x4 g = *(const f32x4*)(g_post + i * 256 + lane * 4);
          f32x4 o;
#pragma unroll
          for (int e = 0; e < 4; ++e) { xv[rr][i * 4 + e] += yv[rr][i * 4 + e] * r * g[e]; o[e] = xv[rr][i * 4 + e]; }
          *(f32x4*)(xout + (size_t)(row0 + rr) * 1024 + i * 256 + lane * 4) = o;
        }
      }
    }
    if (g_next) {
      float ss[2] = {0.f, 0.f};
#pragma unroll
      for (int rr = 0; rr < 2; ++rr)
#pragma unroll
        for (int i = 0; i < 16; ++i) ss[rr] += xv[rr][i] * xv[rr][i];
#pragma unroll
      for (int o = 32; o > 0; o >>= 1) { float t0 = __shfl_xor(ss[0], o), t1 = __shfl_xor(ss[1], o); ss[0] += t0; ss[1] += t1; }
#pragma unroll
      for (int rr = 0; rr < 2; ++rr) {
        const float r = rsqrtf(ss[rr] * (1.f / 1024.f) + 1e-6f);
#pragma unroll
        for (int i = 0; i < 4; ++i) {
          f32x4 g = *(const f32x4*)(g_next + i * 256 + lane * 4);
          *(s16x4*)(H + (size_t)(row0 + rr) * 1024 + i * 256 + lane * 4) =
              pack4(xv[rr][i * 4] * r * g[0], xv[rr][i * 4 + 1] * r * g[1], xv[rr][i * 4 + 2] * r * g[2], xv[rr][i * 4 + 3] * r * g[3]);
        }
      }
    }
  }
}

constexpr int BM = 256, BK = 64, HALF = 128, HT = HALF * BK;
DI int lds_byte(int r, int c) {
  int st = (r >> 4) * 2 + (c >> 5), rr = r & 15, cc = c & 31, ob = rr * 64 + cc * 2;
  return st * 1024 + (ob ^ (((ob >> 9) & 1) << 5));
}
DI void stage_rc(int b, int& R, int& C) {
  int st = b / 1024, sb = b % 1024, swz = sb ^ (((sb >> 9) & 1) << 5);
  R = (st >> 1) * 16 + swz / 64; C = (st & 1) * 32 + (swz % 64) / 2;
}
DI void tile_map(int wgid, int nM, int nN, int& pm, int& pn) {
  const int NXCD = 8, WGM = 8;
  int nwg = nM * nN;
  { int q = nwg / NXCD, r = nwg % NXCD, xcd = wgid % NXCD, off = wgid / NXCD;
    wgid = (xcd < r ? xcd * (q + 1) : r * (q + 1) + (xcd - r) * q) + off; }
  int nig = WGM * nN, gid = wgid / nig, fm = gid * WGM, gsz = min(nM - fm, WGM);
  pm = fm + ((wgid % nig) % gsz); pn = (wgid % nig) / gsz;
}

struct NoPre { DI void operator()(int, int, int) const {} };
template <class Epi, class Pre = NoPre>
DI void gemm_tile(const u16* A, int lda, const u16* Bt, int ldb, int K, int brow, int bcol, Epi epi, Pre pre = Pre()) {
  u16* shm = (u16*)g_shm;
#define SA(b, h) (shm + ((b) * 2 + (h)) * HT)
#define SB(b, h) (shm + (4 + (b) * 2 + (h)) * HT)
#define STAGE(P, BASE, LD, br, kt) do { const char* _gb = (const char*)((BASE) + (size_t)(br) * (LD) + (size_t)(kt) * BK); \
    for (int _i = 0; _i < 2; ++_i) { int _b = tidx * 16 + _i * 8192; \
      __builtin_amdgcn_global_load_lds((const unsigned*)(_gb + (((LD) == lda) ? offA[_i] : offB[_i])), \
        (__attribute__((address_space(3))) unsigned*)((char*)(P) + _b), 16, 0, 0); } } while (0)
#define LDA(dst, b, h) for (int m = 0; m < 4; ++m) for (int k = 0; k < 2; ++k) \
    dst[m][k] = *reinterpret_cast<const bf16x8*>((char*)SA(b, h) + lds_byte(wr * 64 + m * 16 + fr, k * 32 + fq * 8))
#define LDB(dst, b, h) for (int n = 0; n < 2; ++n) for (int k = 0; k < 2; ++k) \
    dst[n][k] = *reinterpret_cast<const bf16x8*>((char*)SB(b, h) + lds_byte(wc * 32 + n * 16 + fr, k * 32 + fq * 8))
#define MMA(ai, bj, At_, Bt_) do { __builtin_amdgcn_s_setprio(1); \
    for (int m = 0; m < 4; ++m) for (int n = 0; n < 2; ++n) for (int k = 0; k < 2; ++k) \
      acc[ai][bj][m][n] = __builtin_amdgcn_mfma_f32_16x16x32_bf16(Bt_[n][k], At_[m][k], acc[ai][bj][m][n], 0, 0, 0); \
    __builtin_amdgcn_s_setprio(0); } while (0)
#define WAIT_V(n) asm volatile("s_waitcnt vmcnt(" #n ")" ::: "memory")
#define WAIT_L(n) asm volatile("s_waitcnt lgkmcnt(" #n ")" ::: "memory")
#define BAR __builtin_amdgcn_s_barrier()
#define SCHED __builtin_amdgcn_sched_barrier(0)
  int tidx = threadIdx.x; asm volatile("" : "+v"(tidx));
  const int wid = tidx >> 6, lane = tidx & 63, wr = wid >> 2, wc = wid & 3, fr = lane & 15, fq = lane >> 4;
  unsigned offA[2], offB[2];
#pragma unroll
  for (int _i = 0; _i < 2; ++_i) { int _r, _c; stage_rc(tidx * 16 + _i * 8192, _r, _c); offA[_i] = (unsigned)(_r * lda + _c) * 2u; offB[_i] = (unsigned)(_r * ldb + _c) * 2u; }
  f32x4 acc[2][2][4][2] = {};
  bf16x8 At[4][2], B0[2][2], B1[2][2];
  const int nt = K / BK;
  STAGE(SB(0, 0), Bt, ldb, bcol, 0); STAGE(SA(0, 0), A, lda, brow, 0);
  STAGE(SB(0, 1), Bt, ldb, bcol + HALF, 0); STAGE(SA(0, 1), A, lda, brow + HALF, 0);
  if (wr == 1) BAR;
  WAIT_V(4); BAR;
  STAGE(SB(1, 0), Bt, ldb, bcol, 1); STAGE(SA(1, 0), A, lda, brow, 1); STAGE(SB(1, 1), Bt, ldb, bcol + HALF, 1);
  WAIT_V(6); BAR;
  for (int t = 0; t < nt - 2; t += 2) {
    LDB(B0, 0, 0); SCHED; LDA(At, 0, 0); STAGE(SA(1, 1), A, lda, brow + HALF, t + 1);
    WAIT_L(8); BAR; WAIT_L(0); MMA(0, 0, At, B0); BAR; SCHED;
    LDB(B1, 0, 1); STAGE(SB(0, 0), Bt, ldb, bcol, t + 2);
    BAR; WAIT_L(0); MMA(0, 1, At, B1); BAR;
    LDA(At, 0, 1); STAGE(SA(0, 0), A, lda, brow, t + 2);
    BAR; WAIT_L(0); MMA(1, 0, At, B0); BAR; SCHED;
    STAGE(SB(0, 1), Bt, ldb, bcol + HALF, t + 2);
    WAIT_V(6); BAR; MMA(1, 1, At, B1); BAR;
    LDB(B0, 1, 0); SCHED; LDA(At, 1, 0); STAGE(SA(0, 1), A, lda, brow + HALF, t + 2);
    WAIT_L(8); BAR; WAIT_L(0); MMA(0, 0, At, B0); BAR; SCHED;
    LDB(B1, 1, 1); STAGE(SB(1, 0), Bt, ldb, bcol, t + 3);
    BAR; WAIT_L(0); MMA(0, 1, At, B1); BAR;
    LDA(At, 1, 1); STAGE(SA(1, 0), A, lda, brow, t + 3);
    BAR; WAIT_L(0); MMA(1, 0, At, B0); BAR; SCHED;
    STAGE(SB(1, 1), Bt, ldb, bcol + HALF, t + 3);
    WAIT_V(6); BAR; MMA(1, 1, At, B1); BAR;
  }
  { LDB(B0, 0, 0); LDA(At, 0, 0); STAGE(SA(1, 1), A, lda, brow + HALF, nt - 1);
    BAR; WAIT_L(0); MMA(0, 0, At, B0); BAR;
    LDB(B1, 0, 1); BAR; WAIT_L(0); MMA(0, 1, At, B1); BAR;
    LDA(At, 0, 1); WAIT_V(4); BAR; WAIT_L(0); MMA(1, 0, At, B0); MMA(1, 1, At, B1); BAR; }
  { LDB(B0, 1, 0); LDA(At, 1, 0); WAIT_V(2); BAR; WAIT_L(0); MMA(0, 0, At, B0); BAR;
    LDB(B1, 1, 1); WAIT_V(0); BAR; WAIT_L(0); MMA(0, 1, At, B1); BAR;
    LDA(At, 1, 1); BAR; WAIT_L(0); MMA(1, 0, At, B0); MMA(1, 1, At, B1); BAR; }
  if (wr == 0) BAR;
  int tid2 = tidx; asm volatile("" : "+v"(tid2));
  const int wid2 = tid2 >> 6, lane2 = tid2 & 63, wr2 = wid2 >> 2, wc2 = wid2 & 3, fr2 = lane2 & 15, fq2 = lane2 >> 4;
#pragma unroll
  for (int ai = 0; ai < 2; ++ai)
#pragma unroll
    for (int bj = 0; bj < 2; ++bj)
#pragma unroll
      for (int m = 0; m < 4; ++m) {
#pragma unroll
        for (int n = 0; n < 2; ++n)
          pre(n, brow + ai * HALF + wr2 * 64 + m * 16 + fr2, bcol + bj * HALF + wc2 * 32 + n * 16 + fq2 * 4);
#pragma unroll
        for (int n = 0; n < 2; ++n)
          epi(n, brow + ai * HALF + wr2 * 64 + m * 16 + fr2, bcol + bj * HALF + wc2 * 32 + n * 16 + fq2 * 4, acc[ai][bj][m][n]);
      }
  __syncthreads();
#undef SA
#undef SB
#undef STAGE
#undef LDA
#undef LDB
#undef MMA
}

static __device__ __attribute__((always_inline)) inline void phase_inproj(const Params& p) {
  char* ws = lsp(p.ws);
  u16* H = (u16*)(ws + OFF_H); u16* WinT = (u16*)(ws + OFF_WBIG); u16* PROJ = (u16*)(ws + OFF_PROJ);
  u16* HALO = (u16*)(ws + OFF_HALO);
  const int nM = 64, nN = 20;
  for (int t = blockIdx.x; t < nM * nN; t += gridDim.x) {
    int pm, pn; tile_map(t, nM, nN, pm, pn);
    gemm_tile(H, 1024, WinT, 1024, 1024, pm * 256, pn * 256, [&](int idx, int row, int col, f32x4 v) {
      if (col < NPJ) {
        s16x4 b = pack4(v[0], v[1], v[2], v[3]);
        *(s16x4*)(PROJ + (size_t)row * NPJ + col) = b;
        if (col < 1536 && (row & 63) >= 61) *(s16x4*)(HALO + ((size_t)(row >> 6) * 3 + ((row & 63) - 61)) * 1536 + col) = b;
      }
    });
  }
}

static __device__ __attribute__((always_inline)) inline void sb_attn_wave(const Params& p, int witem) {
  u16* PROJ = (u16*)(lsp(p.ws) + OFF_PROJ);
  const int tid = lv(threadIdx.x), lane = tid & 63, w = tid >> 6, lq5 = lane & 31, hf = lane >> 5;
  u16* VT = (u16*)lds_base() + w * (64 * 40);
  const int b = witem >> 8, h = (witem >> 5) & 7, qt = witem & 31;
  const int t0 = qt * 64;
  bf16x8 qf[2][4];
#pragma unroll
  for (int qi = 0; qi < 2; ++qi)
#pragma unroll
    for (int s = 0; s < 4; ++s) {
      bf16x8 raw = ld8(PROJ + ((size_t)b * SEQL + t0 + 32 * qi + lq5) * NPJ + C_SQ + h * 64 + 16 * s + 8 * hf);
#pragma unroll
      for (int e = 0; e < 8; ++e) raw[e] = (short)f2bf(bfs(raw[e]) * 0.125f);
      qf[qi][s] = raw;
    }
  f32x16 oacc[2][2];
#pragma unroll
  for (int i = 0; i < 16; ++i) { oacc[0][0][i] = 0.f; oacc[0][1][i] = 0.f; oacc[1][0][i] = 0.f; oacc[1][1][i] = 0.f; }
  float carry[2] = {1.f, 1.f};
#pragma unroll 1
  for (int k0 = t0 + 32; k0 >= 0; k0 -= 32) {
    const size_t krow = ((size_t)b * SEQL + k0 + lq5) * NPJ + C_SK + h * 64;
    {
      bf16x8 v0 = ld8(PROJ + krow + 512 + hf * 32), v1 = ld8(PROJ + krow + 512 + hf * 32 + 8);
      bf16x8 v2 = ld8(PROJ + krow + 512 + hf * 32 + 16), v3 = ld8(PROJ + krow + 512 + hf * 32 + 24);
#pragma unroll
      for (int e = 0; e < 8; ++e) {
        VT[(hf * 32 + e) * 40 + lq5] = (u16)v0[e]; VT[(hf * 32 + 8 + e) * 40 + lq5] = (u16)v1[e];
        VT[(hf * 32 + 16 + e) * 40 + lq5] = (u16)v2[e]; VT[(hf * 32 + 24 + e) * 40 + lq5] = (u16)v3[e];
      }
    }
    bf16x8 kf[4];
#pragma unroll
    for (int s = 0; s < 4; ++s) kf[s] = ld8(PROJ + krow + 16 * s + 8 * hf);
#pragma unroll
    for (int qi = 0; qi < 2; ++qi) {
      if (k0 >= t0 + 32 * qi + 31) continue;
      f32x16 st;
#pragma unroll
      for (int i = 0; i < 16; ++i) st[i] = 0.f;
#pragma unroll
      for (int s = 0; s < 4; ++s) st = mfma32(kf[s], qf[qi][s], st);
      const int t = t0 + 32 * qi + lq5;
      float m[16];
#pragma unroll
      for (int i = 0; i < 16; ++i) {
        const float z = fminf(fmaxf(st[i], -80.f), 80.f);
        const float e = __expf(z);
        const float r = __builtin_amdgcn_rcpf(1.f + e);
        const bool c = (k0 + crow(i, hf)) < t;
        m[i] = c ? r : 1.f;
        st[i] = c ? e * r : 0.f;
      }
      float T[4], P[4];
#pragma unroll
      for (int gi = 0; gi < 4; ++gi) { T[gi] = (m[4 * gi] * m[4 * gi + 1]) * (m[4 * gi + 2] * m[4 * gi + 3]); P[gi] = __shfl_xor(T[gi], 32); }
      float aft[4];
      aft[3] = (hf == 0) ? P[3] : 1.f;
      aft[2] = T[3] * P[3] * ((hf == 0) ? P[2] : 1.f);
      aft[1] = T[3] * P[3] * T[2] * P[2] * ((hf == 0) ? P[1] : 1.f);
      aft[0] = T[3] * P[3] * T[2] * P[2] * T[1] * P[1] * ((hf == 0) ? P[0] : 1.f);
      const float cin = carry[qi];
#pragma unroll
      for (int gi = 0; gi < 4; ++gi) {
        const float base = cin * aft[gi];
        const float w2 = m[4 * gi + 3], w1 = w2 * m[4 * gi + 2], w0 = w1 * m[4 * gi + 1];
        st[4 * gi + 0] *= base * w0;
        st[4 * gi + 1] *= base * w1;
        st[4 * gi + 2] *= base * w2;
        st[4 * gi + 3] *= base;
      }
      carry[qi] = cin * ((T[0] * P[0]) * (T[1] * P[1])) * ((T[2] * P[2]) * (T[3] * P[3]));
#pragma unroll
      for (int s = 0; s < 2; ++s) {
        bf16x8 pf = pack8(st, s);
#pragma unroll
        for (int dt = 0; dt < 2; ++dt) {
          const u16* vp = VT + (32 * dt + lq5) * 40 + 16 * s + 4 * hf;
          s16x4 lo = ld4(vp), hi = ld4(vp + 8);
          bf16x8 vf = __builtin_shufflevector(lo, hi, 0, 1, 2, 3, 4, 5, 6, 7);
          oacc[qi][dt] = mfma32(vf, pf, oacc[qi][dt]);
        }
      }
    }
    if (k0 <= t0 && __all(carry[0] < 1.2e-38f && carry[1] < 1.2e-38f)) break;
  }
#pragma unroll
  for (int qi = 0; qi < 2; ++qi)
#pragma unroll
    for (int dt = 0; dt < 2; ++dt)
#pragma unroll
      for (int g4 = 0; g4 < 4; ++g4)
        *(s16x4*)(PROJ + ((size_t)b * SEQL + t0 + 32 * qi + lq5) * NPJ + C_SQ + h * 64 + 32 * dt + 8 * g4 + 4 * hf) =
            pack4(oacc[qi][dt][4 * g4], oacc[qi][dt][4 * g4 + 1], oacc[qi][dt][4 * g4 + 2], oacc[qi][dt][4 * g4 + 3]);
}

static __device__ __attribute__((always_inline)) inline void nsa_compress(const Params& p, int l, int item) {
  char* ws = lsp(p.ws);
  const u16* PROJ = (const u16*)(ws + OFF_PROJ);
  u16* KC = (u16*)(ws + OFF_KC); u16* VCT = (u16*)(ws + OFF_VCT);
  const u16* WT = (const u16*)(ws + OFF_WT); const float* CB = (const float*)(ws + OFF_CB);
  float* red = (float*)lds_base();
  const int tid = lv(threadIdx.x), lane = tid & 63, w = tid >> 6, lq5 = lane & 31, hf = lane >> 5;
  const int nt4 = item & 3, kv = (item >> 2) & 1, g = (item >> 3) & 1, b = item >> 4;
  const int n = 32 * nt4 + lq5;
  f32x16 acc[2];
#pragma unroll
  for (int i = 0; i < 16; ++i) { acc[0][i] = 0.f; acc[1][i] = 0.f; }
#pragma unroll 4
  for (int ks = 0; ks < 16; ++ks) {
    const int ll = 4 * w + (ks >> 2), d0 = (ks & 3) * 16 + 8 * hf;
    bf16x8 a;
#pragma unroll
    for (int e = 0; e < 8; ++e) a[e] = 0;
    if (n < 127) a = ld8(PROJ + ((size_t)b * SEQL + 16 * n + ll) * NPJ + C_NKV + kv * 128 + g * 64 + d0);
#pragma unroll
    for (int et = 0; et < 2; ++et)
      acc[et] = mfma32(a, ld8(WT + ((size_t)(kv * 64 + 32 * et + lq5)) * 2048 + ll * 64 + d0), acc[et]);
  }
#pragma unroll
  for (int et = 0; et < 2; ++et)
#pragma unroll
    for (int i = 0; i < 16; ++i) red[(w * 32 + crow(i, hf)) * 64 + 32 * et + lq5] = acc[et][i];
  __syncthreads();
  {
    const int nl = tid >> 4, e0 = (tid & 15) * 4;
    float v[4];
#pragma unroll
    for (int q = 0; q < 4; ++q) v[q] = CB[kv * 64 + e0 + q];
#pragma unroll
    for (int ww = 0; ww < 8; ++ww)
#pragma unroll
      for (int q = 0; q < 4; ++q) v[q] += red[(ww * 32 + nl) * 64 + e0 + q];
    const int nn = 32 * nt4 + nl;
    if (nn >= 127) { v[0] = 0.f; v[1] = 0.f; v[2] = 0.f; v[3] = 0.f; }
    if (kv == 0) *(s16x4*)(KC + ((size_t)(b * 2 + g) * 128 + nn) * 64 + e0) = pack4(v[0], v[1], v[2], v[3]);
    else {
#pragma unroll
      for (int q = 0; q < 4; ++q) VCT[((size_t)(b * 2 + g) * 64 + e0 + q) * 128 + nn] = f2bf(v[q]);
    }
  }
  __syncthreads();
}

static __device__ __attribute__((always_inline)) inline void gdn_prep(const Params& p, int l, int item) {
  char* ws = lsp(p.ws);
  u16* PROJ = (u16*)(ws + OFF_PROJ); u16* HALO = (u16*)(ws + OFF_HALO);
  u16* WG = (u16*)(ws + OFF_SCR); u16* ATT = (u16*)(ws + OFF_SCR + 16777216);
  float* EGL = (float*)(ws + OFF_EGL);
  u16* Qb = (u16*)lds_base();
  u16* Kb = Qb + 64 * 136;
  u16* vbT = Kb + 64 * 136;
  u16* kbT = vbT + 128 * 72;
  float* As = (float*)(kbT + 128 * 72);
  u16* Tb = (u16*)(As + 64 * 65);
  float* sg = (float*)(Tb + 64 * 72);
  float* sbeta = sg + 64; float* sgc = sbeta + 64;
  const int tid = lv(threadIdx.x), lane = tid & 63, w = tid >> 6, lr = lane & 15, lq = lane >> 4;
  const int c = item & 31, h = (item >> 5) & 3, b = item >> 7;
  const int t0 = b * SEQL + c * 64;
  const int i = tid & 63, cgp = tid >> 6;
  const float* cw = p.conv_w + (size_t)l * 4 * 1536;
  if (tid < 64) {
    float a = bf2f(PROJ[(size_t)(t0 + tid) * NPJ + C_GA + h]);
    float bt = bf2f(PROJ[(size_t)(t0 + tid) * NPJ + C_GB + h]);
    sg[tid] = -__expf(p.a_log[l * 4 + h]) * softplusf_(a + p.dt_bias[l * 4 + h]);
    sbeta[tid] = sigmoidf_(bt);
  }
  float qkv[3][16];
  {
    bf16x8 xr[3][4][2];
#pragma unroll
    for (int sec = 0; sec < 3; ++sec)
#pragma unroll
      for (int j = 0; j < 4; ++j) {
        const int colb = sec * 512 + h * 128 + cgp * 16;
        const int ii = i - 3 + j;
        const u16* src = (ii >= 0) ? PROJ + (size_t)(t0 + ii) * NPJ + colb
                                   : HALO + ((size_t)(max(t0 >> 6, 1) - 1) * 3 + (3 + ii)) * 1536 + colb;
        xr[sec][j][0] = ld8(src); xr[sec][j][1] = ld8(src + 8);
      }
#pragma unroll
    for (int sec = 0; sec < 3; ++sec) {
      const int colb = sec * 512 + h * 128 + cgp * 16;
#pragma unroll
      for (int e = 0; e < 16; ++e) qkv[sec][e] = 0.f;
#pragma unroll
      for (int j = 0; j < 4; ++j) {
        const int ii = i - 3 + j;
        const float keep = (ii >= 0 || c > 0) ? 1.f : 0.f;
#pragma unroll
        for (int e = 0; e < 8; ++e) {
          qkv[sec][e] += (keep * cw[j * 1536 + colb + e]) * bfs(xr[sec][j][0][e]);
          qkv[sec][8 + e] += (keep * cw[j * 1536 + colb + 8 + e]) * bfs(xr[sec][j][1][e]);
        }
      }
#pragma unroll
      for (int e = 0; e < 16; ++e) { float x = qkv[sec][e]; qkv[sec][e] = x * __builtin_amdgcn_rcpf(1.f + __expf(-x)); }
    }
  }
  {
    float sq = 0.f, sk = 0.f;
#pragma unroll
    for (int e = 0; e < 16; ++e) { sq += qkv[0][e] * qkv[0][e]; sk += qkv[1][e] * qkv[1][e]; }
    float* rdn = As;
    rdn[(0 * 8 + cgp) * 64 + i] = sq; rdn[(1 * 8 + cgp) * 64 + i] = sk;
    __syncthreads();
    sq = 0.f; sk = 0.f;
#pragma unroll
    for (int cc = 0; cc < 8; ++cc) { sq += rdn[(0 * 8 + cc) * 64 + i]; sk += rdn[(1 * 8 + cc) * 64 + i]; }
    float rq = rsqrtf(sq + 1e-6f) * 0.08838834764831845f, rk = rsqrtf(sk + 1e-6f);
#pragma unroll
    for (int e = 0; e < 16; ++e) { qkv[0][e] *= rq; qkv[1][e] *= rk; }
  }
  if (tid < 64) {
    float sc_ = sg[tid];
#pragma unroll
    for (int o = 1; o < 64; o <<= 1) { float t = __shfl_up(sc_, o); if (lane >= o) sc_ += t; }
    sgc[tid] = sc_;
    if (tid == 63) EGL[item] = __expf(sc_);
  }
  __syncthreads();
  {
    const float gci = sgc[i], gl = sgc[63], bi = sbeta[i];
    const float eg = __expf(gci), ekd = __expf(gl - gci);
    bf16x8 a0, a1, b0, b1, c0, c1, d0, d1;
#pragma unroll
    for (int e = 0; e < 8; ++e) {
      a0[e] = (short)f2bf(qkv[0][e]); a1[e] = (short)f2bf(qkv[0][8 + e]);
      b0[e] = (short)f2bf(qkv[1][e]); b1[e] = (short)f2bf(qkv[1][8 + e]);
      c0[e] = (short)f2bf(qkv[0][e] * eg); c1[e] = (short)f2bf(qkv[0][8 + e] * eg);
      d0[e] = (short)f2bf(qkv[1][e] * ekd); d1[e] = (short)f2bf(qkv[1][8 + e] * ekd);
    }
    *(bf16x8*)(Qb + i * 136 + cgp * 16) = a0; *(bf16x8*)(Qb + i * 136 + cgp * 16 + 8) = a1;
    *(bf16x8*)(Kb + i * 136 + cgp * 16) = b0; *(bf16x8*)(Kb + i * 136 + cgp * 16 + 8) = b1;
    u16* gq = PROJ + (size_t)(t0 + i) * NPJ + C_GQ + h * 128 + cgp * 16;
    u16* gk = PROJ + (size_t)(t0 + i) * NPJ + C_GK + h * 128 + cgp * 16;
    *(bf16x8*)gq = c0; *(bf16x8*)(gq + 8) = c1;
    *(bf16x8*)gk = d0; *(bf16x8*)(gk + 8) = d1;
#pragma unroll
    for (int e = 0; e < 16; ++e) {
      vbT[(cgp * 16 + e) * 72 + i] = f2bf(qkv[2][e] * bi);
      kbT[(cgp * 16 + e) * 72 + i] = f2bf(qkv[1][e] * bi * eg);
    }
  }
  __syncthreads();
#pragma unroll 1
  for (int jj = 0; jj < 2; ++jj) {
    const int tile = w * 2 + jj, ti = tile >> 2, tj = tile & 3;
    f32x4 acc = {0.f, 0.f, 0.f, 0.f};
    if (tj <= ti) {
#pragma unroll
      for (int ks = 0; ks < 4; ++ks)
        acc = mfma16(ld8(Kb + (ti * 16 + lr) * 136 + ks * 32 + lq * 8), ld8(Kb + (tj * 16 + lr) * 136 + ks * 32 + lq * 8), acc);
    }
    const int j = tj * 16 + lr;
#pragma unroll
    for (int r = 0; r < 4; ++r) {
      const int ir = ti * 16 + lq * 4 + r;
      As[ir * 65 + j] = (j < ir) ? sbeta[ir] * acc[r] * __expf(sgc[ir] - sgc[j]) : 0.f;
    }
  }
  __syncthreads();
  if (w != 0) {
#pragma unroll 1
    for (int tile = w - 1; tile < 16; tile += 7) {
      const int ti = tile >> 2, tj = tile & 3;
      f32x4 acc = {0.f, 0.f, 0.f, 0.f};
      if (tj <= ti) {
#pragma unroll
        for (int ks = 0; ks < 4; ++ks)
          acc = mfma16(ld8(Qb + (ti * 16 + lr) * 136 + ks * 32 + lq * 8), ld8(Kb + (tj * 16 + lr) * 136 + ks * 32 + lq * 8), acc);
      }
      const int j = tj * 16 + lr;
#pragma unroll
      for (int r = 0; r < 4; ++r) {
        const int ir = ti * 16 + lq * 4 + r;
        const float dec = (j <= ir) ? __expf(sgc[ir] - sgc[j]) : 0.f;
        ATT[(size_t)item * 4096 + ir * 64 + j] = f2bf(acc[r] * dec);
      }
    }
  }
  if (w == 0) {
    float Ar[64], Tc[64];
#pragma unroll
    for (int ir = 0; ir < 64; ++ir) Ar[ir] = As[ir * 65 + lane];
#pragma unroll
    for (int ir = 0; ir < 64; ++ir) {
      float sacc = (ir == lane) ? 1.f : 0.f;
#pragma unroll
      for (int j = 0; j < ir; ++j) sacc -= __uint_as_float(__builtin_amdgcn_readlane(__float_as_uint(Ar[ir]), j)) * Tc[j];
      Tc[ir] = sacc;
    }
#pragma unroll
    for (int ir = 0; ir < 64; ++ir) Tb[ir * 72 + lane] = f2bf(Tc[ir]);
  }
  __syncthreads();
#pragma unroll 1
  for (int jj = 0; jj < 8; ++jj) {
    const int job = w * 8 + jj, which = job >> 5, tile = job & 31, ti = tile >> 3, tn = tile & 7;
    const u16* BT = which ? kbT : vbT;
    f32x4 acc = {0.f, 0.f, 0.f, 0.f};
#pragma unroll
    for (int ks = 0; ks < 2; ++ks)
      acc = mfma16(ld8(Tb + (ti * 16 + lr) * 72 + ks * 32 + lq * 8), ld8(BT + (tn * 16 + lr) * 72 + ks * 32 + lq * 8), acc);
    const int d = tn * 16 + lr;
#pragma unroll
    for (int r = 0; r < 4; ++r) {
      const int ir = ti * 16 + lq * 4 + r;
      if (which == 0) PROJ[(size_t)(t0 + ir) * NPJ + C_GV + h * 128 + d] = f2bf(acc[r]);
      else WG[(size_t)(t0 + ir) * 512 + h * 128 + d] = f2bf(acc[r]);
    }
  }
  __syncthreads();
}

static __device__ __attribute__((always_inline)) inline void gdn_scan(const Params& p, int l, int bh) {
  char* ws = lsp(p.ws);
  u16* PROJ = (u16*)(ws + OFF_PROJ);
  const u16* WG = (const u16*)(ws + OFF_SCR); const u16* ATT = (const u16*)(ws + OFF_SCR + 16777216);
  const float* EGL = (const float*)(ws + OFF_EGL);
  u16* St = (u16*)lds_base();
  u16* Wl = St + 128 * 136;
  u16* Ql = Wl + 64 * 136;
  u16* KdT = Ql + 64 * 136;
  u16* VnT = KdT + 128 * 72;
  u16* At = VnT + 128 * 72;
  float* red = (float*)(At + 64 * 72);
  float* egls = red + 128;
  const int tid = lv(threadIdx.x), lane = tid & 63, w = tid >> 6, lr = lane & 15, lq = lane >> 4;
  const int b = bh >> 2, h = bh & 3;
  const float* ng = p.norm_g + l * 128;
  f32x4 S[8];
#pragma unroll
  for (int v = 0; v < 8; ++v) S[v] = f32x4{0.f, 0.f, 0.f, 0.f};
  for (int idx = tid; idx < 128 * 136; idx += 512) St[idx] = 0;
  const int it = w >> 1, vb = (w & 1) * 4;
  float ngv[4];
#pragma unroll
  for (int n = 0; n < 4; ++n) ngv[n] = ng[(vb + n) * 16 + lr];
  const int r0 = tid >> 4, seg0 = tid & 15;
  const int ra = tid >> 3, sega = tid & 7;
  bf16x8 pw[2], pq[2], pk[2], pa;
  u16 un[16];
  {
    const int t0 = b * SEQL;
#pragma unroll
    for (int rep = 0; rep < 2; ++rep) {
      const int r = r0 + rep * 32;
      pw[rep] = ld8(WG + (size_t)(t0 + r) * 512 + h * 128 + seg0 * 8);
      pq[rep] = ld8(PROJ + (size_t)(t0 + r) * NPJ + C_GQ + h * 128 + seg0 * 8);
      pk[rep] = ld8(PROJ + (size_t)(t0 + r) * NPJ + C_GK + h * 128 + seg0 * 8);
    }
    pa = ld8(ATT + (size_t)(bh * 32) * 4096 + ra * 64 + sega * 8);
#pragma unroll
    for (int n = 0; n < 4; ++n)
#pragma unroll
      for (int r = 0; r < 4; ++r)
        un[n * 4 + r] = PROJ[(size_t)(t0 + it * 16 + lq * 4 + r) * NPJ + C_GV + h * 128 + (vb + n) * 16 + lr];
    if (tid < 32) egls[tid] = EGL[bh * 32 + tid];
  }
#pragma unroll 1
  for (int c = 0; c < 32; ++c) {
    const int t0 = b * SEQL + c * 64;
#pragma unroll
    for (int rep = 0; rep < 2; ++rep) {
      const int r = r0 + rep * 32;
      *(bf16x8*)(Wl + r * 136 + seg0 * 8) = pw[rep];
      *(bf16x8*)(Ql + r * 136 + seg0 * 8) = pq[rep];
#pragma unroll
      for (int e = 0; e < 8; ++e) KdT[(seg0 * 8 + e) * 72 + r] = (u16)pk[rep][e];
    }
    *(bf16x8*)(At + ra * 72 + sega * 8) = pa;
    u16 uc[16], zc[16];
#pragma unroll
    for (int q = 0; q < 16; ++q) uc[q] = un[q];
#pragma unroll
    for (int n = 0; n < 4; ++n)
#pragma unroll
      for (int r = 0; r < 4; ++r)
        zc[n * 4 + r] = PROJ[(size_t)(t0 + it * 16 + lq * 4 + r) * NPJ + C_GZ + h * 128 + (vb + n) * 16 + lr];
    lds_barrier();
    if (c + 1 < 32) {
      const int t1 = t0 + 64;
#pragma unroll
      for (int rep = 0; rep < 2; ++rep) {
        const int r = r0 + rep * 32;
        pw[rep] = ld8(WG + (size_t)(t1 + r) * 512 + h * 128 + seg0 * 8);
        pq[rep] = ld8(PROJ + (size_t)(t1 + r) * NPJ + C_GQ + h * 128 + seg0 * 8);
        pk[rep] = ld8(PROJ + (size_t)(t1 + r) * NPJ + C_GK + h * 128 + seg0 * 8);
      }
      pa = ld8(ATT + (size_t)(bh * 32 + c + 1) * 4096 + ra * 64 + sega * 8);
#pragma unroll
      for (int n = 0; n < 4; ++n)
#pragma unroll
        for (int r = 0; r < 4; ++r)
          un[n * 4 + r] = PROJ[(size_t)(t1 + it * 16 + lq * 4 + r) * NPJ + C_GV + h * 128 + (vb + n) * 16 + lr];
    }
    f32x4 vacc[4], oacc[4];
#pragma unroll
    for (int n = 0; n < 4; ++n) { vacc[n] = f32x4{0.f, 0.f, 0.f, 0.f}; oacc[n] = f32x4{0.f, 0.f, 0.f, 0.f}; }
#pragma unroll
    for (int ks = 0; ks < 4; ++ks) {
      bf16x8 aw = ld8(Wl + (it * 16 + lr) * 136 + ks * 32 + lq * 8);
      bf16x8 aq = ld8(Ql + (it * 16 + lr) * 136 + ks * 32 + lq * 8);
#pragma unroll
      for (int n = 0; n < 4; ++n) {
        bf16x8 bs = ld8(St + ((vb + n) * 16 + lr) * 136 + ks * 32 + lq * 8);
        vacc[n] = mfma16(aw, bs, vacc[n]);
        oacc[n] = mfma16(aq, bs, oacc[n]);
      }
    }
#pragma unroll
    for (int n = 0; n < 4; ++n) {
      const int v = (vb + n) * 16 + lr;
      *(s16x4*)(VnT + v * 72 + it * 16 + lq * 4) =
          pack4(bf2f(uc[n * 4 + 0]) - vacc[n][0], bf2f(uc[n * 4 + 1]) - vacc[n][1], bf2f(uc[n * 4 + 2]) - vacc[n][2], bf2f(uc[n * 4 + 3]) - vacc[n][3]);
    }
    lds_barrier();
#pragma unroll
    for (int ks = 0; ks < 2; ++ks) {
      bf16x8 aa = ld8(At + (it * 16 + lr) * 72 + ks * 32 + lq * 8);
#pragma unroll
      for (int n = 0; n < 4; ++n)
        oacc[n] = mfma16(aa, ld8(VnT + ((vb + n) * 16 + lr) * 72 + ks * 32 + lq * 8), oacc[n]);
    }
    {
      bf16x8 ak0 = ld8(KdT + (w * 16 + lr) * 72 + lq * 8), ak1 = ld8(KdT + (w * 16 + lr) * 72 + 32 + lq * 8);
#pragma unroll
      for (int vt = 0; vt < 8; ++vt) {
        f32x4 a = S[vt] * egls[c];
        a = mfma16(ak0, ld8(VnT + (vt * 16 + lr) * 72 + lq * 8), a);
        a = mfma16(ak1, ld8(VnT + (vt * 16 + lr) * 72 + 32 + lq * 8), a);
        S[vt] = a;
        *(s16x4*)(St + (vt * 16 + lr) * 136 + w * 16 + lq * 4) = pack4(a[0], a[1], a[2], a[3]);
      }
    }
    {
      float ssr[4];
#pragma unroll
      for (int r = 0; r < 4; ++r) {
        float sq = 0.f;
#pragma unroll
        for (int n = 0; n < 4; ++n) sq += oacc[n][r] * oacc[n][r];
        sq += __shfl_xor(sq, 1); sq += __shfl_xor(sq, 2); sq += __shfl_xor(sq, 4); sq += __shfl_xor(sq, 8);
        ssr[r] = sq;
      }
      if (lr == 0) {
#pragma unroll
        for (int r = 0; r < 4; ++r) red[(it * 16 + lq * 4 + r) * 2 + (w & 1)] = ssr[r];
      }
    }
    lds_barrier();
#pragma unroll
    for (int r = 0; r < 4; ++r) {
      const int ir = it * 16 + lq * 4 + r;
      const float rs = rsqrtf((red[ir * 2] + red[ir * 2 + 1]) * (1.f / 128.f) + 1e-6f);
#pragma unroll
      for (int n = 0; n < 4; ++n) {
        const int v = (vb + n) * 16 + lr;
        const float z = bf2f(zc[n * 4 + r]);
        const float y = oacc[n][r] * rs * ngv[n] * z * __builtin_amdgcn_rcpf(1.f + __expf(-z));
        PROJ[(size_t)(t0 + ir) * NPJ + C_GV + h * 128 + v] = f2bf(y);
      }
    }
  }
  __syncthreads();
}


static __device__ __attribute__((always_inline)) inline void nsa_attn(const Params& p, int item) {
  char* ws = lsp(p.ws);
  u16* PROJ = (u16*)(ws + OFF_PROJ);
  const u16* KC = (const u16*)(ws + OFF_KC); const u16* VCT = (const u16*)(ws + OFF_VCT);
  u16* Ks = (u16*)lds_base();
  float* impw = (float*)(Ks + 4 * 64 * 72);
  unsigned* selm = (unsigned*)(impw + 4 * 64 * 32);
  unsigned* uni = selm + 64;
  const int tid = lv(threadIdx.x), lane = tid & 63, w = tid >> 6;
  const int hh = w & 3, qhalf = w >> 2, lq5 = lane & 31, hf = lane >> 5;
  const int qb = 31 - (item >> 4), bg = item & 15, b = bg >> 1, g = bg & 1;
  const int ql = qhalf * 32 + lq5, tpos = qb * 64 + ql;
  const size_t row = (size_t)b * SEQL + tpos;
  const int head = g * 4 + hh;
  bf16x8 qf[4];
#pragma unroll
  for (int s = 0; s < 4; ++s) {
    bf16x8 raw = ld8(PROJ + row * NPJ + C_NQ + head * 64 + 16 * s + 8 * hf);
#pragma unroll
    for (int e = 0; e < 8; ++e) raw[e] = (short)f2bf(bfs(raw[e]) * 0.125f);
    qf[s] = raw;
  }
  if (tid == 0) *uni = 0u;
  float gate[3];
#pragma unroll
  for (int i = 0; i < 3; ++i) gate[i] = sigmoidf_(bf2f(PROJ[row * NPJ + C_NG + head * 3 + i]));
  f32x16 ofin[2];
  {
    f32x16 sc[4];
    const u16* kcb = KC + (size_t)(b * 2 + g) * 128 * 64;
#pragma unroll
    for (int mt = 0; mt < 4; ++mt) {
#pragma unroll
      for (int i = 0; i < 16; ++i) sc[mt][i] = 0.f;
#pragma unroll
      for (int s = 0; s < 4; ++s) sc[mt] = mfma32(ld8(kcb + (32 * mt + lq5) * 64 + 16 * s + 8 * hf), qf[s], sc[mt]);
    }
    const int nlim = (tpos >= 31) ? min(126, (tpos - 31) >> 4) : -1;
    float mx = -1e30f;
#pragma unroll
    for (int mt = 0; mt < 4; ++mt)
#pragma unroll
      for (int i = 0; i < 16; ++i) { int n = 32 * mt + crow(i, hf); if (n <= nlim) mx = fmaxf(mx, sc[mt][i]); }
    mx = fmaxf(mx, __shfl_xor(mx, 32));
    float ls = 0.f;
#pragma unroll
    for (int mt = 0; mt < 4; ++mt)
#pragma unroll
      for (int i = 0; i < 16; ++i) {
        int n = 32 * mt + crow(i, hf);
        float pv = (n <= nlim) ? __expf(sc[mt][i] - mx) : 0.f;
        sc[mt][i] = pv; ls += pv;
      }
    ls += __shfl_xor(ls, 32);
    const float inv = ls > 0.f ? 1.f / ls : 0.f;
#pragma unroll
    for (int mt = 0; mt < 4; ++mt)
#pragma unroll
      for (int i = 0; i < 16; ++i) sc[mt][i] *= inv;
    f32x16 oc[2];
#pragma unroll
    for (int i = 0; i < 16; ++i) { oc[0][i] = 0.f; oc[1][i] = 0.f; }
    const u16* vcb = VCT + (size_t)(b * 2 + g) * 64 * 128;
#pragma unroll
    for (int mt = 0; mt < 4; ++mt)
#pragma unroll
      for (int s = 0; s < 2; ++s) {
        bf16x8 pf = pack8(sc[mt], s);
#pragma unroll
        for (int dt = 0; dt < 2; ++dt) {
          const u16* vp = vcb + (32 * dt + lq5) * 128 + 32 * mt + 16 * s + 4 * hf;
          s16x4 lo = ld4(vp), hi = ld4(vp + 8);
          bf16x8 vf = __builtin_shufflevector(lo, hi, 0, 1, 2, 3, 4, 5, 6, 7);
          oc[dt] = mfma32(vf, pf, oc[dt]);
        }
      }
#pragma unroll
    for (int i = 0; i < 16; ++i) { ofin[0][i] = gate[0] * oc[0][i]; ofin[1][i] = gate[0] * oc[1][i]; }
    float G[4][4], rl[4][4];
#pragma unroll
    for (int mt = 0; mt < 4; ++mt)
#pragma unroll
      for (int gi = 0; gi < 4; ++gi) {
        G[mt][gi] = sc[mt][4 * gi] + sc[mt][4 * gi + 1] + sc[mt][4 * gi + 2] + sc[mt][4 * gi + 3];
        rl[mt][gi] = __shfl_xor(sc[mt][4 * gi + 3], 32);
      }
#pragma unroll
    for (int mt = 0; mt < 4; ++mt)
#pragma unroll
      for (int gi = 0; gi < 4; ++gi) {
        float prev;
        if (hf == 1) prev = rl[mt][gi];
        else prev = (gi > 0) ? rl[mt][gi > 0 ? gi - 1 : 0] : (mt > 0 ? rl[mt > 0 ? mt - 1 : 0][3] : 0.f);
        impw[(hh * 64 + ql) * 32 + 8 * mt + 2 * gi + hf] = G[mt][gi] + prev;
      }
  }
  __syncthreads();
  if (tid < 64) {
    float scv[32];
#pragma unroll
    for (int j = 0; j < 32; ++j) {
      float v = impw[(0 * 64 + tid) * 32 + j] + impw[(1 * 64 + tid) * 32 + j] + impw[(2 * 64 + tid) * 32 + j] + impw[(3 * 64 + tid) * 32 + j];
      if (j == 0 || j == qb || j == qb - 1) v += 1000.f;
      scv[j] = (j <= qb) ? v : -1e30f;
    }
    unsigned m = 0u;
#pragma unroll 1
    for (int k = 0; k < 8; ++k) {
      float bv = -1e29f; int best = -1;
#pragma unroll
      for (int j = 0; j < 32; ++j) { bool take = !((m >> j) & 1u) && scv[j] > bv; bv = take ? scv[j] : bv; best = take ? j : best; }
      if (best >= 0) m |= 1u << best;
    }
    selm[tid] = m;
    atomicOr(uni, m);
  }
  __syncthreads();
  const unsigned U = *uni;
  const unsigned sm = selm[ql];
#pragma unroll 1
  for (int mode = 0; mode < 2; ++mode) {
    float mrun = -1e30f, lrun = 0.f;
    f32x16 oacc[2];
#pragma unroll
    for (int i = 0; i < 16; ++i) { oacc[0][i] = 0.f; oacc[1][i] = 0.f; }
    const unsigned tmask = mode ? ((2u << qb) - 1u) & ~((1u << max(0, qb - 8)) - 1u) : U;
    const int r_ld = 32 * (w & 1) + (lane & 31), seg_ld = (w >> 1) * 2 + (lane >> 5);
    const int kcol = C_NKV + (mode ? 4 : 2) * 128 + g * 64 + seg_ld * 8;
    unsigned rem = tmask;
    int j = __ffs(rem) - 1;
    rem &= rem - 1u;
    bf16x8 kreg = ld8(PROJ + ((size_t)b * SEQL + 64 * j + r_ld) * NPJ + kcol);
    bf16x8 vreg = ld8(PROJ + ((size_t)b * SEQL + 64 * j + r_ld) * NPJ + kcol + 128);
    int buf = 0;
#pragma unroll 1
    while (j >= 0) {
      u16* Kb_ = Ks + buf * (2 * 64 * 72);
      u16* Vb_ = Kb_ + 64 * 72;
      *(bf16x8*)(Kb_ + r_ld * 72 + seg_ld * 8) = kreg;
#pragma unroll
      for (int e = 0; e < 8; ++e) Vb_[(seg_ld * 8 + e) * 72 + r_ld] = (u16)vreg[e];
      __syncthreads();
      const int jn = rem ? (__ffs(rem) - 1) : -1;
      rem &= rem - 1u;
      if (jn >= 0) {
        kreg = ld8(PROJ + ((size_t)b * SEQL + 64 * jn + r_ld) * NPJ + kcol);
        vreg = ld8(PROJ + ((size_t)b * SEQL + 64 * jn + r_ld) * NPJ + kcol + 128);
      }
      const bool selj = mode ? true : (((sm >> j) & 1u) != 0u);
      if (mode || __any(selj)) {
        f32x16 st[2];
#pragma unroll
        for (int mt = 0; mt < 2; ++mt) {
#pragma unroll
          for (int i = 0; i < 16; ++i) st[mt][i] = 0.f;
#pragma unroll
          for (int s = 0; s < 4; ++s) st[mt] = mfma32(ld8(Kb_ + (32 * mt + lq5) * 72 + 16 * s + 8 * hf), qf[s], st[mt]);
        }
        const bool need_mask = (j == qb) || (mode && j == qb - 8);
        float mloc = -1e30f;
        if (need_mask) {
#pragma unroll
          for (int mt = 0; mt < 2; ++mt)
#pragma unroll
            for (int i = 0; i < 16; ++i) {
              const int dist = tpos - (64 * j + 32 * mt + crow(i, hf));
              const bool ok = selj && dist >= 0 && dist < 512;
              st[mt][i] = ok ? st[mt][i] : -1e30f;
              mloc = fmaxf(mloc, st[mt][i]);
            }
        } else {
#pragma unroll
          for (int mt = 0; mt < 2; ++mt)
#pragma unroll
            for (int i = 0; i < 16; ++i) mloc = fmaxf(mloc, st[mt][i]);
          mloc = selj ? mloc : -1e30f;
        }
        mloc = fmaxf(mloc, __shfl_xor(mloc, 32));
        const float mnew = fmaxf(mrun, mloc);
        const float alpha = __expf(mrun - mnew);
        const bool live = selj && (mnew > -1e29f);
        float psum = 0.f;
#pragma unroll
        for (int mt = 0; mt < 2; ++mt)
#pragma unroll
          for (int i = 0; i < 16; ++i) {
            float pv = __expf(st[mt][i] - mnew);
            pv = live ? pv : 0.f;
            st[mt][i] = pv; psum += pv;
          }
        lrun = lrun * alpha + psum;
        mrun = mnew;
#pragma unroll
        for (int i = 0; i < 16; ++i) { oacc[0][i] *= alpha; oacc[1][i] *= alpha; }
#pragma unroll
        for (int mt = 0; mt < 2; ++mt)
#pragma unroll
          for (int s = 0; s < 2; ++s) {
            bf16x8 pf = pack8(st[mt], s);
#pragma unroll
            for (int dt = 0; dt < 2; ++dt) {
              const u16* vp = Vb_ + (32 * dt + lq5) * 72 + 32 * mt + 16 * s + 4 * hf;
              s16x4 lo = ld4(vp), hi = ld4(vp + 8);
              bf16x8 vf = __builtin_shufflevector(lo, hi, 0, 1, 2, 3, 4, 5, 6, 7);
              oacc[dt] = mfma32(vf, pf, oacc[dt]);
            }
          }
      }
      buf ^= 1;
      j = jn;
    }
    const float ltot = lrun + __shfl_xor(lrun, 32);
    const float sc_ = (ltot > 0.f) ? gate[1 + mode] / ltot : 0.f;
#pragma unroll
    for (int i = 0; i < 16; ++i) { ofin[0][i] += sc_ * oacc[0][i]; ofin[1][i] += sc_ * oacc[1][i]; }
    __syncthreads();
  }
#pragma unroll
  for (int dt = 0; dt < 2; ++dt)
#pragma unroll
    for (int g4 = 0; g4 < 4; ++g4)
      *(s16x4*)(PROJ + row * NPJ + C_NQ + head * 64 + 32 * dt + 8 * g4 + 4 * hf) =
          pack4(ofin[dt][4 * g4], ofin[dt][4 * g4 + 1], ofin[dt][4 * g4 + 2], ofin[dt][4 * g4 + 3]);
  __syncthreads();
}

static __device__ __attribute__((always_inline)) inline void phase_merge(const Params& p) {
  char* ws = lsp(p.ws);
  u16* H = (u16*)(ws + OFF_H); u16* WinT = (u16*)(ws + OFF_WBIG); u16* PROJ = (u16*)(ws + OFF_PROJ);
  u16* WbrT = (u16*)(ws + OFF_WBR); u16* M = (u16*)(ws + OFF_SCR);
  const int nM = 64, nN = 4;
  for (int t = blockIdx.x; t < nM * nN; t += gridDim.x) {
    int pm, pn; tile_map(t, nM, nN, pm, pn);
#pragma unroll 1
    for (int i = 0; i < 3; ++i) {
      const int boff = 5120 + i * 1024 + pn * 256;
      gemm_tile(H, 1024, WinT, 1024, 1024, pm * 256, boff, [&](int idx, int row, int col, f32x4 v) {
        *(s16x4*)(PROJ + (size_t)row * NPJ + C_SK + (col - 5120 - i * 1024)) = pack4(sigmoidf_(v[0]), sigmoidf_(v[1]), sigmoidf_(v[2]), sigmoidf_(v[3]));
      });
      const int ycol = (i == 0) ? C_GV : (i == 1 ? C_NQ : C_SQ);
      s16x4 gbuf[2], mbuf[2];
      gemm_tile(PROJ + ycol, NPJ, WbrT + (size_t)i * 1024 * 512, 512, 512, pm * 256, pn * 256, [&](int idx, int row, int col, f32x4 v) {
        const s16x4 gte = gbuf[idx];
        float o0 = bfs(gte[0]) * v[0], o1 = bfs(gte[1]) * v[1], o2 = bfs(gte[2]) * v[2], o3 = bfs(gte[3]) * v[3];
        if (i > 0) { const s16x4 pv = mbuf[idx]; o0 += bfs(pv[0]); o1 += bfs(pv[1]); o2 += bfs(pv[2]); o3 += bfs(pv[3]); }
        *(s16x4*)(M + (unsigned)(row * 1024 + col)) = pack4(o0, o1, o2, o3);
      }, [&](int idx, int row, int col) {
        gbuf[idx] = ld4(PROJ + (unsigned)(row * NPJ + C_SK + col));
        if (i > 0) mbuf[idx] = ld4(M + (unsigned)(row * 1024 + col));
      });
    }
  }
}

template <int MODE>
static __device__ __attribute__((always_inline)) inline void phase_gemm(const u16* A, int lda, const u16* Bt, int ldb, int K, int nM, int nN, u16* C, int ldc) {
  for (int t = blockIdx.x; t < nM * nN; t += gridDim.x) {
    int pm, pn; tile_map(t, nM, nN, pm, pn);
    gemm_tile(A, lda, Bt, ldb, K, pm * 256, pn * 256, [&](int idx, int row, int col, f32x4 v) {
      if (MODE == 1) {
#pragma unroll
        for (int q = 0; q < 4; ++q) { float t = fmaxf(v[q], 0.f); v[q] = t * t; }
      }
      *(s16x4*)(C + (size_t)row * ldc + col) = pack4(v[0], v[1], v[2], v[3]);
    });
  }
}


#define XB_TMO      128
#define XB_XCNT(j)  (256  + 64 * (j))
#define XB_XSUB(j)  (1280 + 64 * (j))
#define XB_XGEN(j)  (2304 + 64 * (j))
#define XB_TOP      3328
#define XB_TOPGEN   3392
#define XCD_BAR_WORDS 3456
#define XB_SPIN_CAP (1u << 18)
#define LAS __attribute__((address_space(3)))
DI unsigned xb_ld(unsigned* q)              { return __hip_atomic_load(q, __ATOMIC_RELAXED, __HIP_MEMORY_SCOPE_AGENT); }
DI unsigned xb_add(unsigned* q, unsigned v) { return __hip_atomic_fetch_add(q, v, __ATOMIC_RELAXED, __HIP_MEMORY_SCOPE_AGENT); }
DI unsigned xb_xcc_id() { return (unsigned)__builtin_amdgcn_s_getreg((3 << 11) | 20) & 0xFu; }
#define XB_SPIN(cond, bar) do { unsigned _sp = 0; while (cond) { __builtin_amdgcn_s_sleep(1); \
    if ((++_sp & 255u) == 0u) { if (xb_ld(&(bar)[XB_TMO])) break; if (_sp > XB_SPIN_CAP) { atomicAdd(&(bar)[XB_TMO], 1u); break; } } } } while (0)
struct XcdBarrier { unsigned* bar; unsigned x; volatile LAS unsigned* st; };
DI XcdBarrier xcd_barrier_post(unsigned* bar, volatile LAS unsigned* st) {
  XcdBarrier b; b.bar = bar; b.x = xb_xcc_id(); b.st = st;
  if (threadIdx.x == 0) (void)xb_add(&bar[XB_XCNT(b.x)], 1u);
  return b;
}
DI void xcd_barrier_complete(unsigned* bar, unsigned x, unsigned& nloc, unsigned& nx) {
  const unsigned G = gridDim.x * gridDim.y * gridDim.z;
  unsigned sum, cnt, mine, sp = 0u;
  for (;;) {
    sum = 0u; cnt = 0u; mine = 0u;
#pragma unroll
    for (unsigned j = 0; j < 16; ++j) { const unsigned c = xb_ld(&bar[XB_XCNT(j)]); sum += c; cnt += (c > 0u) ? 1u : 0u; mine = (j == x) ? c : mine; }
    if (sum == G) break;
    __builtin_amdgcn_s_sleep(1);
    if ((++sp & 255u) == 0u) { if (xb_ld(&bar[XB_TMO])) break; if (sp > XB_SPIN_CAP) { atomicAdd(&bar[XB_TMO], 1u); break; } }
  }
  nloc = mine > 0u ? mine : 1u; nx = cnt > 0u ? cnt : 1u;
}
DI void xcd_barrier(const XcdBarrier& b) {
  asm volatile("s_waitcnt vmcnt(0)" ::: "memory");
  __syncthreads();
  if (threadIdx.x == 0) {
    unsigned* bar = b.bar;
    __builtin_amdgcn_s_waitcnt(0);
    unsigned nloc = b.st[0], nx = b.st[1];
    if (nloc == 0u) { xcd_barrier_complete(bar, b.x, nloc, nx); b.st[0] = nloc; b.st[1] = nx; }
    const unsigned old = xb_add(&bar[XB_XSUB(b.x)], 1u);
    const unsigned gen = old / nloc;
    if (old + 1u == (gen + 1u) * nloc) {
      __builtin_amdgcn_fence(__ATOMIC_RELEASE, "agent");
      asm volatile("s_waitcnt vmcnt(0)" ::: "memory");
      const unsigned og = xb_add(&bar[XB_TOP], 1u);
      const unsigned tg = og / nx;
      if (og + 1u == (tg + 1u) * nx) xb_add(&bar[XB_TOPGEN], 1u);
      else XB_SPIN(xb_ld(&bar[XB_TOPGEN]) == tg, bar);
      __builtin_amdgcn_fence(__ATOMIC_ACQUIRE, "agent");
      xb_add(&bar[XB_XGEN(b.x)], 1u);
      asm volatile("s_waitcnt vmcnt(0)" ::: "memory");
    } else {
      XB_SPIN(xb_ld(&bar[XB_XGEN(b.x)]) == gen, bar);
      __builtin_amdgcn_fence(__ATOMIC_ACQUIRE, "agent");
      asm volatile("s_waitcnt vmcnt(0)" ::: "memory");
    }
  }
  __syncthreads();
}

__global__ void __launch_bounds__(512) fwd_megakernel(Params p_unused) {
#define p (kp())
  cg::grid_group grid = cg::this_grid();
  volatile LAS unsigned* xst = (volatile LAS unsigned*)((LAS char*)g_shm + LDS_XST);
  if (threadIdx.x == 0) { xst[0] = 0u; xst[1] = 0u; }
  __syncthreads();
  (void)xcd_barrier_post((unsigned*)(lsp(p.ws) + OFF_BAR), xst);
#define GSYNC() do { XcdBarrier xb_; xb_.bar = (unsigned*)(lsp(p.ws) + OFF_BAR); unsigned xx_ = xb_xcc_id(); asm volatile("" : "+s"(xx_)); xb_.x = xx_; \
    xb_.st = (volatile LAS unsigned*)((LAS char*)g_shm + LDS_XST); xcd_barrier(xb_); } while (0)
#define WSP(off) ((u16*)(lsp(p.ws) + (off)))
  phase_norm(p.x, nullptr, nullptr, p.g_mix_pre, nullptr, WSP(OFF_H));
  convert_mixer_weights(p, 0);
  if (p.ws == nullptr) grid.sync();
  GSYNC();
#pragma unroll 1
  for (int l = 0; l < 2; ++l) {
    phase_inproj(p);
    GSYNC();
    {
      volatile LAS int* qslot = (volatile LAS int*)((LAS char*)g_shm + LDS_XST + 16);
#pragma unroll 1
      for (;;) {
        if (threadIdx.x == 0) *qslot = (int)atomicAdd((unsigned*)(lsp(p.ws) + OFF_QCTR) + l * 64 + 32, 1u);
        __syncthreads();
        const int it = *qslot;
        __syncthreads();
        if (it >= 1152) break;
        if (it < 128) nsa_compress(p, l, it);
        else gdn_prep(p, l, it - 128);
      }
    }
    GSYNC();
    if (blockIdx.x < 32) gdn_scan(p, l, blockIdx.x);
    {
      volatile LAS int* qslot = (volatile LAS int*)((LAS char*)g_shm + LDS_XST + 16);
#pragma unroll 1
      for (;;) {
        if (threadIdx.x == 0) *qslot = (int)atomicAdd((unsigned*)(lsp(p.ws) + OFF_QCTR) + l * 64, 1u);
        __syncthreads();
        const int it = *qslot;
        __syncthreads();
        if (it >= 768) break;
        if (it < 192) nsa_attn(p, it);
        else if (it < 448) { sb_attn_wave(p, (it - 192) * 8 + (lv(threadIdx.x) >> 6)); __syncthreads(); }
        else nsa_attn(p, it - 256);
      }
    }
    GSYNC();
    phase_merge(p);
    GSYNC();
    phase_gemm<0>(WSP(OFF_SCR), 1024, WSP(OFF_WOUT), 1024, 1024, 64, 4, WSP(OFF_H), 1024);
    GSYNC();
    phase_norm(l == 0 ? p.x : p.out, WSP(OFF_H), p.g_mix_post + l * 1024, p.g_ff_pre + l * 1024, p.out, WSP(OFF_H));
    convert_ffn_weights(p, l);
    GSYNC();
    phase_gemm<1>(WSP(OFF_H), 1024, WSP(OFF_WBIG), 1024, 1024, 64, 16, WSP(OFF_PROJ), 4096);
    GSYNC();
    phase_gemm<0>(WSP(OFF_PROJ), 4096, WSP(OFF_WBIG) + (size_t)4096 * 1024, 4096, 4096, 64, 4, WSP(OFF_SCR), 1024);
    GSYNC();
    phase_norm(p.out, WSP(OFF_SCR), p.g_ff_post + l * 1024, (l == 0) ? p.g_mix_pre + 1024 : nullptr, p.out, WSP(OFF_H));
    if (l == 0) { convert_mixer_weights(p, 1); GSYNC(); }
  }
}
#undef p

extern "C" void kernel_launch(void* const* d_in, const int* in_sizes, int n_in, void* d_out, int out_size, void* d_ws,
                              size_t ws_size, hipStream_t stream) {
  static int grid_blocks = 0;
  if (!grid_blocks) {
    int dev = 0, cus = 0, per_cu = 0;
    (void)hipGetDevice(&dev);
    (void)hipDeviceGetAttribute(&cus, hipDeviceAttributeMultiprocessorCount, dev);
    (void)hipFuncSetAttribute((const void*)fwd_megakernel, hipFuncAttributeMaxDynamicSharedMemorySize, LDS_BYTES);
    (void)hipOccupancyMaxActiveBlocksPerMultiprocessor(&per_cu, (const void*)fwd_megakernel, 512, LDS_BYTES);
    if (per_cu < 1) per_cu = 1;
    grid_blocks = cus * 1;
    if (ws_size < WS_NEED) fprintf(stderr, "workspace too small: %zu < %zu\n", ws_size, (size_t)WS_NEED);
  }
  Params p{};
  p.x = (const float*)d_in[0]; p.g_mix_pre = (const float*)d_in[1]; p.g_mix_post = (const float*)d_in[2];
  p.g_ff_pre = (const float*)d_in[3]; p.g_ff_post = (const float*)d_in[4]; p.w_in = (const float*)d_in[5];
  p.conv_w = (const float*)d_in[6]; p.a_log = (const float*)d_in[7]; p.dt_bias = (const float*)d_in[8];
  p.norm_g = (const float*)d_in[9]; p.cmp_wk = (const float*)d_in[10]; p.cmp_pk = (const float*)d_in[11];
  p.cmp_wv = (const float*)d_in[12]; p.cmp_pv = (const float*)d_in[13]; p.w_br0 = (const float*)d_in[14];
  p.w_br1 = (const float*)d_in[15]; p.w_br2 = (const float*)d_in[16]; p.w_out = (const float*)d_in[17];
  p.w_ff1 = (const float*)d_in[18]; p.w_ff2 = (const float*)d_in[19];
  p.out = (float*)d_out; p.ws = (char*)d_ws;
  (void)hipMemsetAsync((char*)d_ws + OFF_BAR, 0, 16384, stream);
  void* args[] = {&p};
  hipError_t e = hipLaunchCooperativeKernel((const void*)fwd_megakernel, dim3(grid_blocks), dim3(512), args, LDS_BYTES, stream);
  if (e != hipSuccess) fprintf(stderr, "cooperative launch failed: %s (grid %d)\n", hipGetErrorString(e), grid_blocks);
}
```

```cpp
#include <hip/hip_runtime.h>
#include <hip/hip_bf16.h>
#include <hip/hip_cooperative_groups.h>
#include <cstdio>
namespace cg = cooperative_groups;

typedef unsigned short u16;
using bf16x8 = __attribute__((ext_vector_type(8))) short;
using s16x4  = __attribute__((ext_vector_type(4))) short;
using f32x4  = __attribute__((ext_vector_type(4))) float;
using f32x16 = __attribute__((ext_vector_type(16))) float;
#define DI __device__ __forceinline__

constexpr int T_TOK = 16384, SEQL = 2048;
constexpr int NPJ = 4896;
constexpr int N_IN = 7968;
constexpr int C_GQ = 0, C_GK = 512, C_GV = 1024, C_GZ = 1536, C_GA = 2048, C_GB = 2052, C_NQ = 2056, C_NKV = 2568,
              C_NG = 3336, C_SQ = 3360, C_SK = 3872;
constexpr size_t OFF_WBR  = 0;
constexpr size_t OFF_WOUT = 3145728;
constexpr size_t OFF_WBIG = 5242880;
constexpr size_t OFF_PROJ = 22020096;
constexpr size_t OFF_SCR  = OFF_PROJ + 160432128;
constexpr size_t OFF_H    = OFF_SCR + 33554432;
constexpr size_t OFF_HALO = OFF_H + 33554432;
constexpr size_t OFF_KC   = OFF_HALO + 2359296;
constexpr size_t OFF_VCT  = OFF_KC + 262144;
constexpr size_t OFF_EGL  = OFF_VCT + 262144;
constexpr size_t OFF_WT   = OFF_EGL + 4096;
constexpr size_t OFF_CB   = OFF_WT + 524288;
constexpr size_t OFF_BAR  = OFF_CB + 512;
constexpr size_t OFF_QCTR = OFF_BAR + 14336;
constexpr size_t WS_NEED  = OFF_BAR + 16384;
constexpr int LDS_XST = 155648;
constexpr int LDS_BYTES = LDS_XST + 32;

struct Params {
  const float* x; const float* g_mix_pre; const float* g_mix_post; const float* g_ff_pre; const float* g_ff_post;
  const float* w_in; const float* conv_w; const float* a_log; const float* dt_bias; const float* norm_g;
  const float* cmp_wk; const float* cmp_pk; const float* cmp_wv; const float* cmp_pv;
  const float* w_br0; const float* w_br1; const float* w_br2; const float* w_out; const float* w_ff1; const float* w_ff2;
  float* out; char* ws;
};

extern __shared__ __attribute__((aligned(16))) char g_shm[];

typedef __bf16 bf2_t __attribute__((ext_vector_type(2)));
typedef float f2_t __attribute__((ext_vector_type(2)));
typedef unsigned u32x2 __attribute__((ext_vector_type(2)));
typedef unsigned u32x4 __attribute__((ext_vector_type(4)));
DI unsigned cvt2(float a, float b) { f2_t v; v[0] = a; v[1] = b; return __builtin_bit_cast(unsigned, __builtin_convertvector(v, bf2_t)); }
DI u16 f2bf(float x) { return (u16)(cvt2(x, x) & 0xffffu); }
DI float bf2f(u16 b) { return __uint_as_float(((unsigned)b) << 16); }
DI float bfs(short b) { return __uint_as_float(((unsigned)(u16)b) << 16); }
DI bf16x8 ld8(const u16* p) { return *(const bf16x8*)p; }
DI s16x4 ld4(const u16* p) { return *(const s16x4*)p; }
DI f32x4 mfma16(bf16x8 a, bf16x8 b, f32x4 c) { return __builtin_amdgcn_mfma_f32_16x16x32_bf16(a, b, c, 0, 0, 0); }
DI f32x16 mfma32(bf16x8 a, bf16x8 b, f32x16 c) { return __builtin_amdgcn_mfma_f32_32x32x16_bf16(a, b, c, 0, 0, 0); }
DI s16x4 pack4(float a, float b, float c, float d) { u32x2 r; r[0] = cvt2(a, b); r[1] = cvt2(c, d); return __builtin_bit_cast(s16x4, r); }
DI float sigmoidf_(float x) { return __builtin_amdgcn_rcpf(1.f + __expf(-x)); }
DI float softplusf_(float x) { return fmaxf(x, 0.f) + log1pf(__expf(-fabsf(x))); }
DI int lv(int v) { asm volatile("" : "+v"(v)); return v; }
DI char* lsp(char* q) { auto g = (__attribute__((address_space(1))) char*)q; asm volatile("" : "+s"(g)); return (char*)g; }
typedef const __attribute__((address_space(4))) Params* kparg_t;
#if defined(__HIP_DEVICE_COMPILE__)
DI Params kp() { kparg_t q = (kparg_t)__builtin_amdgcn_kernarg_segment_ptr(); asm volatile("" : "+s"(q)); return *q; }
#else
DI Params kp() { return Params{}; }
#endif
DI char* lds_base() { auto q = (__attribute__((address_space(3))) char*)g_shm; asm volatile("" : "+v"(q)); return (char*)q; }
DI void lds_barrier() { asm volatile("s_waitcnt lgkmcnt(0)" ::: "memory"); __builtin_amdgcn_s_barrier(); asm volatile("" ::: "memory"); }
DI int crow(int i, int h) { return (i & 3) + 8 * (i >> 2) + 4 * h; }
DI bf16x8 pack8(const f32x16& x, int s) {
  u32x4 r;
  r[0] = cvt2(x[8 * s + 0], x[8 * s + 1]); r[1] = cvt2(x[8 * s + 2], x[8 * s + 3]);
  r[2] = cvt2(x[8 * s + 4], x[8 * s + 5]); r[3] = cvt2(x[8 * s + 6], x[8 * s + 7]);
  return __builtin_bit_cast(bf16x8, r);
}

static __device__ __attribute__((always_inline)) inline void convert_weight(const float* W, int K, int N, u16* out, int ldo, bool winmap, int boff = 0) {
  float* lds = (float*)lds_base();
  const int tid = lv(threadIdx.x);
  const int nkt = K / 64, nnt = (N + 127) / 128, ntiles = nkt * nnt;
  f32x4 v[4];
#define CW_LOAD(T) do { const int kt_ = (T) % nkt, nt_ = (T) / nkt; \
    _Pragma("unroll") for (int q = 0; q < 4; ++q) { const int e = tid + q * 512, kk = e >> 5, n = nt_ * 128 + (e & 31) * 4; \
      v[q] = f32x4{0.f, 0.f, 0.f, 0.f}; if (n < N) v[q] = *(const f32x4*)(W + (size_t)(kt_ * 64 + kk) * N + n); } } while (0)
  int t = (int)((blockIdx.x + gridDim.x - (unsigned)boff) % gridDim.x);
  if (t < ntiles) CW_LOAD(t);
  for (; t < ntiles; t += gridDim.x) {
    const int kt = t % nkt, nt = t / nkt, k0 = kt * 64, n0 = nt * 128;
#pragma unroll
    for (int q = 0; q < 4; ++q) {
      const int e = tid + q * 512, kk = e >> 5, nn = (e & 31) * 4;
      lds[kk * 129 + nn + 0] = v[q][0]; lds[kk * 129 + nn + 1] = v[q][1]; lds[kk * 129 + nn + 2] = v[q][2]; lds[kk * 129 + nn + 3] = v[q][3];
    }
    lds_barrier();
    if (t + (int)gridDim.x < ntiles) CW_LOAD(t + (int)gridDim.x);
#pragma unroll
    for (int rep = 0; rep < 2; ++rep) {
      const int nn = (tid >> 3) + 64 * rep, ks = tid & 7, n = n0 + nn;
      if (n < N) {
        const int orow = winmap ? (n < NPJ ? n : n + 224) : n;
        u32x4 o;
#pragma unroll
        for (int e = 0; e < 4; ++e) o[e] = cvt2(lds[(ks * 8 + 2 * e) * 129 + nn], lds[(ks * 8 + 2 * e + 1) * 129 + nn]);
        *(u32x4*)(out + (size_t)orow * ldo + k0 + ks * 8) = o;
      }
    }
    lds_barrier();
  }
#undef CW_LOAD
  __syncthreads();
}

static __device__ __attribute__((always_inline)) inline void convert_mixer_weights(const Params& p, int l) {
  char* ws = lsp(p.ws);
  convert_weight(p.w_in + (size_t)l * 1024 * N_IN, 1024, N_IN, (u16*)(ws + OFF_WBIG), 1024, true);
  convert_weight(p.w_br0 + (size_t)l * 512 * 1024, 512, 1024, (u16*)(ws + OFF_WBR), 512, false);
  convert_weight(p.w_br1 + (size_t)l * 512 * 1024, 512, 1024, (u16*)(ws + OFF_WBR) + 1024 * 512, 512, false, 64);
  convert_weight(p.w_br2 + (size_t)l * 512 * 1024, 512, 1024, (u16*)(ws + OFF_WBR) + 2 * 1024 * 512, 512, false, 128);
  convert_weight(p.w_out + (size_t)l * 1024 * 1024, 1024, 1024, (u16*)(ws + OFF_WOUT), 1024, false, 192);
  convert_weight(p.cmp_wk + (size_t)l * 131072, 2048, 64, (u16*)(ws + OFF_WT), 2048, false, 64);
  convert_weight(p.cmp_wv + (size_t)l * 131072, 2048, 64, (u16*)(ws + OFF_WT) + 64 * 2048, 2048, false, 96);
  if (blockIdx.x >= 160 && blockIdx.x < 162) {
    const int kv = blockIdx.x - 160, tid = lv(threadIdx.x), e = tid & 63, part = tid >> 6;
    const float* W = (kv ? p.cmp_wv : p.cmp_wk) + (size_t)l * 131072;
    const float* pp = (kv ? p.cmp_pv : p.cmp_pk) + (size_t)l * 2048;
    float* red = (float*)lds_base();
    float sacc = 0.f;
    for (int k = part * 256; k < part * 256 + 256; ++k) sacc += pp[k] * W[k * 64 + e];
    red[part * 64 + e] = sacc;
    __syncthreads();
    if (tid < 64) { float t = 0.f; for (int q = 0; q < 8; ++q) t += red[q * 64 + tid]; ((float*)(ws + OFF_CB))[kv * 64 + tid] = t; }
    __syncthreads();
  }
}
static __device__ __attribute__((always_inline)) inline void convert_ffn_weights(const Params& p, int l) {
  char* ws = lsp(p.ws);
  convert_weight(p.w_ff1 + (size_t)l * 1024 * 4096, 1024, 4096, (u16*)(ws + OFF_WBIG), 1024, false);
  convert_weight(p.w_ff2 + (size_t)l * 4096 * 1024, 4096, 1024, (u16*)(ws + OFF_WBIG) + (size_t)4096 * 1024, 4096, false);
}

DI float wave_sum(float v) {
#pragma unroll
  for (int o = 32; o > 0; o >>= 1) v += __shfl_xor(v, o);
  return v;
}
static __device__ __attribute__((always_inline)) inline void phase_norm(const float* xin, const u16* y, const float* g_post, const float* g_next, float* xout, u16* H) {
  const int tidn = lv(threadIdx.x);
  const int wave = tidn >> 6, lane = tidn & 63;
  f32x4 gp[4], gn[4];
#pragma unroll
  for (int i = 0; i < 4; ++i) {
    gp[i] = y ? *(const f32x4*)(g_post + i * 256 + lane * 4) : f32x4{0.f, 0.f, 0.f, 0.f};
    gn[i] = g_next ? *(const f32x4*)(g_next + i * 256 + lane * 4) : f32x4{0.f, 0.f, 0.f, 0.f};
  }
  for (int row0 = (blockIdx.x * 8 + wave) * 2; row0 < T_TOK; row0 += gridDim.x * 16) {
    float xv[2][16], yv[2][16];
#pragma unroll
    for (int rr = 0; rr < 2; ++rr)
#pragma unroll
      for (int i = 0; i < 4; ++i) {
        f32x4 t = *(const f32x4*)(xin + (size_t)(row0 + rr) * 1024 + i * 256 + lane * 4);
        xv[rr][i * 4 + 0] = t[0]; xv[rr][i * 4 + 1] = t[1]; xv[rr][i * 4 + 2] = t[2]; xv[rr][i * 4 + 3] = t[3];
      }
    if (y) {
      float ss[2] = {0.f, 0.f};
#pragma unroll
      for (int rr = 0; rr < 2; ++rr)
#pragma unroll
        for (int i = 0; i < 4; ++i) {
          s16x4 t = ld4(y + (size_t)(row0 + rr) * 1024 + i * 256 + lane * 4);
#pragma unroll
          for (int e = 0; e < 4; ++e) { yv[rr][i * 4 + e] = bfs(t[e]); ss[rr] += yv[rr][i * 4 + e] * yv[rr][i * 4 + e]; }
        }
#pragma unroll
      for (int o = 32; o > 0; o >>= 1) { float t0 = __shfl_xor(ss[0], o), t1 = __shfl_xor(ss[1], o); ss[0] += t0; ss[1] += t1; }
#pragma unroll
      for (int rr = 0; rr < 2; ++rr) {
        const float r = rsqrtf(ss[rr] * (1.f / 1024.f) + 1e-6f);
#pragma unroll
        for (int i = 0; i < 4; ++i) {
          const f32x4 g = gp[i];
          f32x4 o;
#pragma unroll
          for (int e = 0; e < 4; ++e) { xv[rr][i * 4 + e] += yv[rr][i * 4 + e] * r * g[e]; o[e] = xv[rr][i * 4 + e]; }
          *(f32x4*)(xout + (size_t)(row0 + rr) * 1024 + i * 256 + lane * 4) = o;
        }
      }
    }
    if (g_next) {
      float ss[2] = {0.f, 0.f};
#pragma unroll
      for (int rr = 0; rr < 2; ++rr)
#pragma unroll
        for (int i = 0; i < 16; ++i) ss[rr] += xv[rr][i] * xv[rr][i];
#pragma unroll
      for (int o = 32; o > 0; o >>= 1) { float t0 = __shfl_xor(ss[0], o), t1 = __shfl_xor(ss[1], o); ss[0] += t0; ss[1] += t1; }
#pragma unroll
      for (int rr = 0; rr < 2; ++rr) {
        const float r = rsqrtf(ss[rr] * (1.f / 1024.f) + 1e-6f);
#pragma unroll
        for (int i = 0; i < 4; ++i) {
          const f32x4 g = gn[i];
          *(s16x4*)(H + (size_t)(row0 + rr) * 1024 + i * 256 + lane * 4) =
              pack4(xv[rr][i * 4] * r * g[0], xv[rr][i * 4 + 1] * r * g[1], xv[rr][i * 4 + 2] * r * g[2], xv[rr][i * 4 + 3] * r * g[3]);
        }
      }
    }
  }
}

constexpr int BM = 256, BK = 64, HALF = 128, HT = HALF * BK;
DI int lds_byte(int r, int c) {
  int st = (r >> 4) * 2 + (c >> 5), rr = r & 15, cc = c & 31, ob = rr * 64 + cc * 2;
  return st * 1024 + (ob ^ (((ob >> 9) & 1) << 5));
}
DI void stage_rc(int b, int& R, int& C) {
  int st = b / 1024, sb = b % 1024, swz = sb ^ (((sb >> 9) & 1) << 5);
  R = (st >> 1) * 16 + swz / 64; C = (st & 1) * 32 + (swz % 64) / 2;
}
DI void tile_map(int wgid, int nM, int nN, int& pm, int& pn) {
  const int NXCD = 8, WGM = 8;
  int nwg = nM * nN;
  { int q = nwg / NXCD, r = nwg % NXCD, xcd = wgid % NXCD, off = wgid / NXCD;
    wgid = (xcd < r ? xcd * (q + 1) : r * (q + 1) + (xcd - r) * q) + off; }
  int nig = WGM * nN, gid = wgid / nig, fm = gid * WGM, gsz = min(nM - fm, WGM);
  pm = fm + ((wgid % nig) % gsz); pn = (wgid % nig) / gsz;
}

struct NoPre { DI void operator()(int, int, int) const {} };
template <class Epi, class Pre = NoPre>
DI void gemm_tile(const u16* A, int lda, const u16* Bt, int ldb, int K, int brow, int bcol, Epi epi, Pre pre = Pre()) {
  u16* shm = (u16*)g_shm;
#define SA(b, h) (shm + ((b) * 2 + (h)) * HT)
#define SB(b, h) (shm + (4 + (b) * 2 + (h)) * HT)
#define STAGE(P, BASE, LD, br, kt) do { const char* _gb = (const char*)((BASE) + (size_t)(br) * (LD) + (size_t)(kt) * BK); \
    for (int _i = 0; _i < 2; ++_i) { int _b = tidx * 16 + _i * 8192; \
      __builtin_amdgcn_global_load_lds((const unsigned*)(_gb + (((LD) == lda) ? offA[_i] : offB[_i])), \
        (__attribute__((address_space(3))) unsigned*)((char*)(P) + _b), 16, 0, 0); } } while (0)
#define LDA(dst, b, h) for (int m = 0; m < 4; ++m) for (int k = 0; k < 2; ++k) \
    dst[m][k] = *reinterpret_cast<const bf16x8*>((char*)SA(b, h) + lds_byte(wr * 64 + m * 16 + fr, k * 32 + fq * 8))
#define LDB(dst, b, h) for (int n = 0; n < 2; ++n) for (int k = 0; k < 2; ++k) \
    dst[n][k] = *reinterpret_cast<const bf16x8*>((char*)SB(b, h) + lds_byte(wc * 32 + n * 16 + fr, k * 32 + fq * 8))
#define MMA(ai, bj, At_, Bt_) do { __builtin_amdgcn_s_setprio(1); \
    for (int m = 0; m < 4; ++m) for (int n = 0; n < 2; ++n) for (int k = 0; k < 2; ++k) \
      acc[ai][bj][m][n] = __builtin_amdgcn_mfma_f32_16x16x32_bf16(Bt_[n][k], At_[m][k], acc[ai][bj][m][n], 0, 0, 0); \
    __builtin_amdgcn_s_setprio(0); } while (0)
#define WAIT_V(n) asm volatile("s_waitcnt vmcnt(" #n ")" ::: "memory")
#define WAIT_L(n) asm volatile("s_waitcnt lgkmcnt(" #n ")" ::: "memory")
#define BAR __builtin_amdgcn_s_barrier()
#define SCHED __builtin_amdgcn_sched_barrier(0)
  int tidx = threadIdx.x; asm volatile("" : "+v"(tidx));
  const int wid = tidx >> 6, lane = tidx & 63, wr = wid >> 2, wc = wid & 3, fr = lane & 15, fq = lane >> 4;
  unsigned offA[2], offB[2];
#pragma unroll
  for (int _i = 0; _i < 2; ++_i) { int _r, _c; stage_rc(tidx * 16 + _i * 8192, _r, _c); offA[_i] = (unsigned)(_r * lda + _c) * 2u; offB[_i] = (unsigned)(_r * ldb + _c) * 2u; }
  f32x4 acc[2][2][4][2] = {};
  bf16x8 At[4][2], B0[2][2], B1[2][2];
  const int nt = K / BK;
  STAGE(SB(0, 0), Bt, ldb, bcol, 0); STAGE(SA(0, 0), A, lda, brow, 0);
  STAGE(SB(0, 1), Bt, ldb, bcol + HALF, 0); STAGE(SA(0, 1), A, lda, brow + HALF, 0);
  if (wr == 1) BAR;
  WAIT_V(4); BAR;
  STAGE(SB(1, 0), Bt, ldb, bcol, 1); STAGE(SA(1, 0), A, lda, brow, 1); STAGE(SB(1, 1), Bt, ldb, bcol + HALF, 1);
  WAIT_V(6); BAR;
  for (int t = 0; t < nt - 2; t += 2) {
    LDB(B0, 0, 0); SCHED; LDA(At, 0, 0); STAGE(SA(1, 1), A, lda, brow + HALF, t + 1);
    WAIT_L(8); BAR; WAIT_L(0); MMA(0, 0, At, B0); BAR; SCHED;
    LDB(B1, 0, 1); STAGE(SB(0, 0), Bt, ldb, bcol, t + 2);
    BAR; WAIT_L(0); MMA(0, 1, At, B1); BAR;
    LDA(At, 0, 1); STAGE(SA(0, 0), A, lda, brow, t + 2);
    BAR; WAIT_L(0); MMA(1, 0, At, B0); BAR; SCHED;
    STAGE(SB(0, 1), Bt, ldb, bcol + HALF, t + 2);
    WAIT_V(6); BAR; MMA(1, 1, At, B1); BAR;
    LDB(B0, 1, 0); SCHED; LDA(At, 1, 0); STAGE(SA(0, 1), A, lda, brow + HALF, t + 2);
    WAIT_L(8); BAR; WAIT_L(0); MMA(0, 0, At, B0); BAR; SCHED;
    LDB(B1, 1, 1); STAGE(SB(1, 0), Bt, ldb, bcol, t + 3);
    BAR; WAIT_L(0); MMA(0, 1, At, B1); BAR;
    LDA(At, 1, 1); STAGE(SA(1, 0), A, lda, brow, t + 3);
    BAR; WAIT_L(0); MMA(1, 0, At, B0); BAR; SCHED;
    STAGE(SB(1, 1), Bt, ldb, bcol + HALF, t + 3);
    WAIT_V(6); BAR; MMA(1, 1, At, B1); BAR;
  }
  { LDB(B0, 0, 0); LDA(At, 0, 0); STAGE(SA(1, 1), A, lda, brow + HALF, nt - 1);
    BAR; WAIT_L(0); MMA(0, 0, At, B0); BAR;
    LDB(B1, 0, 1); BAR; WAIT_L(0); MMA(0, 1, At, B1); BAR;
    LDA(At, 0, 1); WAIT_V(4); BAR; WAIT_L(0); MMA(1, 0, At, B0); MMA(1, 1, At, B1); BAR; }
  { LDB(B0, 1, 0); LDA(At, 1, 0); WAIT_V(2); BAR; WAIT_L(0); MMA(0, 0, At, B0); BAR;
    LDB(B1, 1, 1); WAIT_V(0); BAR; WAIT_L(0); MMA(0, 1, At, B1); BAR;
    LDA(At, 1, 1); BAR; WAIT_L(0); MMA(1, 0, At, B0); MMA(1, 1, At, B1); BAR; }
  if (wr == 0) BAR;
  int tid2 = tidx; asm volatile("" : "+v"(tid2));
  const int wid2 = tid2 >> 6, lane2 = tid2 & 63, wr2 = wid2 >> 2, wc2 = wid2 & 3, fr2 = lane2 & 15, fq2 = lane2 >> 4;
#pragma unroll
  for (int ai = 0; ai < 2; ++ai)
#pragma unroll
    for (int bj = 0; bj < 2; ++bj)
#pragma unroll
      for (int m = 0; m < 4; ++m) {
#pragma unroll
        for (int n = 0; n < 2; ++n)
          pre(n, brow + ai * HALF + wr2 * 64 + m * 16 + fr2, bcol + bj * HALF + wc2 * 32 + n * 16 + fq2 * 4);
#pragma unroll
        for (int n = 0; n < 2; ++n)
          epi(n, brow + ai * HALF + wr2 * 64 + m * 16 + fr2, bcol + bj * HALF + wc2 * 32 + n * 16 + fq2 * 4, acc[ai][bj][m][n]);
      }
  __syncthreads();
#undef SA
#undef SB
#undef STAGE
#undef LDA
#undef LDB
#undef MMA
}

static __device__ __attribute__((always_inline)) inline void phase_inproj(const Params& p) {
  char* ws = lsp(p.ws);
  u16* H = (u16*)(ws + OFF_H); u16* WinT = (u16*)(ws + OFF_WBIG); u16* PROJ = (u16*)(ws + OFF_PROJ);
  u16* HALO = (u16*)(ws + OFF_HALO);
  const int nM = 64, nN = 20;
  for (int t = blockIdx.x; t < nM * nN; t += gridDim.x) {
    int pm, pn; tile_map(t, nM, nN, pm, pn);
    gemm_tile(H, 1024, WinT, 1024, 1024, pm * 256, pn * 256, [&](int idx, int row, int col, f32x4 v) {
      if (col < NPJ) {
        s16x4 b = pack4(v[0], v[1], v[2], v[3]);
        *(s16x4*)(PROJ + (size_t)row * NPJ + col) = b;
        if (col < 1536 && (row & 63) >= 61) *(s16x4*)(HALO + ((size_t)(row >> 6) * 3 + ((row & 63) - 61)) * 1536 + col) = b;
      }
    });
  }
}

static __device__ __attribute__((always_inline)) inline void sb_attn_wave(const Params& p, int witem) {
  u16* PROJ = (u16*)(lsp(p.ws) + OFF_PROJ);
  const int tid = lv(threadIdx.x), lane = tid & 63, w = tid >> 6, lq5 = lane & 31, hf = lane >> 5;
  u16* VT = (u16*)lds_base() + w * (64 * 40);
  const int b = witem >> 8, h = (witem >> 5) & 7, qt = witem & 31;
  const int t0 = qt * 64;
  bf16x8 qf[2][4];
#pragma unroll
  for (int qi = 0; qi < 2; ++qi)
#pragma unroll
    for (int s = 0; s < 4; ++s) {
      bf16x8 raw = ld8(PROJ + ((size_t)b * SEQL + t0 + 32 * qi + lq5) * NPJ + C_SQ + h * 64 + 16 * s + 8 * hf);
#pragma unroll
      for (int e = 0; e < 8; ++e) raw[e] = (short)f2bf(bfs(raw[e]) * 0.125f);
      qf[qi][s] = raw;
    }
  f32x16 oacc[2][2];
#pragma unroll
  for (int i = 0; i < 16; ++i) { oacc[0][0][i] = 0.f; oacc[0][1][i] = 0.f; oacc[1][0][i] = 0.f; oacc[1][1][i] = 0.f; }
  float carry[2] = {1.f, 1.f};
#pragma unroll 1
  for (int k0 = t0 + 32; k0 >= 0; k0 -= 32) {
    const size_t krow = ((size_t)b * SEQL + k0 + lq5) * NPJ + C_SK + h * 64;
    {
      bf16x8 v0 = ld8(PROJ + krow + 512 + hf * 32), v1 = ld8(PROJ + krow + 512 + hf * 32 + 8);
      bf16x8 v2 = ld8(PROJ + krow + 512 + hf * 32 + 16), v3 = ld8(PROJ + krow + 512 + hf * 32 + 24);
#pragma unroll
      for (int e = 0; e < 8; ++e) {
        VT[(hf * 32 + e) * 40 + lq5] = (u16)v0[e]; VT[(hf * 32 + 8 + e) * 40 + lq5] = (u16)v1[e];
        VT[(hf * 32 + 16 + e) * 40 + lq5] = (u16)v2[e]; VT[(hf * 32 + 24 + e) * 40 + lq5] = (u16)v3[e];
      }
    }
    bf16x8 kf[4];
#pragma unroll
    for (int s = 0; s < 4; ++s) kf[s] = ld8(PROJ + krow + 16 * s + 8 * hf);
#pragma unroll
    for (int qi = 0; qi < 2; ++qi) {
      if (k0 >= t0 + 32 * qi + 31) continue;
      f32x16 st;
#pragma unroll
      for (int i = 0; i < 16; ++i) st[i] = 0.f;
#pragma unroll
      for (int s = 0; s < 4; ++s) st = mfma32(kf[s], qf[qi][s], st);
      const int t = t0 + 32 * qi + lq5;
      float m[16];
#pragma unroll
      for (int i = 0; i < 16; ++i) {
        const float z = fminf(fmaxf(st[i], -80.f), 80.f);
        const float e = __expf(z);
        const float r = __builtin_amdgcn_rcpf(1.f + e);
        const bool c = (k0 + crow(i, hf)) < t;
        m[i] = c ? r : 1.f;
        st[i] = c ? e * r : 0.f;
      }
      float T[4], P[4];
#pragma unroll
      for (int gi = 0; gi < 4; ++gi) { T[gi] = (m[4 * gi] * m[4 * gi + 1]) * (m[4 * gi + 2] * m[4 * gi + 3]); P[gi] = __shfl_xor(T[gi], 32); }
      float aft[4];
      aft[3] = (hf == 0) ? P[3] : 1.f;
      aft[2] = T[3] * P[3] * ((hf == 0) ? P[2] : 1.f);
      aft[1] = T[3] * P[3] * T[2] * P[2] * ((hf == 0) ? P[1] : 1.f);
      aft[0] = T[3] * P[3] * T[2] * P[2] * T[1] * P[1] * ((hf == 0) ? P[0] : 1.f);
      const float cin = carry[qi];
#pragma unroll
      for (int gi = 0; gi < 4; ++gi) {
        const float base = cin * aft[gi];
        const float w2 = m[4 * gi + 3], w1 = w2 * m[4 * gi + 2], w0 = w1 * m[4 * gi + 1];
        st[4 * gi + 0] *= base * w0;
        st[4 * gi + 1] *= base * w1;
        st[4 * gi + 2] *= base * w2;
        st[4 * gi + 3] *= base;
      }
      carry[qi] = cin * ((T[0] * P[0]) * (T[1] * P[1])) * ((T[2] * P[2]) * (T[3] * P[3]));
#pragma unroll
      for (int s = 0; s < 2; ++s) {
        bf16x8 pf = pack8(st, s);
#pragma unroll
        for (int dt = 0; dt < 2; ++dt) {
          const u16* vp = VT + (32 * dt + lq5) * 40 + 16 * s + 4 * hf;
          s16x4 lo = ld4(vp), hi = ld4(vp + 8);
          bf16x8 vf = __builtin_shufflevector(lo, hi, 0, 1, 2, 3, 4, 5, 6, 7);
          oacc[qi][dt] = mfma32(vf, pf, oacc[qi][dt]);
        }
      }
    }
    if (k0 <= t0 && __all(carry[0] < 1.2e-38f && carry[1] < 1.2e-38f)) break;
  }
#pragma unroll
  for (int qi = 0; qi < 2; ++qi)
#pragma unroll
    for (int dt = 0; dt < 2; ++dt)
#pragma unroll
      for (int g4 = 0; g4 < 4; ++g4)
        *(s16x4*)(PROJ + ((size_t)b * SEQL + t0 + 32 * qi + lq5) * NPJ + C_SQ + h * 64 + 32 * dt + 8 * g4 + 4 * hf) =
            pack4(oacc[qi][dt][4 * g4], oacc[qi][dt][4 * g4 + 1], oacc[qi][dt][4 * g4 + 2], oacc[qi][dt][4 * g4 + 3]);
}

static __device__ __attribute__((always_inline)) inline void nsa_compress(const Params& p, int l, int item) {
  char* ws = lsp(p.ws);
  const u16* PROJ = (const u16*)(ws + OFF_PROJ);
  u16* KC = (u16*)(ws + OFF_KC); u16* VCT = (u16*)(ws + OFF_VCT);
  const u16* WT = (const u16*)(ws + OFF_WT); const float* CB = (const float*)(ws + OFF_CB);
  float* red = (float*)lds_base();
  const int tid = lv(threadIdx.x), lane = tid & 63, w = tid >> 6, lq5 = lane & 31, hf = lane >> 5;
  const int nt4 = item & 3, kv = (item >> 2) & 1, g = (item >> 3) & 1, b = item >> 4;
  const int n = 32 * nt4 + lq5;
  f32x16 acc[2];
#pragma unroll
  for (int i = 0; i < 16; ++i) { acc[0][i] = 0.f; acc[1][i] = 0.f; }
#pragma unroll 4
  for (int ks = 0; ks < 16; ++ks) {
    const int ll = 4 * w + (ks >> 2), d0 = (ks & 3) * 16 + 8 * hf;
    bf16x8 a;
#pragma unroll
    for (int e = 0; e < 8; ++e) a[e] = 0;
    if (n < 127) a = ld8(PROJ + ((size_t)b * SEQL + 16 * n + ll) * NPJ + C_NKV + kv * 128 + g * 64 + d0);
#pragma unroll
    for (int et = 0; et < 2; ++et)
      acc[et] = mfma32(a, ld8(WT + ((size_t)(kv * 64 + 32 * et + lq5)) * 2048 + ll * 64 + d0), acc[et]);
  }
#pragma unroll
  for (int et = 0; et < 2; ++et)
#pragma unroll
    for (int i = 0; i < 16; ++i) red[(w * 32 + crow(i, hf)) * 64 + 32 * et + lq5] = acc[et][i];
  __syncthreads();
  {
    const int nl = tid >> 4, e0 = (tid & 15) * 4;
    float v[4];
#pragma unroll
    for (int q = 0; q < 4; ++q) v[q] = CB[kv * 64 + e0 + q];
#pragma unroll
    for (int ww = 0; ww < 8; ++ww)
#pragma unroll
      for (int q = 0; q < 4; ++q) v[q] += red[(ww * 32 + nl) * 64 + e0 + q];
    const int nn = 32 * nt4 + nl;
    if (nn >= 127) { v[0] = 0.f; v[1] = 0.f; v[2] = 0.f; v[3] = 0.f; }
    if (kv == 0) *(s16x4*)(KC + ((size_t)(b * 2 + g) * 128 + nn) * 64 + e0) = pack4(v[0], v[1], v[2], v[3]);
    else {
#pragma unroll
      for (int q = 0; q < 4; ++q) VCT[((size_t)(b * 2 + g) * 64 + e0 + q) * 128 + nn] = f2bf(v[q]);
    }
  }
  __syncthreads();
}

static __device__ __attribute__((always_inline)) inline void gdn_prep(const Params& p, int l, int item) {
  char* ws = lsp(p.ws);
  u16* PROJ = (u16*)(ws + OFF_PROJ); u16* HALO = (u16*)(ws + OFF_HALO);
  u16* WG = (u16*)(ws + OFF_SCR); u16* ATT = (u16*)(ws + OFF_SCR + 16777216);
  float* EGL = (float*)(ws + OFF_EGL);
  u16* Qb = (u16*)lds_base();
  u16* Kb = Qb + 64 * 136;
  u16* vbT = Kb + 64 * 136;
  u16* kbT = vbT + 128 * 72;
  float* As = (float*)(kbT + 128 * 72);
  u16* Tb = (u16*)(As + 64 * 65);
  float* sg = (float*)(Tb + 64 * 72);
  float* sbeta = sg + 64; float* sgc = sbeta + 64;
  const int tid = lv(threadIdx.x), lane = tid & 63, w = tid >> 6, lr = lane & 15, lq = lane >> 4;
  const int c = item & 31, h = (item >> 5) & 3, b = item >> 7;
  const int t0 = b * SEQL + c * 64;
  const int i = tid & 63, cgp = tid >> 6;
  const float* cw = p.conv_w + (size_t)l * 4 * 1536;
  if (tid < 64) {
    float a = bf2f(PROJ[(size_t)(t0 + tid) * NPJ + C_GA + h]);
    float bt = bf2f(PROJ[(size_t)(t0 + tid) * NPJ + C_GB + h]);
    sg[tid] = -__expf(p.a_log[l * 4 + h]) * softplusf_(a + p.dt_bias[l * 4 + h]);
    sbeta[tid] = sigmoidf_(bt);
  }
  float qkv[3][16];
  {
    bf16x8 xr[3][4][2];
#pragma unroll
    for (int sec = 0; sec < 3; ++sec)
#pragma unroll
      for (int j = 0; j < 4; ++j) {
        const int colb = sec * 512 + h * 128 + cgp * 16;
        const int ii = i - 3 + j;
        const u16* src = (ii >= 0) ? PROJ + (size_t)(t0 + ii) * NPJ + colb
                                   : HALO + ((size_t)(max(t0 >> 6, 1) - 1) * 3 + (3 + ii)) * 1536 + colb;
        xr[sec][j][0] = ld8(src); xr[sec][j][1] = ld8(src + 8);
      }
#pragma unroll
    for (int sec = 0; sec < 3; ++sec) {
      const int colb = sec * 512 + h * 128 + cgp * 16;
#pragma unroll
      for (int e = 0; e < 16; ++e) qkv[sec][e] = 0.f;
#pragma unroll
      for (int j = 0; j < 4; ++j) {
        const int ii = i - 3 + j;
        const float keep = (ii >= 0 || c > 0) ? 1.f : 0.f;
#pragma unroll
        for (int e = 0; e < 8; ++e) {
          qkv[sec][e] += (keep * cw[j * 1536 + colb + e]) * bfs(xr[sec][j][0][e]);
          qkv[sec][8 + e] += (keep * cw[j * 1536 + colb + 8 + e]) * bfs(xr[sec][j][1][e]);
        }
      }
#pragma unroll
      for (int e = 0; e < 16; ++e) { float x = qkv[sec][e]; qkv[sec][e] = x * __builtin_amdgcn_rcpf(1.f + __expf(-x)); }
    }
  }
  {
    float sq = 0.f, sk = 0.f;
#pragma unroll
    for (int e = 0; e < 16; ++e) { sq += qkv[0][e] * qkv[0][e]; sk += qkv[1][e] * qkv[1][e]; }
    float* rdn = As;
    rdn[(0 * 8 + cgp) * 64 + i] = sq; rdn[(1 * 8 + cgp) * 64 + i] = sk;
    __syncthreads();
    sq = 0.f; sk = 0.f;
#pragma unroll
    for (int cc = 0; cc < 8; ++cc) { sq += rdn[(0 * 8 + cc) * 64 + i]; sk += rdn[(1 * 8 + cc) * 64 + i]; }
    float rq = rsqrtf(sq + 1e-6f) * 0.08838834764831845f, rk = rsqrtf(sk + 1e-6f);
#pragma unroll
    for (int e = 0; e < 16; ++e) { qkv[0][e] *= rq; qkv[1][e] *= rk; }
  }
  if (tid < 64) {
    float sc_ = sg[tid];
#pragma unroll
    for (int o = 1; o < 64; o <<= 1) { float t = __shfl_up(sc_, o); if (lane >= o) sc_ += t; }
    sgc[tid] = sc_;
    if (tid == 63) EGL[item] = __expf(sc_);
  }
  __syncthreads();
  {
    const float gci = sgc[i], gl = sgc[63], bi = sbeta[i];
    const float eg = __expf(gci), ekd = __expf(gl - gci);
    bf16x8 a0, a1, b0, b1, c0, c1, d0, d1;
#pragma unroll
    for (int e = 0; e < 8; ++e) {
      a0[e] = (short)f2bf(qkv[0][e]); a1[e] = (short)f2bf(qkv[0][8 + e]);
      b0[e] = (short)f2bf(qkv[1][e]); b1[e] = (short)f2bf(qkv[1][8 + e]);
      c0[e] = (short)f2bf(qkv[0][e] * eg); c1[e] = (short)f2bf(qkv[0][8 + e] * eg);
      d0[e] = (short)f2bf(qkv[1][e] * ekd); d1[e] = (short)f2bf(qkv[1][8 + e] * ekd);
    }
    *(bf16x8*)(Qb + i * 136 + cgp * 16) = a0; *(bf16x8*)(Qb + i * 136 + cgp * 16 + 8) = a1;
    *(bf16x8*)(Kb + i * 136 + cgp * 16) = b0; *(bf16x8*)(Kb + i * 136 + cgp * 16 + 8) = b1;
    u16* gq = PROJ + (size_t)(t0 + i) * NPJ + C_GQ + h * 128 + cgp * 16;
    u16* gk = PROJ + (size_t)(t0 + i) * NPJ + C_GK + h * 128 + cgp * 16;
    *(bf16x8*)gq = c0; *(bf16x8*)(gq + 8) = c1;
    *(bf16x8*)gk = d0; *(bf16x8*)(gk + 8) = d1;
#pragma unroll
    for (int e = 0; e < 16; ++e) {
      vbT[(cgp * 16 + e) * 72 + i] = f2bf(qkv[2][e] * bi);
      kbT[(cgp * 16 + e) * 72 + i] = f2bf(qkv[1][e] * bi * eg);
    }
  }
  __syncthreads();
#pragma unroll 1
  for (int jj = 0; jj < 2; ++jj) {
    const int tile = w * 2 + jj, ti = tile >> 2, tj = tile & 3;
    f32x4 acc = {0.f, 0.f, 0.f, 0.f};
    if (tj <= ti) {
#pragma unroll
      for (int ks = 0; ks < 4; ++ks)
        acc = mfma16(ld8(Kb + (ti * 16 + lr) * 136 + ks * 32 + lq * 8), ld8(Kb + (tj * 16 + lr) * 136 + ks * 32 + lq * 8), acc);
    }
    const int j = tj * 16 + lr;
#pragma unroll
    for (int r = 0; r < 4; ++r) {
      const int ir = ti * 16 + lq * 4 + r;
      As[ir * 65 + j] = (j < ir) ? sbeta[ir] * acc[r] * __expf(sgc[ir] - sgc[j]) : 0.f;
    }
  }
  __syncthreads();
  if (w != 0) {
#pragma unroll 1
    for (int tile = w - 1; tile < 16; tile += 7) {
      const int ti = tile >> 2, tj = tile & 3;
      f32x4 acc = {0.f, 0.f, 0.f, 0.f};
      if (tj <= ti) {
#pragma unroll
        for (int ks = 0; ks < 4; ++ks)
          acc = mfma16(ld8(Qb + (ti * 16 + lr) * 136 + ks * 32 + lq * 8), ld8(Kb + (tj * 16 + lr) * 136 + ks * 32 + lq * 8), acc);
      }
      const int j = tj * 16 + lr;
#pragma unroll
      for (int r = 0; r < 4; ++r) {
        const int ir = ti * 16 + lq * 4 + r;
        const float dec = (j <= ir) ? __expf(sgc[ir] - sgc[j]) : 0.f;
        ATT[(size_t)item * 4096 + ir * 64 + j] = f2bf(acc[r] * dec);
      }
    }
  }
  if (w == 0) {
    float Ar[64], Tc[64];
#pragma unroll
    for (int ir = 0; ir < 64; ++ir) Ar[ir] = As[ir * 65 + lane];
#pragma unroll
    for (int ir = 0; ir < 64; ++ir) {
      float sacc = (ir == lane) ? 1.f : 0.f;
#pragma unroll
      for (int j = 0; j < ir; ++j) sacc -= __uint_as_float(__builtin_amdgcn_readlane(__float_as_uint(Ar[ir]), j)) * Tc[j];
      Tc[ir] = sacc;
    }
#pragma unroll
    for (int ir = 0; ir < 64; ++ir) Tb[ir * 72 + lane] = f2bf(Tc[ir]);
  }
  __syncthreads();
#pragma unroll 1
  for (int jj = 0; jj < 8; ++jj) {
    const int job = w * 8 + jj, which = job >> 5, tile = job & 31, ti = tile >> 3, tn = tile & 7;
    const u16* BT = which ? kbT : vbT;
    f32x4 acc = {0.f, 0.f, 0.f, 0.f};
#pragma unroll
    for (int ks = 0; ks < 2; ++ks)
      acc = mfma16(ld8(Tb + (ti * 16 + lr) * 72 + ks * 32 + lq * 8), ld8(BT + (tn * 16 + lr) * 72 + ks * 32 + lq * 8), acc);
    const int d = tn * 16 + lr;
#pragma unroll
    for (int r = 0; r < 4; ++r) {
      const int ir = ti * 16 + lq * 4 + r;
      if (which == 0) PROJ[(size_t)(t0 + ir) * NPJ + C_GV + h * 128 + d] = f2bf(acc[r]);
      else WG[(size_t)(t0 + ir) * 512 + h * 128 + d] = f2bf(acc[r]);
    }
  }
  __syncthreads();
}

static __device__ __attribute__((always_inline)) inline void gdn_scan(const Params& p, int l, int bh) {
  char* ws = lsp(p.ws);
  u16* PROJ = (u16*)(ws + OFF_PROJ);
  const u16* WG = (const u16*)(ws + OFF_SCR); const u16* ATT = (const u16*)(ws + OFF_SCR + 16777216);
  const float* EGL = (const float*)(ws + OFF_EGL);
  u16* St = (u16*)lds_base();
  u16* Wl = St + 128 * 136;
  u16* Ql = Wl + 64 * 136;
  u16* KdT = Ql + 64 * 136;
  u16* VnT = KdT + 128 * 72;
  u16* At = VnT + 128 * 72;
  float* red = (float*)(At + 64 * 72);
  float* egls = red + 128;
  const int tid = lv(threadIdx.x), lane = tid & 63, w = tid >> 6, lr = lane & 15, lq = lane >> 4;
  const int b = bh >> 2, h = bh & 3;
  const float* ng = p.norm_g + l * 128;
  f32x4 S[8];
#pragma unroll
  for (int v = 0; v < 8; ++v) S[v] = f32x4{0.f, 0.f, 0.f, 0.f};
  for (int idx = tid; idx < 128 * 136; idx += 512) St[idx] = 0;
  const int it = w >> 1, vb = (w & 1) * 4;
  float ngv[4];
#pragma unroll
  for (int n = 0; n < 4; ++n) ngv[n] = ng[(vb + n) * 16 + lr];
  const int r0 = tid >> 4, seg0 = tid & 15;
  const int ra = tid >> 3, sega = tid & 7;
  bf16x8 pw[2], pq[2], pk[2], pa;
  u16 un[16];
  {
    const int t0 = b * SEQL;
#pragma unroll
    for (int rep = 0; rep < 2; ++rep) {
      const int r = r0 + rep * 32;
      pw[rep] = ld8(WG + (size_t)(t0 + r) * 512 + h * 128 + seg0 * 8);
      pq[rep] = ld8(PROJ + (size_t)(t0 + r) * NPJ + C_GQ + h * 128 + seg0 * 8);
      pk[rep] = ld8(PROJ + (size_t)(t0 + r) * NPJ + C_GK + h * 128 + seg0 * 8);
    }
    pa = ld8(ATT + (size_t)(bh * 32) * 4096 + ra * 64 + sega * 8);
#pragma unroll
    for (int n = 0; n < 4; ++n)
#pragma unroll
      for (int r = 0; r < 4; ++r)
        un[n * 4 + r] = PROJ[(size_t)(t0 + it * 16 + lq * 4 + r) * NPJ + C_GV + h * 128 + (vb + n) * 16 + lr];
    if (tid < 32) egls[tid] = EGL[bh * 32 + tid];
  }
#pragma unroll 1
  for (int c = 0; c < 32; ++c) {
    const int t0 = b * SEQL + c * 64;
#pragma unroll
    for (int rep = 0; rep < 2; ++rep) {
      const int r = r0 + rep * 32;
      *(bf16x8*)(Wl + r * 136 + seg0 * 8) = pw[rep];
      *(bf16x8*)(Ql + r * 136 + seg0 * 8) = pq[rep];
#pragma unroll
      for (int e = 0; e < 8; ++e) KdT[(seg0 * 8 + e) * 72 + r] = (u16)pk[rep][e];
    }
    *(bf16x8*)(At + ra * 72 + sega * 8) = pa;
    u16 uc[16], zc[16];
#pragma unroll
    for (int q = 0; q < 16; ++q) uc[q] = un[q];
#pragma unroll
    for (int n = 0; n < 4; ++n)
#pragma unroll
      for (int r = 0; r < 4; ++r)
        zc[n * 4 + r] = PROJ[(size_t)(t0 + it * 16 + lq * 4 + r) * NPJ + C_GZ + h * 128 + (vb + n) * 16 + lr];
    lds_barrier();
    if (c + 1 < 32) {
      const int t1 = t0 + 64;
#pragma unroll
      for (int rep = 0; rep < 2; ++rep) {
        const int r = r0 + rep * 32;
        pw[rep] = ld8(WG + (size_t)(t1 + r) * 512 + h * 128 + seg0 * 8);
        pq[rep] = ld8(PROJ + (size_t)(t1 + r) * NPJ + C_GQ + h * 128 + seg0 * 8);
        pk[rep] = ld8(PROJ + (size_t)(t1 + r) * NPJ + C_GK + h * 128 + seg0 * 8);
      }
      pa = ld8(ATT + (size_t)(bh * 32 + c + 1) * 4096 + ra * 64 + sega * 8);
#pragma unroll
      for (int n = 0; n < 4; ++n)
#pragma unroll
        for (int r = 0; r < 4; ++r)
          un[n * 4 + r] = PROJ[(size_t)(t1 + it * 16 + lq * 4 + r) * NPJ + C_GV + h * 128 + (vb + n) * 16 + lr];
    }
    f32x4 vacc[4], oacc[4];
#pragma unroll
    for (int n = 0; n < 4; ++n) { vacc[n] = f32x4{0.f, 0.f, 0.f, 0.f}; oacc[n] = f32x4{0.f, 0.f, 0.f, 0.f}; }
#pragma unroll
    for (int ks = 0; ks < 4; ++ks) {
      bf16x8 aw = ld8(Wl + (it * 16 + lr) * 136 + ks * 32 + lq * 8);
      bf16x8 aq = ld8(Ql + (it * 16 + lr) * 136 + ks * 32 + lq * 8);
#pragma unroll
      for (int n = 0; n < 4; ++n) {
        bf16x8 bs = ld8(St + ((vb + n) * 16 + lr) * 136 + ks * 32 + lq * 8);
        vacc[n] = mfma16(aw, bs, vacc[n]);
        oacc[n] = mfma16(aq, bs, oacc[n]);
      }
    }
#pragma unroll
    for (int n = 0; n < 4; ++n) {
      const int v = (vb + n) * 16 + lr;
      *(s16x4*)(VnT + v * 72 + it * 16 + lq * 4) =
          pack4(bf2f(uc[n * 4 + 0]) - vacc[n][0], bf2f(uc[n * 4 + 1]) - vacc[n][1], bf2f(uc[n * 4 + 2]) - vacc[n][2], bf2f(uc[n * 4 + 3]) - vacc[n][3]);
    }
    lds_barrier();
#pragma unroll
    for (int ks = 0; ks < 2; ++ks) {
      bf16x8 aa = ld8(At + (it * 16 + lr) * 72 + ks * 32 + lq * 8);
#pragma unroll
      for (int n = 0; n < 4; ++n)
        oacc[n] = mfma16(aa, ld8(VnT + ((vb + n) * 16 + lr) * 72 + ks * 32 + lq * 8), oacc[n]);
    }
    {
      bf16x8 ak0 = ld8(KdT + (w * 16 + lr) * 72 + lq * 8), ak1 = ld8(KdT + (w * 16 + lr) * 72 + 32 + lq * 8);
#pragma unroll
      for (int vt = 0; vt < 8; ++vt) {
        f32x4 a = S[vt] * egls[c];
        a = mfma16(ak0, ld8(VnT + (vt * 16 + lr) * 72 + lq * 8), a);
        a = mfma16(ak1, ld8(VnT + (vt * 16 + lr) * 72 + 32 + lq * 8), a);
        S[vt] = a;
        *(s16x4*)(St + (vt * 16 + lr) * 136 + w * 16 + lq * 4) = pack4(a[0], a[1], a[2], a[3]);
      }
    }
    {
      float ssr[4];
#pragma unroll
      for (int r = 0; r < 4; ++r) {
        float sq = 0.f;
#pragma unroll
        for (int n = 0; n < 4; ++n) sq += oacc[n][r] * oacc[n][r];
        sq += __shfl_xor(sq, 1); sq += __shfl_xor(sq, 2); sq += __shfl_xor(sq, 4); sq += __shfl_xor(sq, 8);
        ssr[r] = sq;
      }
      if (lr == 0) {
#pragma unroll
        for (int r = 0; r < 4; ++r) red[(it * 16 + lq * 4 + r) * 2 + (w & 1)] = ssr[r];
      }
    }
    lds_barrier();
#pragma unroll
    for (int r = 0; r < 4; ++r) {
      const int ir = it * 16 + lq * 4 + r;
      const float rs = rsqrtf((red[ir * 2] + red[ir * 2 + 1]) * (1.f / 128.f) + 1e-6f);
#pragma unroll
      for (int n = 0; n < 4; ++n) {
        const int v = (vb + n) * 16 + lr;
        const float z = bf2f(zc[n * 4 + r]);
        const float y = oacc[n][r] * rs * ngv[n] * z * __builtin_amdgcn_rcpf(1.f + __expf(-z));
        PROJ[(size_t)(t0 + ir) * NPJ + C_GV + h * 128 + v] = f2bf(y);
      }
    }
  }
  __syncthreads();
}


static __device__ __attribute__((always_inline)) inline void nsa_attn(const Params& p, int item) {
  char* ws = lsp(p.ws);
  u16* PROJ = (u16*)(ws + OFF_PROJ);
  const u16* KC = (const u16*)(ws + OFF_KC); const u16* VCT = (const u16*)(ws + OFF_VCT);
  u16* Ks = (u16*)lds_base();
  float* impw = (float*)(Ks + 4 * 64 * 72);
  unsigned* selm = (unsigned*)(impw + 4 * 64 * 32);
  unsigned* uni = selm + 64;
  const int tid = lv(threadIdx.x), lane = tid & 63, w = tid >> 6;
  const int hh = w & 3, qhalf = w >> 2, lq5 = lane & 31, hf = lane >> 5;
  const int qb = 31 - (item >> 4), bg = item & 15, b = bg >> 1, g = bg & 1;
  const int ql = qhalf * 32 + lq5, tpos = qb * 64 + ql;
  const size_t row = (size_t)b * SEQL + tpos;
  const int head = g * 4 + hh;
  bf16x8 qf[4];
#pragma unroll
  for (int s = 0; s < 4; ++s) {
    bf16x8 raw = ld8(PROJ + row * NPJ + C_NQ + head * 64 + 16 * s + 8 * hf);
#pragma unroll
    for (int e = 0; e < 8; ++e) raw[e] = (short)f2bf(bfs(raw[e]) * 0.125f);
    qf[s] = raw;
  }
  if (tid == 0) *uni = 0u;
  float gate[3];
#pragma unroll
  for (int i = 0; i < 3; ++i) gate[i] = sigmoidf_(bf2f(PROJ[row * NPJ + C_NG + head * 3 + i]));
  f32x16 ofin[2];
  {
    f32x16 sc[4];
    const u16* kcb = KC + (size_t)(b * 2 + g) * 128 * 64;
#pragma unroll
    for (int mt = 0; mt < 4; ++mt) {
#pragma unroll
      for (int i = 0; i < 16; ++i) sc[mt][i] = 0.f;
#pragma unroll
      for (int s = 0; s < 4; ++s) sc[mt] = mfma32(ld8(kcb + (32 * mt + lq5) * 64 + 16 * s + 8 * hf), qf[s], sc[mt]);
    }
    const int nlim = (tpos >= 31) ? min(126, (tpos - 31) >> 4) : -1;
    float mx = -1e30f;
#pragma unroll
    for (int mt = 0; mt < 4; ++mt)
#pragma unroll
      for (int i = 0; i < 16; ++i) { int n = 32 * mt + crow(i, hf); if (n <= nlim) mx = fmaxf(mx, sc[mt][i]); }
    mx = fmaxf(mx, __shfl_xor(mx, 32));
    float ls = 0.f;
#pragma unroll
    for (int mt = 0; mt < 4; ++mt)
#pragma unroll
      for (int i = 0; i < 16; ++i) {
        int n = 32 * mt + crow(i, hf);
        float pv = (n <= nlim) ? __expf(sc[mt][i] - mx) : 0.f;
        sc[mt][i] = pv; ls += pv;
      }
    ls += __shfl_xor(ls, 32);
    const float inv = ls > 0.f ? 1.f / ls : 0.f;
#pragma unroll
    for (int mt = 0; mt < 4; ++mt)
#pragma unroll
      for (int i = 0; i < 16; ++i) sc[mt][i] *= inv;
    f32x16 oc[2];
#pragma unroll
    for (int i = 0; i < 16; ++i) { oc[0][i] = 0.f; oc[1][i] = 0.f; }
    const u16* vcb = VCT + (size_t)(b * 2 + g) * 64 * 128;
#pragma unroll
    for (int mt = 0; mt < 4; ++mt)
#pragma unroll
      for (int s = 0; s < 2; ++s) {
        bf16x8 pf = pack8(sc[mt], s);
#pragma unroll
        for (int dt = 0; dt < 2; ++dt) {
          const u16* vp = vcb + (32 * dt + lq5) * 128 + 32 * mt + 16 * s + 4 * hf;
          s16x4 lo = ld4(vp), hi = ld4(vp + 8);
          bf16x8 vf = __builtin_shufflevector(lo, hi, 0, 1, 2, 3, 4, 5, 6, 7);
          oc[dt] = mfma32(vf, pf, oc[dt]);
        }
      }
#pragma unroll
    for (int i = 0; i < 16; ++i) { ofin[0][i] = gate[0] * oc[0][i]; ofin[1][i] = gate[0] * oc[1][i]; }
    float G[4][4], rl[4][4];
#pragma unroll
    for (int mt = 0; mt < 4; ++mt)
#pragma unroll
      for (int gi = 0; gi < 4; ++gi) {
        G[mt][gi] = sc[mt][4 * gi] + sc[mt][4 * gi + 1] + sc[mt][4 * gi + 2] + sc[mt][4 * gi + 3];
        rl[mt][gi] = __shfl_xor(sc[mt][4 * gi + 3], 32);
      }
#pragma unroll
    for (int mt = 0; mt < 4; ++mt)
#pragma unroll
      for (int gi = 0; gi < 4; ++gi) {
        float prev;
        if (hf == 1) prev = rl[mt][gi];
        else prev = (gi > 0) ? rl[mt][gi > 0 ? gi - 1 : 0] : (mt > 0 ? rl[mt > 0 ? mt - 1 : 0][3] : 0.f);
        impw[(hh * 64 + ql) * 32 + 8 * mt + 2 * gi + hf] = G[mt][gi] + prev;
      }
  }
  __syncthreads();
  if (tid < 64) {
    float scv[32];
#pragma unroll
    for (int j = 0; j < 32; ++j) {
      float v = impw[(0 * 64 + tid) * 32 + j] + impw[(1 * 64 + tid) * 32 + j] + impw[(2 * 64 + tid) * 32 + j] + impw[(3 * 64 + tid) * 32 + j];
      if (j == 0 || j == qb || j == qb - 1) v += 1000.f;
      scv[j] = (j <= qb) ? v : -1e30f;
    }
    unsigned m = 0u;
#pragma unroll 1
    for (int k = 0; k < 8; ++k) {
      float bv = -1e29f; int best = -1;
#pragma unroll
      for (int j = 0; j < 32; ++j) { bool take = !((m >> j) & 1u) && scv[j] > bv; bv = take ? scv[j] : bv; best = take ? j : best; }
      if (best >= 0) m |= 1u << best;
    }
    selm[tid] = m;
    atomicOr(uni, m);
  }
  __syncthreads();
  const unsigned U = *uni;
  const unsigned sm = selm[ql];
#pragma unroll 1
  for (int mode = 0; mode < 2; ++mode) {
    float mrun = -1e30f, lrun = 0.f;
    f32x16 oacc[2];
#pragma unroll
    for (int i = 0; i < 16; ++i) { oacc[0][i] = 0.f; oacc[1][i] = 0.f; }
    const unsigned tmask = mode ? ((2u << qb) - 1u) & ~((1u << max(0, qb - 8)) - 1u) : U;
    const int r_ld = 32 * (w & 1) + (lane & 31), seg_ld = (w >> 1) * 2 + (lane >> 5);
    const int kcol = C_NKV + (mode ? 4 : 2) * 128 + g * 64 + seg_ld * 8;
    unsigned rem = tmask;
    int j = __ffs(rem) - 1;
    rem &= rem - 1u;
    bf16x8 kreg = ld8(PROJ + ((size_t)b * SEQL + 64 * j + r_ld) * NPJ + kcol);
    bf16x8 vreg = ld8(PROJ + ((size_t)b * SEQL + 64 * j + r_ld) * NPJ + kcol + 128);
    int buf = 0;
#pragma unroll 1
    while (j >= 0) {
      u16* Kb_ = Ks + buf * (2 * 64 * 72);
      u16* Vb_ = Kb_ + 64 * 72;
      *(bf16x8*)(Kb_ + r_ld * 72 + seg_ld * 8) = kreg;
#pragma unroll
      for (int e = 0; e < 8; ++e) Vb_[(seg_ld * 8 + e) * 72 + r_ld] = (u16)vreg[e];
      __syncthreads();
      const int jn = rem ? (__ffs(rem) - 1) : -1;
      rem &= rem - 1u;
      if (jn >= 0) {
        kreg = ld8(PROJ + ((size_t)b * SEQL + 64 * jn + r_ld) * NPJ + kcol);
        vreg = ld8(PROJ + ((size_t)b * SEQL + 64 * jn + r_ld) * NPJ + kcol + 128);
      }
      const bool selj = mode ? true : (((sm >> j) & 1u) != 0u);
      if (mode || __any(selj)) {
        f32x16 st[2];
#pragma unroll
        for (int mt = 0; mt < 2; ++mt) {
#pragma unroll
          for (int i = 0; i < 16; ++i) st[mt][i] = 0.f;
#pragma unroll
          for (int s = 0; s < 4; ++s) st[mt] = mfma32(ld8(Kb_ + (32 * mt + lq5) * 72 + 16 * s + 8 * hf), qf[s], st[mt]);
        }
        const bool need_mask = (j == qb) || (mode && j == qb - 8);
        float mloc = -1e30f;
        if (need_mask) {
#pragma unroll
          for (int mt = 0; mt < 2; ++mt)
#pragma unroll
            for (int i = 0; i < 16; ++i) {
              const int dist = tpos - (64 * j + 32 * mt + crow(i, hf));
              const bool ok = selj && dist >= 0 && dist < 512;
              st[mt][i] = ok ? st[mt][i] : -1e30f;
              mloc = fmaxf(mloc, st[mt][i]);
            }
        } else {
#pragma unroll
          for (int mt = 0; mt < 2; ++mt)
#pragma unroll
            for (int i = 0; i < 16; ++i) mloc = fmaxf(mloc, st[mt][i]);
          mloc = selj ? mloc : -1e30f;
        }
        mloc = fmaxf(mloc, __shfl_xor(mloc, 32));
        const float mnew = fmaxf(mrun, mloc);
        const float alpha = __expf(mrun - mnew);
        const bool live = selj && (mnew > -1e29f);
        float psum = 0.f;
#pragma unroll
        for (int mt = 0; mt < 2; ++mt)
#pragma unroll
          for (int i = 0; i < 16; ++i) {
            float pv = __expf(st[mt][i] - mnew);
            pv = live ? pv : 0.f;
            st[mt][i] = pv; psum += pv;
          }
        lrun = lrun * alpha + psum;
        mrun = mnew;
#pragma unroll
        for (int i = 0; i < 16; ++i) { oacc[0][i] *= alpha; oacc[1][i] *= alpha; }
#pragma unroll
        for (int mt = 0; mt < 2; ++mt)
#pragma unroll
          for (int s = 0; s < 2; ++s) {
            bf16x8 pf = pack8(st[mt], s);
#pragma unroll
            for (int dt = 0; dt < 2; ++dt) {
              const u16* vp = Vb_ + (32 * dt + lq5) * 72 + 32 * mt + 16 * s + 4 * hf;
              s16x4 lo = ld4(vp), hi = ld4(vp + 8);
              bf16x8 vf = __builtin_shufflevector(lo, hi, 0, 1, 2, 3, 4, 5, 6, 7);
              oacc[dt] = mfma32(vf, pf, oacc[dt]);
            }
          }
      }
      buf ^= 1;
      j = jn;
    }
    const float ltot = lrun + __shfl_xor(lrun, 32);
    const float sc_ = (ltot > 0.f) ? gate[1 + mode] / ltot : 0.f;
#pragma unroll
    for (int i = 0; i < 16; ++i) { ofin[0][i] += sc_ * oacc[0][i]; ofin[1][i] += sc_ * oacc[1][i]; }
    __syncthreads();
  }
#pragma unroll
  for (int dt = 0; dt < 2; ++dt)
#pragma unroll
    for (int g4 = 0; g4 < 4; ++g4)
      *(s16x4*)(PROJ + row * NPJ + C_NQ + head * 64 + 32 * dt + 8 * g4 + 4 * hf) =
          pack4(ofin[dt][4 * g4], ofin[dt][4 * g4 + 1], ofin[dt][4 * g4 + 2], ofin[dt][4 * g4 + 3]);
  __syncthreads();
}

static __device__ __attribute__((always_inline)) inline void phase_merge(const Params& p) {
  char* ws = lsp(p.ws);
  u16* H = (u16*)(ws + OFF_H); u16* WinT = (u16*)(ws + OFF_WBIG); u16* PROJ = (u16*)(ws + OFF_PROJ);
  u16* WbrT = (u16*)(ws + OFF_WBR); u16* M = (u16*)(ws + OFF_SCR);
  const int nM = 64, nN = 4;
  for (int t = blockIdx.x; t < nM * nN; t += gridDim.x) {
    int pm, pn; tile_map(t, nM, nN, pm, pn);
#pragma unroll 1
    for (int i = 0; i < 3; ++i) {
      const int boff = 5120 + i * 1024 + pn * 256;
      gemm_tile(H, 1024, WinT, 1024, 1024, pm * 256, boff, [&](int idx, int row, int col, f32x4 v) {
        *(s16x4*)(PROJ + (size_t)row * NPJ + C_SK + (col - 5120 - i * 1024)) = pack4(sigmoidf_(v[0]), sigmoidf_(v[1]), sigmoidf_(v[2]), sigmoidf_(v[3]));
      });
      const int ycol = (i == 0) ? C_GV : (i == 1 ? C_NQ : C_SQ);
      s16x4 gbuf[2], mbuf[2];
      gemm_tile(PROJ + ycol, NPJ, WbrT + (size_t)i * 1024 * 512, 512, 512, pm * 256, pn * 256, [&](int idx, int row, int col, f32x4 v) {
        const s16x4 gte = gbuf[idx];
        float o0 = bfs(gte[0]) * v[0], o1 = bfs(gte[1]) * v[1], o2 = bfs(gte[2]) * v[2], o3 = bfs(gte[3]) * v[3];
        if (i > 0) { const s16x4 pv = mbuf[idx]; o0 += bfs(pv[0]); o1 += bfs(pv[1]); o2 += bfs(pv[2]); o3 += bfs(pv[3]); }
        *(s16x4*)(M + (unsigned)(row * 1024 + col)) = pack4(o0, o1, o2, o3);
      }, [&](int idx, int row, int col) {
        gbuf[idx] = ld4(PROJ + (unsigned)(row * NPJ + C_SK + col));
        if (i > 0) mbuf[idx] = ld4(M + (unsigned)(row * 1024 + col));
      });
    }
  }
}

template <int MODE>
static __device__ __attribute__((always_inline)) inline void phase_gemm(const u16* A, int lda, const u16* Bt, int ldb, int K, int nM, int nN, u16* C, int ldc) {
  for (int t = blockIdx.x; t < nM * nN; t += gridDim.x) {
    int pm, pn; tile_map(t, nM, nN, pm, pn);
    gemm_tile(A, lda, Bt, ldb, K, pm * 256, pn * 256, [&](int idx, int row, int col, f32x4 v) {
      if (MODE == 1) {
#pragma unroll
        for (int q = 0; q < 4; ++q) { float t = fmaxf(v[q], 0.f); v[q] = t * t; }
      }
      *(s16x4*)(C + (size_t)row * ldc + col) = pack4(v[0], v[1], v[2], v[3]);
    });
  }
}


#define XB_TMO      128
#define XB_XCNT(j)  (256  + 64 * (j))
#define XB_XSUB(j)  (1280 + 64 * (j))
#define XB_XGEN(j)  (2304 + 64 * (j))
#define XB_TOP      3328
#define XB_TOPGEN   3392
#define XCD_BAR_WORDS 3456
#define XB_SPIN_CAP (1u << 18)
#define LAS __attribute__((address_space(3)))
DI unsigned xb_ld(unsigned* q)              { return __hip_atomic_load(q, __ATOMIC_RELAXED, __HIP_MEMORY_SCOPE_AGENT); }
DI unsigned xb_add(unsigned* q, unsigned v) { return __hip_atomic_fetch_add(q, v, __ATOMIC_RELAXED, __HIP_MEMORY_SCOPE_AGENT); }
DI unsigned xb_xcc_id() { return (unsigned)__builtin_amdgcn_s_getreg((3 << 11) | 20) & 0xFu; }
#define XB_SPIN(cond, bar) do { unsigned _sp = 0; while (cond) { __builtin_amdgcn_s_sleep(1); \
    if ((++_sp & 255u) == 0u) { if (xb_ld(&(bar)[XB_TMO])) break; if (_sp > XB_SPIN_CAP) { atomicAdd(&(bar)[XB_TMO], 1u); break; } } } } while (0)
struct XcdBarrier { unsigned* bar; unsigned x; volatile LAS unsigned* st; };
DI XcdBarrier xcd_barrier_post(unsigned* bar, volatile LAS unsigned* st) {
  XcdBarrier b; b.bar = bar; b.x = xb_xcc_id(); b.st = st;
  if (threadIdx.x == 0) (void)xb_add(&bar[XB_XCNT(b.x)], 1u);
  return b;
}
DI void xcd_barrier_complete(unsigned* bar, unsigned x, unsigned& nloc, unsigned& nx) {
  const unsigned G = gridDim.x * gridDim.y * gridDim.z;
  unsigned sum, cnt, mine, sp = 0u;
  for (;;) {
    sum = 0u; cnt = 0u; mine = 0u;
#pragma unroll
    for (unsigned j = 0; j < 16; ++j) { const unsigned c = xb_ld(&bar[XB_XCNT(j)]); sum += c; cnt += (c > 0u) ? 1u : 0u; mine = (j == x) ? c : mine; }
    if (sum == G) break;
    __builtin_amdgcn_s_sleep(1);
    if ((++sp & 255u) == 0u) { if (xb_ld(&bar[XB_TMO])) break; if (sp > XB_SPIN_CAP) { atomicAdd(&bar[XB_TMO], 1u); break; } }
  }
  nloc = mine > 0u ? mine : 1u; nx = cnt > 0u ? cnt : 1u;
}
DI void xcd_barrier(const XcdBarrier& b) {
  asm volatile("s_waitcnt vmcnt(0)" ::: "memory");
  __syncthreads();
  if (threadIdx.x == 0) {
    unsigned* bar = b.bar;
    __builtin_amdgcn_s_waitcnt(0);
    unsigned nloc = b.st[0], nx = b.st[1];
    if (nloc == 0u) { xcd_barrier_complete(bar, b.x, nloc, nx); b.st[0] = nloc; b.st[1] = nx; }
    const unsigned old = xb_add(&bar[XB_XSUB(b.x)], 1u);
    const unsigned gen = old / nloc;
    if (old + 1u == (gen + 1u) * nloc) {
      __builtin_amdgcn_fence(__ATOMIC_RELEASE, "agent");
      asm volatile("s_waitcnt vmcnt(0)" ::: "memory");
      const unsigned og = xb_add(&bar[XB_TOP], 1u);
      const unsigned tg = og / nx;
      if (og + 1u == (tg + 1u) * nx) xb_add(&bar[XB_TOPGEN], 1u);
      else XB_SPIN(xb_ld(&bar[XB_TOPGEN]) == tg, bar);
      __builtin_amdgcn_fence(__ATOMIC_ACQUIRE, "agent");
      xb_add(&bar[XB_XGEN(b.x)], 1u);
      asm volatile("s_waitcnt vmcnt(0)" ::: "memory");
    } else {
      XB_SPIN(xb_ld(&bar[XB_XGEN(b.x)]) == gen, bar);
      __builtin_amdgcn_fence(__ATOMIC_ACQUIRE, "agent");
      asm volatile("s_waitcnt vmcnt(0)" ::: "memory");
    }
  }
  __syncthreads();
}

__global__ void __launch_bounds__(512) fwd_megakernel(Params p_unused) {
#define p (kp())
  cg::grid_group grid = cg::this_grid();
  volatile LAS unsigned* xst = (volatile LAS unsigned*)((LAS char*)g_shm + LDS_XST);
  if (threadIdx.x == 0) { xst[0] = 0u; xst[1] = 0u; }
  __syncthreads();
  (void)xcd_barrier_post((unsigned*)(lsp(p.ws) + OFF_BAR), xst);
#define GSYNC() do { XcdBarrier xb_; xb_.bar = (unsigned*)(lsp(p.ws) + OFF_BAR); unsigned xx_ = xb_xcc_id(); asm volatile("" : "+s"(xx_)); xb_.x = xx_; \
    xb_.st = (volatile LAS unsigned*)((LAS char*)g_shm + LDS_XST); xcd_barrier(xb_); } while (0)
#define WSP(off) ((u16*)(lsp(p.ws) + (off)))
  phase_norm(p.x, nullptr, nullptr, p.g_mix_pre, nullptr, WSP(OFF_H));
  convert_mixer_weights(p, 0);
  if (p.ws == nullptr) grid.sync();
  GSYNC();
#pragma unroll 1
  for (int l = 0; l < 2; ++l) {
    phase_inproj(p);
    GSYNC();
    {
      volatile LAS int* qslot = (volatile LAS int*)((LAS char*)g_shm + LDS_XST + 16);
#pragma unroll 1
      for (;;) {
        if (threadIdx.x == 0) *qslot = (int)atomicAdd((unsigned*)(lsp(p.ws) + OFF_QCTR) + l * 64 + 32, 1u);
        __syncthreads();
        const int it = *qslot;
        __syncthreads();
        if (it >= 1152) break;
        if (it < 128) nsa_compress(p, l, it);
        else gdn_prep(p, l, it - 128);
      }
    }
    GSYNC();
    if (blockIdx.x < 32) gdn_scan(p, l, blockIdx.x);
    {
      volatile LAS int* qslot = (volatile LAS int*)((LAS char*)g_shm + LDS_XST + 16);
#pragma unroll 1
      for (;;) {
        if (threadIdx.x == 0) *qslot = (int)atomicAdd((unsigned*)(lsp(p.ws) + OFF_QCTR) + l * 64, 1u);
        __syncthreads();
        const int it = *qslot;
        __syncthreads();
        if (it >= 768) break;
        if (it < 192) nsa_attn(p, it);
        else if (it < 448) { sb_attn_wave(p, (it - 192) * 8 + (lv(threadIdx.x) >> 6)); __syncthreads(); }
        else nsa_attn(p, it - 256);
      }
    }
    GSYNC();
    phase_merge(p);
    GSYNC();
    phase_gemm<0>(WSP(OFF_SCR), 1024, WSP(OFF_WOUT), 1024, 1024, 64, 4, WSP(OFF_H), 1024);
    GSYNC();
    phase_norm(l == 0 ? p.x : p.out, WSP(OFF_H), p.g_mix_post + l * 1024, p.g_ff_pre + l * 1024, p.out, WSP(OFF_H));
    convert_ffn_weights(p, l);
    GSYNC();
    phase_gemm<1>(WSP(OFF_H), 1024, WSP(OFF_WBIG), 1024, 1024, 64, 16, WSP(OFF_PROJ), 4096);
    GSYNC();
    phase_gemm<0>(WSP(OFF_PROJ), 4096, WSP(OFF_WBIG) + (size_t)4096 * 1024, 4096, 4096, 64, 4, WSP(OFF_SCR), 1024);
    GSYNC();
    phase_norm(p.out, WSP(OFF_SCR), p.g_ff_post + l * 1024, (l == 0) ? p.g_mix_pre + 1024 : nullptr, p.out, WSP(OFF_H));
    if (l == 0) { convert_mixer_weights(p, 1); GSYNC(); }
  }
}
#undef p

extern "C" void kernel_launch(void* const* d_in, const int* in_sizes, int n_in, void* d_out, int out_size, void* d_ws,
                              size_t ws_size, hipStream_t stream) {
  static int grid_blocks = 0;
  if (!grid_blocks) {
    int dev = 0, cus = 0, per_cu = 0;
    (void)hipGetDevice(&dev);
    (void)hipDeviceGetAttribute(&cus, hipDeviceAttributeMultiprocessorCount, dev);
    (void)hipFuncSetAttribute((const void*)fwd_megakernel, hipFuncAttributeMaxDynamicSharedMemorySize, LDS_BYTES);
    (void)hipOccupancyMaxActiveBlocksPerMultiprocessor(&per_cu, (const void*)fwd_megakernel, 512, LDS_BYTES);
    if (per_cu < 1) per_cu = 1;
    grid_blocks = cus * 1;
    if (ws_size < WS_NEED) fprintf(stderr, "workspace too small: %zu < %zu\n", ws_size, (size_t)WS_NEED);
  }
  Params p{};
  p.x = (const float*)d_in[0]; p.g_mix_pre = (const float*)d_in[1]; p.g_mix_post = (const float*)d_in[2];
  p.g_ff_pre = (const float*)d_in[3]; p.g_ff_post = (const float*)d_in[4]; p.w_in = (const float*)d_in[5];
  p.conv_w = (const float*)d_in[6]; p.a_log = (const float*)d_in[7]; p.dt_bias = (const float*)d_in[8];
  p.norm_g = (const float*)d_in[9]; p.cmp_wk = (const float*)d_in[10]; p.cmp_pk = (const float*)d_in[11];
  p.cmp_wv = (const float*)d_in[12]; p.cmp_pv = (const float*)d_in[13]; p.w_br0 = (const float*)d_in[14];
  p.w_br1 = (const float*)d_in[15]; p.w_br2 = (const float*)d_in[16]; p.w_out = (const float*)d_in[17];
  p.w_ff1 = (const float*)d_in[18]; p.w_ff2 = (const float*)d_in[19];
  p.out = (float*)d_out; p.ws = (char*)d_ws;
  (void)hipMemsetAsync((char*)d_ws + OFF_BAR, 0, 16384, stream);
  void* args[] = {&p};
  hipError_t e = hipLaunchCooperativeKernel((const void*)fwd_megakernel, dim3(grid_blocks), dim3(512), args, LDS_BYTES, stream);
  if (e != hipSuccess) fprintf(stderr, "cooperative launch failed: %s (grid %d)\n", hipGetErrorString(e), grid_blocks);
}
```

```cpp
#include <hip/hip_runtime.h>
#include <hip/hip_bf16.h>
#include <hip/hip_cooperative_groups.h>
#include <cstdio>
namespace cg = cooperative_groups;

typedef unsigned short u16;
using bf16x8 = __attribute__((ext_vector_type(8))) short;
using s16x4  = __attribute__((ext_vector_type(4))) short;
using f32x4  = __attribute__((ext_vector_type(4))) float;
using f32x16 = __attribute__((ext_vector_type(16))) float;
#define DI __device__ __forceinline__

constexpr int T_TOK = 16384, SEQL = 2048;
constexpr int NPJ = 4896;
constexpr int N_IN = 7968;
constexpr int C_GQ = 0, C_GK = 512, C_GV = 1024, C_GZ = 1536, C_GA = 2048, C_GB = 2052, C_NQ = 2056, C_NKV = 2568,
              C_NG = 3336, C_SQ = 3360, C_SK = 3872;
constexpr size_t OFF_WBR  = 0;
constexpr size_t OFF_WOUT = 3145728;
constexpr size_t OFF_WBIG = 5242880;
constexpr size_t OFF_PROJ = 22020096;
constexpr size_t OFF_SCR  = OFF_PROJ + 160432128;
constexpr size_t OFF_H    = OFF_SCR + 33554432;
constexpr size_t OFF_HALO = OFF_H + 33554432;
constexpr size_t OFF_KC   = OFF_HALO + 2359296;
constexpr size_t OFF_VCT  = OFF_KC + 262144;
constexpr size_t OFF_EGL  = OFF_VCT + 262144;
constexpr size_t OFF_WT   = OFF_EGL + 4096;
constexpr size_t OFF_CB   = OFF_WT + 524288;
constexpr size_t OFF_BAR  = OFF_CB + 512;
constexpr size_t OFF_QCTR = OFF_BAR + 14336;
constexpr size_t WS_NEED  = OFF_BAR + 16384;
constexpr int LDS_XST = 155648;
constexpr int LDS_BYTES = LDS_XST + 32;

struct Params {
  const float* x; const float* g_mix_pre; const float* g_mix_post; const float* g_ff_pre; const float* g_ff_post;
  const float* w_in; const float* conv_w; const float* a_log; const float* dt_bias; const float* norm_g;
  const float* cmp_wk; const float* cmp_pk; const float* cmp_wv; const float* cmp_pv;
  const float* w_br0; const float* w_br1; const float* w_br2; const float* w_out; const float* w_ff1; const float* w_ff2;
  float* out; char* ws;
};

extern __shared__ __attribute__((aligned(16))) char g_shm[];

typedef __bf16 bf2_t __attribute__((ext_vector_type(2)));
typedef float f2_t __attribute__((ext_vector_type(2)));
typedef unsigned u32x2 __attribute__((ext_vector_type(2)));
typedef unsigned u32x4 __attribute__((ext_vector_type(4)));
DI unsigned cvt2(float a, float b) { f2_t v; v[0] = a; v[1] = b; return __builtin_bit_cast(unsigned, __builtin_convertvector(v, bf2_t)); }
DI u16 f2bf(float x) { return (u16)(cvt2(x, x) & 0xffffu); }
DI float bf2f(u16 b) { return __uint_as_float(((unsigned)b) << 16); }
DI float bfs(short b) { return __uint_as_float(((unsigned)(u16)b) << 16); }
DI bf16x8 ld8(const u16* p) { return *(const bf16x8*)p; }
DI s16x4 ld4(const u16* p) { return *(const s16x4*)p; }
DI f32x4 mfma16(bf16x8 a, bf16x8 b, f32x4 c) { return __builtin_amdgcn_mfma_f32_16x16x32_bf16(a, b, c, 0, 0, 0); }
DI f32x16 mfma32(bf16x8 a, bf16x8 b, f32x16 c) { return __builtin_amdgcn_mfma_f32_32x32x16_bf16(a, b, c, 0, 0, 0); }
DI s16x4 pack4(float a, float b, float c, float d) { u32x2 r; r[0] = cvt2(a, b); r[1] = cvt2(c, d); return __builtin_bit_cast(s16x4, r); }
DI float sigmoidf_(float x) { return __builtin_amdgcn_rcpf(1.f + __expf(-x)); }
DI float softplusf_(float x) { return fmaxf(x, 0.f) + log1pf(__expf(-fabsf(x))); }
DI int lv(int v) { asm volatile("" : "+v"(v)); return v; }
DI char* lsp(char* q) { auto g = (__attribute__((address_space(1))) char*)q; asm volatile("" : "+s"(g)); return (char*)g; }
typedef const __attribute__((address_space(4))) Params* kparg_t;
#if defined(__HIP_DEVICE_COMPILE__)
DI Params kp() { kparg_t q = (kparg_t)__builtin_amdgcn_kernarg_segment_ptr(); asm volatile("" : "+s"(q)); return *q; }
#else
DI Params kp() { return Params{}; }
#endif
DI char* lds_base() { auto q = (__attribute__((address_space(3))) char*)g_shm; asm volatile("" : "+v"(q)); return (char*)q; }
DI void lds_barrier() { asm volatile("s_waitcnt lgkmcnt(0)" ::: "memory"); __builtin_amdgcn_s_barrier(); asm volatile("" ::: "memory"); }
DI int crow(int i, int h) { return (i & 3) + 8 * (i >> 2) + 4 * h; }
DI bf16x8 pack8(const f32x16& x, int s) {
  u32x4 r;
  r[0] = cvt2(x[8 * s + 0], x[8 * s + 1]); r[1] = cvt2(x[8 * s + 2], x[8 * s + 3]);
  r[2] = cvt2(x[8 * s + 4], x[8 * s + 5]); r[3] = cvt2(x[8 * s + 6], x[8 * s + 7]);
  return __builtin_bit_cast(bf16x8, r);
}

static __device__ __attribute__((always_inline)) inline void convert_weight(const float* W, int K, int N, u16* out, int ldo, bool winmap, int boff = 0) {
  float* lds = (float*)lds_base();
  const int tid = lv(threadIdx.x);
  const int nkt = K / 64, nnt = (N + 127) / 128, ntiles = nkt * nnt;
  f32x4 v[4];
#define CW_LOAD(T) do { const int kt_ = (T) % nkt, nt_ = (T) / nkt; \
    _Pragma("unroll") for (int q = 0; q < 4; ++q) { const int e = tid + q * 512, kk = e >> 5, n = nt_ * 128 + (e & 31) * 4; \
      v[q] = f32x4{0.f, 0.f, 0.f, 0.f}; if (n < N) v[q] = *(const f32x4*)(W + (size_t)(kt_ * 64 + kk) * N + n); } } while (0)
  int t = (int)((blockIdx.x + gridDim.x - (unsigned)boff) % gridDim.x);
  if (t < ntiles) CW_LOAD(t);
  for (; t < ntiles; t += gridDim.x) {
    const int kt = t % nkt, nt = t / nkt, k0 = kt * 64, n0 = nt * 128;
#pragma unroll
    for (int q = 0; q < 4; ++q) {
      const int e = tid + q * 512, kk = e >> 5, nn = (e & 31) * 4;
      lds[kk * 129 + nn + 0] = v[q][0]; lds[kk * 129 + nn + 1] = v[q][1]; lds[kk * 129 + nn + 2] = v[q][2]; lds[kk * 129 + nn + 3] = v[q][3];
    }
    lds_barrier();
    if (t + (int)gridDim.x < ntiles) CW_LOAD(t + (int)gridDim.x);
#pragma unroll
    for (int rep = 0; rep < 2; ++rep) {
      const int nn = (tid >> 3) + 64 * rep, ks = tid & 7, n = n0 + nn;
      if (n < N) {
        const int orow = winmap ? (n < NPJ ? n : n + 224) : n;
        u32x4 o;
#pragma unroll
        for (int e = 0; e < 4; ++e) o[e] = cvt2(lds[(ks * 8 + 2 * e) * 129 + nn], lds[(ks * 8 + 2 * e + 1) * 129 + nn]);
        *(u32x4*)(out + (size_t)orow * ldo + k0 + ks * 8) = o;
      }
    }
    lds_barrier();
  }
#undef CW_LOAD
  __syncthreads();
}

static __device__ __attribute__((always_inline)) inline void convert_mixer_weights(const Params& p, int l) {
  char* ws = lsp(p.ws);
  convert_weight(p.w_in + (size_t)l * 1024 * N_IN, 1024, N_IN, (u16*)(ws + OFF_WBIG), 1024, true);
  convert_weight(p.w_br0 + (size_t)l * 512 * 1024, 512, 1024, (u16*)(ws + OFF_WBR), 512, false);
  convert_weight(p.w_br1 + (size_t)l * 512 * 1024, 512, 1024, (u16*)(ws + OFF_WBR) + 1024 * 512, 512, false, 64);
  convert_weight(p.w_br2 + (size_t)l * 512 * 1024, 512, 1024, (u16*)(ws + OFF_WBR) + 2 * 1024 * 512, 512, false, 128);
  convert_weight(p.w_out + (size_t)l * 1024 * 1024, 1024, 1024, (u16*)(ws + OFF_WOUT), 1024, false, 192);
  convert_weight(p.cmp_wk + (size_t)l * 131072, 2048, 64, (u16*)(ws + OFF_WT), 2048, false, 64);
  convert_weight(p.cmp_wv + (size_t)l * 131072, 2048, 64, (u16*)(ws + OFF_WT) + 64 * 2048, 2048, false, 96);
  if (blockIdx.x >= 160 && blockIdx.x < 162) {
    const int kv = blockIdx.x - 160, tid = lv(threadIdx.x), e = tid & 63, part = tid >> 6;
    const float* W = (kv ? p.cmp_wv : p.cmp_wk) + (size_t)l * 131072;
    const float* pp = (kv ? p.cmp_pv : p.cmp_pk) + (size_t)l * 2048;
    float* red = (float*)lds_base();
    float sacc = 0.f;
    for (int k = part * 256; k < part * 256 + 256; ++k) sacc += pp[k] * W[k * 64 + e];
    red[part * 64 + e] = sacc;
    __syncthreads();
    if (tid < 64) { float t = 0.f; for (int q = 0; q < 8; ++q) t += red[q * 64 + tid]; ((float*)(ws + OFF_CB))[kv * 64 + tid] = t; }
    __syncthreads();
  }
}
static __device__ __attribute__((always_inline)) inline void convert_ffn_weights(const Params& p, int l) {
  char* ws = lsp(p.ws);
  convert_weight(p.w_ff1 + (size_t)l * 1024 * 4096, 1024, 4096, (u16*)(ws + OFF_WBIG), 1024, false);
  convert_weight(p.w_ff2 + (size_t)l * 4096 * 1024, 4096, 1024, (u16*)(ws + OFF_WBIG) + (size_t)4096 * 1024, 4096, false);
}

DI float wave_sum(float v) {
#pragma unroll
  for (int o = 32; o > 0; o >>= 1) v += __shfl_xor(v, o);
  return v;
}
static __device__ __attribute__((always_inline)) inline void phase_norm(const float* xin, const u16* y, const float* g_post, const float* g_next, float* xout, u16* H) {
  const int tidn = lv(threadIdx.x);
  const int wave = tidn >> 6, lane = tidn & 63;
  f32x4 gp[4], gn[4];
#pragma unroll
  for (int i = 0; i < 4; ++i) {
    gp[i] = y ? *(const f32x4*)(g_post + i * 256 + lane * 4) : f32x4{0.f, 0.f, 0.f, 0.f};
    gn[i] = g_next ? *(const f32x4*)(g_next + i * 256 + lane * 4) : f32x4{0.f, 0.f, 0.f, 0.f};
  }
  for (int row0 = (blockIdx.x * 8 + wave) * 2; row0 < T_TOK; row0 += gridDim.x * 16) {
    float xv[2][16], yv[2][16];
#pragma unroll
    for (int rr = 0; rr < 2; ++rr)
#pragma unroll
      for (int i = 0; i < 4; ++i) {
        f32x4 t = *(const f32x4*)(xin + (size_t)(row0 + rr) * 1024 + i * 256 + lane * 4);
        xv[rr][i * 4 + 0] = t[0]; xv[rr][i * 4 + 1] = t[1]; xv[rr][i * 4 + 2] = t[2]; xv[rr][i * 4 + 3] = t[3];
      }
    if (y) {
      float ss[2] = {0.f, 0.f};
#pragma unroll
      for (int rr = 0; rr < 2; ++rr)
#pragma unroll
        for (int i = 0; i < 4; ++i) {
          s16x4 t = ld4(y + (size_t)(row0 + rr) * 1024 + i * 256 + lane * 4);
#pragma unroll
          for (int e = 0; e < 4; ++e) { yv[rr][i * 4 + e] = bfs(t[e]); ss[rr] += yv[rr][i * 4 + e] * yv[rr][i * 4 + e]; }
        }
#pragma unroll
      for (int o = 32; o > 0; o >>= 1) { float t0 = __shfl_xor(ss[0], o), t1 = __shfl_xor(ss[1], o); ss[0] += t0; ss[1] += t1; }
#pragma unroll
      for (int rr = 0; rr < 2; ++rr) {
        const float r = rsqrtf(ss[rr] * (1.f / 1024.f) + 1e-6f);
#pragma unroll
        for (int i = 0; i < 4; ++i) {
          const f32x4 g = gp[i];
          f32x4 o;
#pragma unroll
          for (int e = 0; e < 4; ++e) { xv[rr][i * 4 + e] += yv[rr][i * 4 + e] * r * g[e]; o[e] = xv[rr][i * 4 + e]; }
          *(f32x4*)(xout + (size_t)(row0 + rr) * 1024 + i * 256 + lane * 4) = o;
        }
      }
    }
    if (g_next) {
      float ss[2] = {0.f, 0.f};
#pragma unroll
      for (int rr = 0; rr < 2; ++rr)
#pragma unroll
        for (int i = 0; i < 16; ++i) ss[rr] += xv[rr][i] * xv[rr][i];
#pragma unroll
      for (int o = 32; o > 0; o >>= 1) { float t0 = __shfl_xor(ss[0], o), t1 = __shfl_xor(ss[1], o); ss[0] += t0; ss[1] += t1; }
#pragma unroll
      for (int rr = 0; rr < 2; ++rr) {
        const float r = rsqrtf(ss[rr] * (1.f / 1024.f) + 1e-6f);
#pragma unroll
        for (int i = 0; i < 4; ++i) {
          const f32x4 g = gn[i];
          *(s16x4*)(H + (size_t)(row0 + rr) * 1024 + i * 256 + lane * 4) =
              pack4(xv[rr][i * 4] * r * g[0], xv[rr][i * 4 + 1] * r * g[1], xv[rr][i * 4 + 2] * r * g[2], xv[rr][i * 4 + 3] * r * g[3]);
        }
      }
    }
  }
}

constexpr int BM = 256, BK = 64, HALF = 128, HT = HALF * BK;
DI int lds_byte(int r, int c) {
  int st = (r >> 4) * 2 + (c >> 5), rr = r & 15, cc = c & 31, ob = rr * 64 + cc * 2;
  return st * 1024 + (ob ^ (((ob >> 9) & 1) << 5));
}
DI void stage_rc(int b, int& R, int& C) {
  int st = b / 1024, sb = b % 1024, swz = sb ^ (((sb >> 9) & 1) << 5);
  R = (st >> 1) * 16 + swz / 64; C = (st & 1) * 32 + (swz % 64) / 2;
}
DI void tile_map(int wgid, int nM, int nN, int& pm, int& pn) {
  const int NXCD = 8, WGM = 8;
  int nwg = nM * nN;
  { int q = nwg / NXCD, r = nwg % NXCD, xcd = wgid % NXCD, off = wgid / NXCD;
    wgid = (xcd < r ? xcd * (q + 1) : r * (q + 1) + (xcd - r) * q) + off; }
  int nig = WGM * nN, gid = wgid / nig, fm = gid * WGM, gsz = min(nM - fm, WGM);
  pm = fm + ((wgid % nig) % gsz); pn = (wgid % nig) / gsz;
}

struct NoPre { DI void operator()(int, int, int) const {} };
template <class Epi, class Pre = NoPre>
DI void gemm_tile(const u16* A, int lda, const u16* Bt, int ldb, int K, int brow, int bcol, Epi epi, Pre pre = Pre()) {
  u16* shm = (u16*)g_shm;
#define SA(b, h) (shm + ((b) * 2 + (h)) * HT)
#define SB(b, h) (shm + (4 + (b) * 2 + (h)) * HT)
#define STAGE(P, BASE, LD, br, kt) do { const char* _gb = (const char*)((BASE) + (size_t)(br) * (LD) + (size_t)(kt) * BK); \
    for (int _i = 0; _i < 2; ++_i) { int _b = tidx * 16 + _i * 8192; \
      __builtin_amdgcn_global_load_lds((const unsigned*)(_gb + (((LD) == lda) ? offA[_i] : offB[_i])), \
        (__attribute__((address_space(3))) unsigned*)((char*)(P) + _b), 16, 0, 0); } } while (0)
#define LDA(dst, b, h) for (int m = 0; m < 4; ++m) for (int k = 0; k < 2; ++k) \
    dst[m][k] = *reinterpret_cast<const bf16x8*>((char*)SA(b, h) + lds_byte(wr * 64 + m * 16 + fr, k * 32 + fq * 8))
#define LDB(dst, b, h) for (int n = 0; n < 2; ++n) for (int k = 0; k < 2; ++k) \
    dst[n][k] = *reinterpret_cast<const bf16x8*>((char*)SB(b, h) + lds_byte(wc * 32 + n * 16 + fr, k * 32 + fq * 8))
#define MMA(ai, bj, At_, Bt_) do { __builtin_amdgcn_s_setprio(1); \
    for (int m = 0; m < 4; ++m) for (int n = 0; n < 2; ++n) for (int k = 0; k < 2; ++k) \
      acc[ai][bj][m][n] = __builtin_amdgcn_mfma_f32_16x16x32_bf16(Bt_[n][k], At_[m][k], acc[ai][bj][m][n], 0, 0, 0); \
    __builtin_amdgcn_s_setprio(0); } while (0)
#define WAIT_V(n) asm volatile("s_waitcnt vmcnt(" #n ")" ::: "memory")
#define WAIT_L(n) asm volatile("s_waitcnt lgkmcnt(" #n ")" ::: "memory")
#define BAR __builtin_amdgcn_s_barrier()
#define SCHED __builtin_amdgcn_sched_barrier(0)
  int tidx = threadIdx.x; asm volatile("" : "+v"(tidx));
  const int wid = tidx >> 6, lane = tidx & 63, wr = wid >> 2, wc = wid & 3, fr = lane & 15, fq = lane >> 4;
  unsigned offA[2], offB[2];
#pragma unroll
  for (int _i = 0; _i < 2; ++_i) { int _r, _c; stage_rc(tidx * 16 + _i * 8192, _r, _c); offA[_i] = (unsigned)(_r * lda + _c) * 2u; offB[_i] = (unsigned)(_r * ldb + _c) * 2u; }
  f32x4 acc[2][2][4][2] = {};
  bf16x8 At[4][2], B0[2][2], B1[2][2];
  const int nt = K / BK;
  STAGE(SB(0, 0), Bt, ldb, bcol, 0); STAGE(SA(0, 0), A, lda, brow, 0);
  STAGE(SB(0, 1), Bt, ldb, bcol + HALF, 0); STAGE(SA(0, 1), A, lda, brow + HALF, 0);
  if (wr == 1) BAR;
  WAIT_V(4); BAR;
  STAGE(SB(1, 0), Bt, ldb, bcol, 1); STAGE(SA(1, 0), A, lda, brow, 1); STAGE(SB(1, 1), Bt, ldb, bcol + HALF, 1);
  WAIT_V(6); BAR;
  for (int t = 0; t < nt - 2; t += 2) {
    LDB(B0, 0, 0); SCHED; LDA(At, 0, 0); STAGE(SA(1, 1), A, lda, brow + HALF, t + 1);
    WAIT_L(8); BAR; WAIT_L(0); MMA(0, 0, At, B0); BAR; SCHED;
    LDB(B1, 0, 1); STAGE(SB(0, 0), Bt, ldb, bcol, t + 2);
    BAR; WAIT_L(0); MMA(0, 1, At, B1); BAR;
    LDA(At, 0, 1); STAGE(SA(0, 0), A, lda, brow, t + 2);
    BAR; WAIT_L(0); MMA(1, 0, At, B0); BAR; SCHED;
    STAGE(SB(0, 1), Bt, ldb, bcol + HALF, t + 2);
    WAIT_V(6); BAR; MMA(1, 1, At, B1); BAR;
    LDB(B0, 1, 0); SCHED; LDA(At, 1, 0); STAGE(SA(0, 1), A, lda, brow + HALF, t + 2);
    WAIT_L(8); BAR; WAIT_L(0); MMA(0, 0, At, B0); BAR; SCHED;
    LDB(B1, 1, 1); STAGE(SB(1, 0), Bt, ldb, bcol, t + 3);
    BAR; WAIT_L(0); MMA(0, 1, At, B1); BAR;
    LDA(At, 1, 1); STAGE(SA(1, 0), A, lda, brow, t + 3);
    BAR; WAIT_L(0); MMA(1, 0, At, B0); BAR; SCHED;
    STAGE(SB(1, 1), Bt, ldb, bcol + HALF, t + 3);
    WAIT_V(6); BAR; MMA(1, 1, At, B1); BAR;
  }
  { LDB(B0, 0, 0); LDA(At, 0, 0); STAGE(SA(1, 1), A, lda, brow + HALF, nt - 1);
    BAR; WAIT_L(0); MMA(0, 0, At, B0); BAR;
    LDB(B1, 0, 1); BAR; WAIT_L(0); MMA(0, 1, At, B1); BAR;
    LDA(At, 0, 1); WAIT_V(4); BAR; WAIT_L(0); MMA(1, 0, At, B0); MMA(1, 1, At, B1); BAR; }
  { LDB(B0, 1, 0); LDA(At, 1, 0); WAIT_V(2); BAR; WAIT_L(0); MMA(0, 0, At, B0); BAR;
    LDB(B1, 1, 1); WAIT_V(0); BAR; WAIT_L(0); MMA(0, 1, At, B1); BAR;
    LDA(At, 1, 1); BAR; WAIT_L(0); MMA(1, 0, At, B0); MMA(1, 1, At, B1); BAR; }
  if (wr == 0) BAR;
  int tid2 = tidx; asm volatile("" : "+v"(tid2));
  const int wid2 = tid2 >> 6, lane2 = tid2 & 63, wr2 = wid2 >> 2, wc2 = wid2 & 3, fr2 = lane2 & 15, fq2 = lane2 >> 4;
#pragma unroll
  for (int ai = 0; ai < 2; ++ai)
#pragma unroll
    for (int bj = 0; bj < 2; ++bj)
#pragma unroll
      for (int m = 0; m < 4; ++m) {
#pragma unroll
        for (int n = 0; n < 2; ++n)
          pre(n, brow + ai * HALF + wr2 * 64 + m * 16 + fr2, bcol + bj * HALF + wc2 * 32 + n * 16 + fq2 * 4);
#pragma unroll
        for (int n = 0; n < 2; ++n)
          epi(n, brow + ai * HALF + wr2 * 64 + m * 16 + fr2, bcol + bj * HALF + wc2 * 32 + n * 16 + fq2 * 4, acc[ai][bj][m][n]);
      }
  __syncthreads();
#undef SA
#undef SB
#undef STAGE
#undef LDA
#undef LDB
#undef MMA
}

static __device__ __attribute__((always_inline)) inline void phase_inproj(const Params& p) {
  char* ws = lsp(p.ws);
  u16* H = (u16*)(ws + OFF_H); u16* WinT = (u16*)(ws + OFF_WBIG); u16* PROJ = (u16*)(ws + OFF_PROJ);
  u16* HALO = (u16*)(ws + OFF_HALO);
  const int nM = 64, nN = 20;
  for (int t = blockIdx.x; t < nM * nN; t += gridDim.x) {
    int pm, pn; tile_map(t, nM, nN, pm, pn);
    gemm_tile(H, 1024, WinT, 1024, 1024, pm * 256, pn * 256, [&](int idx, int row, int col, f32x4 v) {
      if (col < NPJ) {
        s16x4 b = pack4(v[0], v[1], v[2], v[3]);
        *(s16x4*)(PROJ + (size_t)row * NPJ + col) = b;
        if (col < 1536 && (row & 63) >= 61) *(s16x4*)(HALO + ((size_t)(row >> 6) * 3 + ((row & 63) - 61)) * 1536 + col) = b;
      }
    });
  }
}

static __device__ __attribute__((always_inline)) inline void sb_attn_wave(const Params& p, int witem) {
  u16* PROJ = (u16*)(lsp(p.ws) + OFF_PROJ);
  const int tid = lv(threadIdx.x), lane = tid & 63, w = tid >> 6, lq5 = lane & 31, hf = lane >> 5;
  u16* VT = (u16*)lds_base() + w * (64 * 40);
  const int b = witem >> 8, h = (witem >> 5) & 7, qt = witem & 31;
  const int t0 = qt * 64;
  bf16x8 qf[2][4];
#pragma unroll
  for (int qi = 0; qi < 2; ++qi)
#pragma unroll
    for (int s = 0; s < 4; ++s) {
      bf16x8 raw = ld8(PROJ + ((size_t)b * SEQL + t0 + 32 * qi + lq5) * NPJ + C_SQ + h * 64 + 16 * s + 8 * hf);
#pragma unroll
      for (int e = 0; e < 8; ++e) raw[e] = (short)f2bf(bfs(raw[e]) * 0.125f);
      qf[qi][s] = raw;
    }
  f32x16 oacc[2][2];
#pragma unroll
  for (int i = 0; i < 16; ++i) { oacc[0][0][i] = 0.f; oacc[0][1][i] = 0.f; oacc[1][0][i] = 0.f; oacc[1][1][i] = 0.f; }
  float carry[2] = {1.f, 1.f};
#pragma unroll 1
  for (int k0 = t0 + 32; k0 >= 0; k0 -= 32) {
    const size_t krow = ((size_t)b * SEQL + k0 + lq5) * NPJ + C_SK + h * 64;
    {
      bf16x8 v0 = ld8(PROJ + krow + 512 + hf * 32), v1 = ld8(PROJ + krow + 512 + hf * 32 + 8);
      bf16x8 v2 = ld8(PROJ + krow + 512 + hf * 32 + 16), v3 = ld8(PROJ + krow + 512 + hf * 32 + 24);
#pragma unroll
      for (int e = 0; e < 8; ++e) {
        VT[(hf * 32 + e) * 40 + lq5] = (u16)v0[e]; VT[(hf * 32 + 8 + e) * 40 + lq5] = (u16)v1[e];
        VT[(hf * 32 + 16 + e) * 40 + lq5] = (u16)v2[e]; VT[(hf * 32 + 24 + e) * 40 + lq5] = (u16)v3[e];
      }
    }
    bf16x8 kf[4];
#pragma unroll
    for (int s = 0; s < 4; ++s) kf[s] = ld8(PROJ + krow + 16 * s + 8 * hf);
#pragma unroll
    for (int qi = 0; qi < 2; ++qi) {
      if (k0 >= t0 + 32 * qi + 31) continue;
      f32x16 st;
#pragma unroll
      for (int i = 0; i < 16; ++i) st[i] = 0.f;
#pragma unroll
      for (int s = 0; s < 4; ++s) st = mfma32(kf[s], qf[qi][s], st);
      const int t = t0 + 32 * qi + lq5;
      float m[16];
#pragma unroll
      for (int i = 0; i < 16; ++i) {
        const float z = fminf(fmaxf(st[i], -80.f), 80.f);
        const float e = __expf(z);
        const float r = __builtin_amdgcn_rcpf(1.f + e);
        const bool c = (k0 + crow(i, hf)) < t;
        m[i] = c ? r : 1.f;
        st[i] = c ? e * r : 0.f;
      }
      float T[4], P[4];
#pragma unroll
      for (int gi = 0; gi < 4; ++gi) { T[gi] = (m[4 * gi] * m[4 * gi + 1]) * (m[4 * gi + 2] * m[4 * gi + 3]); P[gi] = __shfl_xor(T[gi], 32); }
      float aft[4];
      aft[3] = (hf == 0) ? P[3] : 1.f;
      aft[2] = T[3] * P[3] * ((hf == 0) ? P[2] : 1.f);
      aft[1] = T[3] * P[3] * T[2] * P[2] * ((hf == 0) ? P[1] : 1.f);
      aft[0] = T[3] * P[3] * T[2] * P[2] * T[1] * P[1] * ((hf == 0) ? P[0] : 1.f);
      const float cin = carry[qi];
#pragma unroll
      for (int gi = 0; gi < 4; ++gi) {
        const float base = cin * aft[gi];
        const float w2 = m[4 * gi + 3], w1 = w2 * m[4 * gi + 2], w0 = w1 * m[4 * gi + 1];
        st[4 * gi + 0] *= base * w0;
        st[4 * gi + 1] *= base * w1;
        st[4 * gi + 2] *= base * w2;
        st[4 * gi + 3] *= base;
      }
      carry[qi] = cin * ((T[0] * P[0]) * (T[1] * P[1])) * ((T[2] * P[2]) * (T[3] * P[3]));
#pragma unroll
      for (int s = 0; s < 2; ++s) {
        bf16x8 pf = pack8(st, s);
#pragma unroll
        for (int dt = 0; dt < 2; ++dt) {
          const u16* vp = VT + (32 * dt + lq5) * 40 + 16 * s + 4 * hf;
          s16x4 lo = ld4(vp), hi = ld4(vp + 8);
          bf16x8 vf = __builtin_shufflevector(lo, hi, 0, 1, 2, 3, 4, 5, 6, 7);
          oacc[qi][dt] = mfma32(vf, pf, oacc[qi][dt]);
        }
      }
    }
    if (k0 <= t0 && __all(carry[0] < 1.2e-38f && carry[1] < 1.2e-38f)) break;
  }
#pragma unroll
  for (int qi = 0; qi < 2; ++qi)
#pragma unroll
    for (int dt = 0; dt < 2; ++dt)
#pragma unroll
      for (int g4 = 0; g4 < 4; ++g4)
        *(s16x4*)(PROJ + ((size_t)b * SEQL + t0 + 32 * qi + lq5) * NPJ + C_SQ + h * 64 + 32 * dt + 8 * g4 + 4 * hf) =
            pack4(oacc[qi][dt][4 * g4], oacc[qi][dt][4 * g4 + 1], oacc[qi][dt][4 * g4 + 2], oacc[qi][dt][4 * g4 + 3]);
}

static __device__ __attribute__((always_inline)) inline void nsa_compress(const Params& p, int l, int item) {
  char* ws = lsp(p.ws);
  const u16* PROJ = (const u16*)(ws + OFF_PROJ);
  u16* KC = (u16*)(ws + OFF_KC); u16* VCT = (u16*)(ws + OFF_VCT);
  const u16* WT = (const u16*)(ws + OFF_WT); const float* CB = (const float*)(ws + OFF_CB);
  float* red = (float*)lds_base();
  const int tid = lv(threadIdx.x), lane = tid & 63, w = tid >> 6, lq5 = lane & 31, hf = lane >> 5;
  const int nt4 = item & 3, kv = (item >> 2) & 1, g = (item >> 3) & 1, b = item >> 4;
  const int n = 32 * nt4 + lq5;
  f32x16 acc[2];
#pragma unroll
  for (int i = 0; i < 16; ++i) { acc[0][i] = 0.f; acc[1][i] = 0.f; }
#pragma unroll 4
  for (int ks = 0; ks < 16; ++ks) {
    const int ll = 4 * w + (ks >> 2), d0 = (ks & 3) * 16 + 8 * hf;
    bf16x8 a;
#pragma unroll
    for (int e = 0; e < 8; ++e) a[e] = 0;
    if (n < 127) a = ld8(PROJ + ((size_t)b * SEQL + 16 * n + ll) * NPJ + C_NKV + kv * 128 + g * 64 + d0);
#pragma unroll
    for (int et = 0; et < 2; ++et)
      acc[et] = mfma32(a, ld8(WT + ((size_t)(kv * 64 + 32 * et + lq5)) * 2048 + ll * 64 + d0), acc[et]);
  }
#pragma unroll
  for (int et = 0; et < 2; ++et)
#pragma unroll
    for (int i = 0; i < 16; ++i) red[(w * 32 + crow(i, hf)) * 64 + 32 * et + lq5] = acc[et][i];
  __syncthreads();
  {
    const int nl = tid >> 4, e0 = (tid & 15) * 4;
    float v[4];
#pragma unroll
    for (int q = 0; q < 4; ++q) v[q] = CB[kv * 64 + e0 + q];
#pragma unroll
    for (int ww = 0; ww < 8; ++ww)
#pragma unroll
      for (int q = 0; q < 4; ++q) v[q] += red[(ww * 32 + nl) * 64 + e0 + q];
    const int nn = 32 * nt4 + nl;
    if (nn >= 127) { v[0] = 0.f; v[1] = 0.f; v[2] = 0.f; v[3] = 0.f; }
    if (kv == 0) *(s16x4*)(KC + ((size_t)(b * 2 + g) * 128 + nn) * 64 + e0) = pack4(v[0], v[1], v[2], v[3]);
    else {
#pragma unroll
      for (int q = 0; q < 4; ++q) VCT[((size_t)(b * 2 + g) * 64 + e0 + q) * 128 + nn] = f2bf(v[q]);
    }
  }
  __syncthreads();
}

static __device__ __attribute__((always_inline)) inline void gdn_prep(const Params& p, int l, int item) {
  char* ws = lsp(p.ws);
  u16* PROJ = (u16*)(ws + OFF_PROJ); u16* HALO = (u16*)(ws + OFF_HALO);
  u16* WG = (u16*)(ws + OFF_SCR); u16* ATT = (u16*)(ws + OFF_SCR + 16777216);
  float* EGL = (float*)(ws + OFF_EGL);
  u16* Qb = (u16*)lds_base();
  u16* Kb = Qb + 64 * 136;
  u16* vbT = Kb + 64 * 136;
  u16* kbT = vbT + 128 * 72;
  float* As = (float*)(kbT + 128 * 72);
  u16* Tb = (u16*)(As + 64 * 65);
  float* sg = (float*)(Tb + 64 * 72);
  float* sbeta = sg + 64; float* sgc = sbeta + 64;
  const int tid = lv(threadIdx.x), lane = tid & 63, w = tid >> 6, lr = lane & 15, lq = lane >> 4;
  const int c = item & 31, h = (item >> 5) & 3, b = item >> 7;
  const int t0 = b * SEQL + c * 64;
  const int i = tid & 63, cgp = tid >> 6;
  const float* cw = p.conv_w + (size_t)l * 4 * 1536;
  if (tid < 64) {
    float a = bf2f(PROJ[(size_t)(t0 + tid) * NPJ + C_GA + h]);
    float bt = bf2f(PROJ[(size_t)(t0 + tid) * NPJ + C_GB + h]);
    sg[tid] = -__expf(p.a_log[l * 4 + h]) * softplusf_(a + p.dt_bias[l * 4 + h]);
    sbeta[tid] = sigmoidf_(bt);
  }
  float qkv[3][16];
  {
    bf16x8 xr[3][4][2];
#pragma unroll
    for (int sec = 0; sec < 3; ++sec)
#pragma unroll
      for (int j = 0; j < 4; ++j) {
        const int colb = sec * 512 + h * 128 + cgp * 16;
        const int ii = i - 3 + j;
        const u16* src = (ii >= 0) ? PROJ + (size_t)(t0 + ii) * NPJ + colb
                                   : HALO + ((size_t)(max(t0 >> 6, 1) - 1) * 3 + (3 + ii)) * 1536 + colb;
        xr[sec][j][0] = ld8(src); xr[sec][j][1] = ld8(src + 8);
      }
#pragma unroll
    for (int sec = 0; sec < 3; ++sec) {
      const int colb = sec * 512 + h * 128 + cgp * 16;
#pragma unroll
      for (int e = 0; e < 16; ++e) qkv[sec][e] = 0.f;
#pragma unroll
      for (int j = 0; j < 4; ++j) {
        const int ii = i - 3 + j;
        const float keep = (ii >= 0 || c > 0) ? 1.f : 0.f;
#pragma unroll
        for (int e = 0; e < 8; ++e) {
          qkv[sec][e] += (keep * cw[j * 1536 + colb + e]) * bfs(xr[sec][j][0][e]);
          qkv[sec][8 + e] += (keep * cw[j * 1536 + colb + 8 + e]) * bfs(xr[sec][j][1][e]);
        }
      }
#pragma unroll
      for (int e = 0; e < 16; ++e) { float x = qkv[sec][e]; qkv[sec][e] = x * __builtin_amdgcn_rcpf(1.f + __expf(-x)); }
    }
  }
  {
    float sq = 0.f, sk = 0.f;
#pragma unroll
    for (int e = 0; e < 16; ++e) { sq += qkv[0][e] * qkv[0][e]; sk += qkv[1][e] * qkv[1][e]; }
    float* rdn = As;
    rdn[(0 * 8 + cgp) * 64 + i] = sq; rdn[(1 * 8 + cgp) * 64 + i] = sk;
    __syncthreads();
    sq = 0.f; sk = 0.f;
#pragma unroll
    for (int cc = 0; cc < 8; ++cc) { sq += rdn[(0 * 8 + cc) * 64 + i]; sk += rdn[(1 * 8 + cc) * 64 + i]; }
    float rq = rsqrtf(sq + 1e-6f) * 0.08838834764831845f, rk = rsqrtf(sk + 1e-6f);
#pragma unroll
    for (int e = 0; e < 16; ++e) { qkv[0][e] *= rq; qkv[1][e] *= rk; }
  }
  if (tid < 64) {
    float sc_ = sg[tid];
#pragma unroll
    for (int o = 1; o < 64; o <<= 1) { float t = __shfl_up(sc_, o); if (lane >= o) sc_ += t; }
    sgc[tid] = sc_;
    if (tid == 63) EGL[item] = __expf(sc_);
  }
  __syncthreads();
  {
    const float gci = sgc[i], gl = sgc[63], bi = sbeta[i];
    const float eg = __expf(gci), ekd = __expf(gl - gci);
    bf16x8 a0, a1, b0, b1, c0, c1, d0, d1;
#pragma unroll
    for (int e = 0; e < 8; ++e) {
      a0[e] = (short)f2bf(qkv[0][e]); a1[e] = (short)f2bf(qkv[0][8 + e]);
      b0[e] = (short)f2bf(qkv[1][e]); b1[e] = (short)f2bf(qkv[1][8 + e]);
      c0[e] = (short)f2bf(qkv[0][e] * eg); c1[e] = (short)f2bf(qkv[0][8 + e] * eg);
      d0[e] = (short)f2bf(qkv[1][e] * ekd); d1[e] = (short)f2bf(qkv[1][8 + e] * ekd);
    }
    *(bf16x8*)(Qb + i * 136 + cgp * 16) = a0; *(bf16x8*)(Qb + i * 136 + cgp * 16 + 8) = a1;
    *(bf16x8*)(Kb + i * 136 + cgp * 16) = b0; *(bf16x8*)(Kb + i * 136 + cgp * 16 + 8) = b1;
    u16* gq = PROJ + (size_t)(t0 + i) * NPJ + C_GQ + h * 128 + cgp * 16;
    u16* gk = PROJ + (size_t)(t0 + i) * NPJ + C_GK + h * 128 + cgp * 16;
    *(bf16x8*)gq = c0; *(bf16x8*)(gq + 8) = c1;
    *(bf16x8*)gk = d0; *(bf16x8*)(gk + 8) = d1;
#pragma unroll
    for (int e = 0; e < 16; ++e) {
      vbT[(cgp * 16 + e) * 72 + i] = f2bf(qkv[2][e] * bi);
      kbT[(cgp * 16 + e) * 72 + i] = f2bf(qkv[1][e] * bi * eg);
    }
  }
  __syncthreads();
#pragma unroll 1
  for (int jj = 0; jj < 2; ++jj) {
    const int tile = w * 2 + jj, ti = tile >> 2, tj = tile & 3;
    f32x4 acc = {0.f, 0.f, 0.f, 0.f};
    if (tj <= ti) {
#pragma unroll
      for (int ks = 0; ks < 4; ++ks)
        acc = mfma16(ld8(Kb + (ti * 16 + lr) * 136 + ks * 32 + lq * 8), ld8(Kb + (tj * 16 + lr) * 136 + ks * 32 + lq * 8), acc);
    }
    const int j = tj * 16 + lr;
#pragma unroll
    for (int r = 0; r < 4; ++r) {
      const int ir = ti * 16 + lq * 4 + r;
      As[ir * 65 + j] = (j < ir) ? sbeta[ir] * acc[r] * __expf(sgc[ir] - sgc[j]) : 0.f;
    }
  }
  __syncthreads();
  if (w != 0) {
#pragma unroll 1
    for (int tile = w - 1; tile < 16; tile += 7) {
      const int ti = tile >> 2, tj = tile & 3;
      f32x4 acc = {0.f, 0.f, 0.f, 0.f};
      if (tj <= ti) {
#pragma unroll
        for (int ks = 0; ks < 4; ++ks)
          acc = mfma16(ld8(Qb + (ti * 16 + lr) * 136 + ks * 32 + lq * 8), ld8(Kb + (tj * 16 + lr) * 136 + ks * 32 + lq * 8), acc);
      }
      const int j = tj * 16 + lr;
#pragma unroll
      for (int r = 0; r < 4; ++r) {
        const int ir = ti * 16 + lq * 4 + r;
        const float dec = (j <= ir) ? __expf(sgc[ir] - sgc[j]) : 0.f;
        ATT[(size_t)item * 4096 + ir * 64 + j] = f2bf(acc[r] * dec);
      }
    }
  }
  if (w == 0) {
    float Ar[64], Tc[64];
#pragma unroll
    for (int ir = 0; ir < 64; ++ir) Ar[ir] = As[ir * 65 + lane];
#pragma unroll
    for (int ir = 0; ir < 64; ++ir) {
      float sacc = (ir == lane) ? 1.f : 0.f;
#pragma unroll
      for (int j = 0; j < ir; ++j) sacc -= __uint_as_float(__builtin_amdgcn_readlane(__float_as_uint(Ar[ir]), j)) * Tc[j];
      Tc[ir] = sacc;
    }
#pragma unroll
    for (int ir = 0; ir < 64; ++ir) Tb[ir * 72 + lane] = f2bf(Tc[ir]);
  }
  __syncthreads();
#pragma unroll 1
  for (int jj = 0; jj < 8; ++jj) {
    const int job = w * 8 + jj, which = job >> 5, tile = job & 31, ti = tile >> 3, tn = tile & 7;
    const u16* BT = which ? kbT : vbT;
    f32x4 acc = {0.f, 0.f, 0.f, 0.f};
#pragma unroll
    for (int ks = 0; ks < 2; ++ks)
      acc = mfma16(ld8(Tb + (ti * 16 + lr) * 72 + ks * 32 + lq * 8), ld8(BT + (tn * 16 + lr) * 72 + ks * 32 + lq * 8), acc);
    const int d = tn * 16 + lr;
#pragma unroll
    for (int r = 0; r < 4; ++r) {
      const int ir = ti * 16 + lq * 4 + r;
      if (which == 0) PROJ[(size_t)(t0 + ir) * NPJ + C_GV + h * 128 + d] = f2bf(acc[r]);
      else WG[(size_t)(t0 + ir) * 512 + h * 128 + d] = f2bf(acc[r]);
    }
  }
  __syncthreads();
}

static __device__ __attribute__((always_inline)) inline void gdn_scan(const Params& p, int l, int bh) {
  char* ws = lsp(p.ws);
  u16* PROJ = (u16*)(ws + OFF_PROJ);
  const u16* WG = (const u16*)(ws + OFF_SCR); const u16* ATT = (const u16*)(ws + OFF_SCR + 16777216);
  const float* EGL = (const float*)(ws + OFF_EGL);
  u16* St = (u16*)lds_base();
  u16* Wl = St + 128 * 136;
  u16* Ql = Wl + 64 * 136;
  u16* KdT = Ql + 64 * 136;
  u16* VnT = KdT + 128 * 72;
  u16* At = VnT + 128 * 72;
  float* red = (float*)(At + 64 * 72);
  float* egls = red + 128;
  const int tid = lv(threadIdx.x), lane = tid & 63, w = tid >> 6, lr = lane & 15, lq = lane >> 4;
  const int b = bh >> 2, h = bh & 3;
  const float* ng = p.norm_g + l * 128;
  f32x4 S[8];
#pragma unroll
  for (int v = 0; v < 8; ++v) S[v] = f32x4{0.f, 0.f, 0.f, 0.f};
  for (int idx = tid; idx < 128 * 136; idx += 512) St[idx] = 0;
  const int it = w >> 1, vb = (w & 1) * 4;
  float ngv[4];
#pragma unroll
  for (int n = 0; n < 4; ++n) ngv[n] = ng[(vb + n) * 16 + lr];
  const int r0 = tid >> 4, seg0 = tid & 15;
  const int ra = tid >> 3, sega = tid & 7;
  bf16x8 pw[2], pq[2], pk[2], pa;
  u16 un[16];
  {
    const int t0 = b * SEQL;
#pragma unroll
    for (int rep = 0; rep < 2; ++rep) {
      const int r = r0 + rep * 32;
      pw[rep] = ld8(WG + (size_t)(t0 + r) * 512 + h * 128 + seg0 * 8);
      pq[rep] = ld8(PROJ + (size_t)(t0 + r) * NPJ + C_GQ + h * 128 + seg0 * 8);
      pk[rep] = ld8(PROJ + (size_t)(t0 + r) * NPJ + C_GK + h * 128 + seg0 * 8);
    }
    pa = ld8(ATT + (size_t)(bh * 32) * 4096 + ra * 64 + sega * 8);
#pragma unroll
    for (int n = 0; n < 4; ++n)
#pragma unroll
      for (int r = 0; r < 4; ++r)
        un[n * 4 + r] = PROJ[(size_t)(t0 + it * 16 + lq * 4 + r) * NPJ + C_GV + h * 128 + (vb + n) * 16 + lr];
    if (tid < 32) egls[tid] = EGL[bh * 32 + tid];
  }
#pragma unroll 1
  for (int c = 0; c < 32; ++c) {
    const int t0 = b * SEQL + c * 64;
#pragma unroll
    for (int rep = 0; rep < 2; ++rep) {
      const int r = r0 + rep * 32;
      *(bf16x8*)(Wl + r * 136 + seg0 * 8) = pw[rep];
      *(bf16x8*)(Ql + r * 136 + seg0 * 8) = pq[rep];
#pragma unroll
      for (int e = 0; e < 8; ++e) KdT[(seg0 * 8 + e) * 72 + r] = (u16)pk[rep][e];
    }
    *(bf16x8*)(At + ra * 72 + sega * 8) = pa;
    u16 uc[16], zc[16];
#pragma unroll
    for (int q = 0; q < 16; ++q) uc[q] = un[q];
#pragma unroll
    for (int n = 0; n < 4; ++n)
#pragma unroll
      for (int r = 0; r < 4; ++r)
        zc[n * 4 + r] = PROJ[(size_t)(t0 + it * 16 + lq * 4 + r) * NPJ + C_GZ + h * 128 + (vb + n) * 16 + lr];
    lds_barrier();
    if (c + 1 < 32) {
      const int t1 = t0 + 64;
#pragma unroll
      for (int rep = 0; rep < 2; ++rep) {
        const int r = r0 + rep * 32;
        pw[rep] = ld8(WG + (size_t)(t1 + r) * 512 + h * 128 + seg0 * 8);
        pq[rep] = ld8(PROJ + (size_t)(t1 + r) * NPJ + C_GQ + h * 128 + seg0 * 8);
        pk[rep] = ld8(PROJ + (size_t)(t1 + r) * NPJ + C_GK + h * 128 + seg0 * 8);
      }
      pa = ld8(ATT + (size_t)(bh * 32 + c + 1) * 4096 + ra * 64 + sega * 8);
#pragma unroll
      for (int n = 0; n < 4; ++n)
#pragma unroll
        for (int r = 0; r < 4; ++r)
          un[n * 4 + r] = PROJ[(size_t)(t1 + it * 16 + lq * 4 + r) * NPJ + C_GV + h * 128 + (vb + n) * 16 + lr];
    }
    f32x4 vacc[4], oacc[4];
#pragma unroll
    for (int n = 0; n < 4; ++n) { vacc[n] = f32x4{0.f, 0.f, 0.f, 0.f}; oacc[n] = f32x4{0.f, 0.f, 0.f, 0.f}; }
#pragma unroll
    for (int ks = 0; ks < 4; ++ks) {
      bf16x8 aw = ld8(Wl + (it * 16 + lr) * 136 + ks * 32 + lq * 8);
      bf16x8 aq = ld8(Ql + (it * 16 + lr) * 136 + ks * 32 + lq * 8);
#pragma unroll
      for (int n = 0; n < 4; ++n) {
        bf16x8 bs = ld8(St + ((vb + n) * 16 + lr) * 136 + ks * 32 + lq * 8);
        vacc[n] = mfma16(aw, bs, vacc[n]);
        oacc[n] = mfma16(aq, bs, oacc[n]);
      }
    }
#pragma unroll
    for (int n = 0; n < 4; ++n) {
      const int v = (vb + n) * 16 + lr;
      *(s16x4*)(VnT + v * 72 + it * 16 + lq * 4) =
          pack4(bf2f(uc[n * 4 + 0]) - vacc[n][0], bf2f(uc[n * 4 + 1]) - vacc[n][1], bf2f(uc[n * 4 + 2]) - vacc[n][2], bf2f(uc[n * 4 + 3]) - vacc[n][3]);
    }
    lds_barrier();
#pragma unroll
    for (int ks = 0; ks < 2; ++ks) {
      bf16x8 aa = ld8(At + (it * 16 + lr) * 72 + ks * 32 + lq * 8);
#pragma unroll
      for (int n = 0; n < 4; ++n)
        oacc[n] = mfma16(aa, ld8(VnT + ((vb + n) * 16 + lr) * 72 + ks * 32 + lq * 8), oacc[n]);
    }
    {
      bf16x8 ak0 = ld8(KdT + (w * 16 + lr) * 72 + lq * 8), ak1 = ld8(KdT + (w * 16 + lr) * 72 + 32 + lq * 8);
#pragma unroll
      for (int vt = 0; vt < 8; ++vt) {
        f32x4 a = S[vt] * egls[c];
        a = mfma16(ak0, ld8(VnT + (vt * 16 + lr) * 72 + lq * 8), a);
        a = mfma16(ak1, ld8(VnT + (vt * 16 + lr) * 72 + 32 + lq * 8), a);
        S[vt] = a;
        *(s16x4*)(St + (vt * 16 + lr) * 136 + w * 16 + lq * 4) = pack4(a[0], a[1], a[2], a[3]);
      }
    }
    {
      float ssr[4];
#pragma unroll
      for (int r = 0; r < 4; ++r) {
        float sq = 0.f;
#pragma unroll
        for (int n = 0; n < 4; ++n) sq += oacc[n][r] * oacc[n][r];
        sq += __shfl_xor(sq, 1); sq += __shfl_xor(sq, 2); sq += __shfl_xor(sq, 4); sq += __shfl_xor(sq, 8);
        ssr[r] = sq;
      }
      if (lr == 0) {
#pragma unroll
        for (int r = 0; r < 4; ++r) red[(it * 16 + lq * 4 + r) * 2 + (w & 1)] = ssr[r];
      }
    }
    lds_barrier();
#pragma unroll
    for (int r = 0; r < 4; ++r) {
      const int ir = it * 16 + lq * 4 + r;
      const float rs = rsqrtf((red[ir * 2] + red[ir * 2 + 1]) * (1.f / 128.f) + 1e-6f);
#pragma unroll
      for (int n = 0; n < 4; ++n) {
        const int v = (vb + n) * 16 + lr;
        const float z = bf2f(zc[n * 4 + r]);
        const float y = oacc[n][r] * rs * ngv[n] * z * __builtin_amdgcn_rcpf(1.f + __expf(-z));
        PROJ[(size_t)(t0 + ir) * NPJ + C_GV + h * 128 + v] = f2bf(y);
      }
    }
  }
  __syncthreads();
}


static __device__ __attribute__((always_inline)) inline void nsa_attn(const Params& p, int item) {
  char* ws = lsp(p.ws);
  u16* PROJ = (u16*)(ws + OFF_PROJ);
  const u16* KC = (const u16*)(ws + OFF_KC); const u16* VCT = (const u16*)(ws + OFF_VCT);
  u16* Ks = (u16*)lds_base();
  float* impw = (float*)(Ks + 4 * 64 * 72);
  unsigned* selm = (unsigned*)(impw + 4 * 64 * 32);
  unsigned* uni = selm + 64;
  const int tid = lv(threadIdx.x), lane = tid & 63, w = tid >> 6;
  const int hh = w & 3, qhalf = w >> 2, lq5 = lane & 31, hf = lane >> 5;
  const int qb = 31 - (item >> 4), bg = item & 15, b = bg >> 1, g = bg & 1;
  const int ql = qhalf * 32 + lq5, tpos = qb * 64 + ql;
  const size_t row = (size_t)b * SEQL + tpos;
  const int head = g * 4 + hh;
  bf16x8 qf[4];
#pragma unroll
  for (int s = 0; s < 4; ++s) {
    bf16x8 raw = ld8(PROJ + row * NPJ + C_NQ + head * 64 + 16 * s + 8 * hf);
#pragma unroll
    for (int e = 0; e < 8; ++e) raw[e] = (short)f2bf(bfs(raw[e]) * 0.125f);
    qf[s] = raw;
  }
  if (tid == 0) *uni = 0u;
  float gate[3];
#pragma unroll
  for (int i = 0; i < 3; ++i) gate[i] = sigmoidf_(bf2f(PROJ[row * NPJ + C_NG + head * 3 + i]));
  f32x16 ofin[2];
  {
    f32x16 sc[4];
    const u16* kcb = KC + (size_t)(b * 2 + g) * 128 * 64;
#pragma unroll
    for (int mt = 0; mt < 4; ++mt) {
#pragma unroll
      for (int i = 0; i < 16; ++i) sc[mt][i] = 0.f;
#pragma unroll
      for (int s = 0; s < 4; ++s) sc[mt] = mfma32(ld8(kcb + (32 * mt + lq5) * 64 + 16 * s + 8 * hf), qf[s], sc[mt]);
    }
    const int nlim = (tpos >= 31) ? min(126, (tpos - 31) >> 4) : -1;
    float mx = -1e30f;
#pragma unroll
    for (int mt = 0; mt < 4; ++mt)
#pragma unroll
      for (int i = 0; i < 16; ++i) { int n = 32 * mt + crow(i, hf); if (n <= nlim) mx = fmaxf(mx, sc[mt][i]); }
    mx = fmaxf(mx, __shfl_xor(mx, 32));
    float ls = 0.f;
#pragma unroll
    for (int mt = 0; mt < 4; ++mt)
#pragma unroll
      for (int i = 0; i < 16; ++i) {
        int n = 32 * mt + crow(i, hf);
        float pv = (n <= nlim) ? __expf(sc[mt][i] - mx) : 0.f;
        sc[mt][i] = pv; ls += pv;
      }
    ls += __shfl_xor(ls, 32);
    const float inv = ls > 0.f ? 1.f / ls : 0.f;
#pragma unroll
    for (int mt = 0; mt < 4; ++mt)
#pragma unroll
      for (int i = 0; i < 16; ++i) sc[mt][i] *= inv;
    f32x16 oc[2];
#pragma unroll
    for (int i = 0; i < 16; ++i) { oc[0][i] = 0.f; oc[1][i] = 0.f; }
    const u16* vcb = VCT + (size_t)(b * 2 + g) * 64 * 128;
#pragma unroll
    for (int mt = 0; mt < 4; ++mt)
#pragma unroll
      for (int s = 0; s < 2; ++s) {
        bf16x8 pf = pack8(sc[mt], s);
#pragma unroll
        for (int dt = 0; dt < 2; ++dt) {
          const u16* vp = vcb + (32 * dt + lq5) * 128 + 32 * mt + 16 * s + 4 * hf;
          s16x4 lo = ld4(vp), hi = ld4(vp + 8);
          bf16x8 vf = __builtin_shufflevector(lo, hi, 0, 1, 2, 3, 4, 5, 6, 7);
          oc[dt] = mfma32(vf, pf, oc[dt]);
        }
      }
#pragma unroll
    for (int i = 0; i < 16; ++i) { ofin[0][i] = gate[0] * oc[0][i]; ofin[1][i] = gate[0] * oc[1][i]; }
    float G[4][4], rl[4][4];
#pragma unroll
    for (int mt = 0; mt < 4; ++mt)
#pragma unroll
      for (int gi = 0; gi < 4; ++gi) {
        G[mt][gi] = sc[mt][4 * gi] + sc[mt][4 * gi + 1] + sc[mt][4 * gi + 2] + sc[mt][4 * gi + 3];
        rl[mt][gi] = __shfl_xor(sc[mt][4 * gi + 3], 32);
      }
#pragma unroll
    for (int mt = 0; mt < 4; ++mt)
#pragma unroll
      for (int gi = 0; gi < 4; ++gi) {
        float prev;
        if (hf == 1) prev = rl[mt][gi];
        else prev = (gi > 0) ? rl[mt][gi > 0 ? gi - 1 : 0] : (mt > 0 ? rl[mt > 0 ? mt - 1 : 0][3] : 0.f);
        impw[(hh * 64 + ql) * 32 + 8 * mt + 2 * gi + hf] = G[mt][gi] + prev;
      }
  }
  __syncthreads();
  if (tid < 64) {
    float scv[32];
#pragma unroll
    for (int j = 0; j < 32; ++j) {
      float v = impw[(0 * 64 + tid) * 32 + j] + impw[(1 * 64 + tid) * 32 + j] + impw[(2 * 64 + tid) * 32 + j] + impw[(3 * 64 + tid) * 32 + j];
      if (j == 0 || j == qb || j == qb - 1) v += 1000.f;
      scv[j] = (j <= qb) ? v : -1e30f;
    }
    unsigned m = 0u;
#pragma unroll 1
    for (int k = 0; k < 8; ++k) {
      float bv = -1e29f; int best = -1;
#pragma unroll
      for (int j = 0; j < 32; ++j) { bool take = !((m >> j) & 1u) && scv[j] > bv; bv = take ? scv[j] : bv; best = take ? j : best; }
      if (best >= 0) m |= 1u << best;
    }
    selm[tid] = m;
    atomicOr(uni, m);
  }
  __syncthreads();
  const unsigned U = *uni;
  const unsigned sm = selm[ql];
#pragma unroll 1
  for (int mode = 0; mode < 2; ++mode) {
    float mrun = -1e30f, lrun = 0.f;
    f32x16 oacc[2];
#pragma unroll
    for (int i = 0; i < 16; ++i) { oacc[0][i] = 0.f; oacc[1][i] = 0.f; }
    const unsigned tmask = mode ? ((2u << qb) - 1u) & ~((1u << max(0, qb - 8)) - 1u) : U;
    const int r_ld = 32 * (w & 1) + (lane & 31), seg_ld = (w >> 1) * 2 + (lane >> 5);
    const int kcol = C_NKV + (mode ? 4 : 2) * 128 + g * 64 + seg_ld * 8;
    unsigned rem = tmask;
    int j = __ffs(rem) - 1;
    rem &= rem - 1u;
    bf16x8 kreg = ld8(PROJ + ((size_t)b * SEQL + 64 * j + r_ld) * NPJ + kcol);
    bf16x8 vreg = ld8(PROJ + ((size_t)b * SEQL + 64 * j + r_ld) * NPJ + kcol + 128);
    int buf = 0;
#pragma unroll 1
    while (j >= 0) {
      u16* Kb_ = Ks + buf * (2 * 64 * 72);
      u16* Vb_ = Kb_ + 64 * 72;
      *(bf16x8*)(Kb_ + r_ld * 72 + seg_ld * 8) = kreg;
#pragma unroll
      for (int e = 0; e < 8; ++e) Vb_[(seg_ld * 8 + e) * 72 + r_ld] = (u16)vreg[e];
      __syncthreads();
      const int jn = rem ? (__ffs(rem) - 1) : -1;
      rem &= rem - 1u;
      if (jn >= 0) {
        kreg = ld8(PROJ + ((size_t)b * SEQL + 64 * jn + r_ld) * NPJ + kcol);
        vreg = ld8(PROJ + ((size_t)b * SEQL + 64 * jn + r_ld) * NPJ + kcol + 128);
      }
      const bool selj = mode ? true : (((sm >> j) & 1u) != 0u);
      if (mode || __any(selj)) {
        f32x16 st[2];
#pragma unroll
        for (int mt = 0; mt < 2; ++mt) {
#pragma unroll
          for (int i = 0; i < 16; ++i) st[mt][i] = 0.f;
#pragma unroll
          for (int s = 0; s < 4; ++s) st[mt] = mfma32(ld8(Kb_ + (32 * mt + lq5) * 72 + 16 * s + 8 * hf), qf[s], st[mt]);
        }
        const bool need_mask = (j == qb) || (mode && j == qb - 8);
        float mloc = -1e30f;
        if (need_mask) {
#pragma unroll
          for (int mt = 0; mt < 2; ++mt)
#pragma unroll
            for (int i = 0; i < 16; ++i) {
              const int dist = tpos - (64 * j + 32 * mt + crow(i, hf));
              const bool ok = selj && dist >= 0 && dist < 512;
              st[mt][i] = ok ? st[mt][i] : -1e30f;
              mloc = fmaxf(mloc, st[mt][i]);
            }
        } else {
#pragma unroll
          for (int mt = 0; mt < 2; ++mt)
#pragma unroll
            for (int i = 0; i < 16; ++i) mloc = fmaxf(mloc, st[mt][i]);
          mloc = selj ? mloc : -1e30f;
        }
        mloc = fmaxf(mloc, __shfl_xor(mloc, 32));
        const float mnew = fmaxf(mrun, mloc);
        const float alpha = __expf(mrun - mnew);
        const bool live = selj && (mnew > -1e29f);
        float psum = 0.f;
#pragma unroll
        for (int mt = 0; mt < 2; ++mt)
#pragma unroll
          for (int i = 0; i < 16; ++i) {
            float pv = __expf(st[mt][i] - mnew);
            pv = live ? pv : 0.f;
            st[mt][i] = pv; psum += pv;
          }
        lrun = lrun * alpha + psum;
        mrun = mnew;
#pragma unroll
        for (int i = 0; i < 16; ++i) { oacc[0][i] *= alpha; oacc[1][i] *= alpha; }
#pragma unroll
        for (int mt = 0; mt < 2; ++mt)
#pragma unroll
          for (int s = 0; s < 2; ++s) {
            bf16x8 pf = pack8(st[mt], s);
#pragma unroll
            for (int dt = 0; dt < 2; ++dt) {
              const u16* vp = Vb_ + (32 * dt + lq5) * 72 + 32 * mt + 16 * s + 4 * hf;
              s16x4 lo = ld4(vp), hi = ld4(vp + 8);
              bf16x8 vf = __builtin_shufflevector(lo, hi, 0, 1, 2, 3, 4, 5, 6, 7);
              oacc[dt] = mfma32(vf, pf, oacc[dt]);
            }
          }
      }
      buf ^= 1;
      j = jn;
    }
    const float ltot = lrun + __shfl_xor(lrun, 32);
    const float sc_ = (ltot > 0.f) ? gate[1 + mode] / ltot : 0.f;
#pragma unroll
    for (int i = 0; i < 16; ++i) { ofin[0][i] += sc_ * oacc[0][i]; ofin[1][i] += sc_ * oacc[1][i]; }
    __syncthreads();
  }
#pragma unroll
  for (int dt = 0; dt < 2; ++dt)
#pragma unroll
    for (int g4 = 0; g4 < 4; ++g4)
      *(s16x4*)(PROJ + row * NPJ + C_NQ + head * 64 + 32 * dt + 8 * g4 + 4 * hf) =
          pack4(ofin[dt][4 * g4], ofin[dt][4 * g4 + 1], ofin[dt][4 * g4 + 2], ofin[dt][4 * g4 + 3]);
  __syncthreads();
}

static __device__ __attribute__((always_inline)) inline void phase_merge(const Params& p) {
  char* ws = lsp(p.ws);
  u16* H = (u16*)(ws + OFF_H); u16* WinT = (u16*)(ws + OFF_WBIG); u16* PROJ = (u16*)(ws + OFF_PROJ);
  u16* WbrT = (u16*)(ws + OFF_WBR); u16* M = (u16*)(ws + OFF_SCR);
  const int nM = 64, nN = 4;
  for (int t = blockIdx.x; t < nM * nN; t += gridDim.x) {
    int pm, pn; tile_map(t, nM, nN, pm, pn);
#pragma unroll 1
    for (int i = 0; i < 3; ++i) {
      const int boff = 5120 + i * 1024 + pn * 256;
      gemm_tile(H, 1024, WinT, 1024, 1024, pm * 256, boff, [&](int idx, int row, int col, f32x4 v) {
        *(s16x4*)(PROJ + (size_t)row * NPJ + C_SK + (col - 5120 - i * 1024)) = pack4(sigmoidf_(v[0]), sigmoidf_(v[1]), sigmoidf_(v[2]), sigmoidf_(v[3]));
      });
      const int ycol = (i == 0) ? C_GV : (i == 1 ? C_NQ : C_SQ);
      s16x4 gbuf[2], mbuf[2];
      gemm_tile(PROJ + ycol, NPJ, WbrT + (size_t)i * 1024 * 512, 512, 512, pm * 256, pn * 256, [&](int idx, int row, int col, f32x4 v) {
        const s16x4 gte = gbuf[idx];
        float o0 = bfs(gte[0]) * v[0], o1 = bfs(gte[1]) * v[1], o2 = bfs(gte[2]) * v[2], o3 = bfs(gte[3]) * v[3];
        if (i > 0) { const s16x4 pv = mbuf[idx]; o0 += bfs(pv[0]); o1 += bfs(pv[1]); o2 += bfs(pv[2]); o3 += bfs(pv[3]); }
        *(s16x4*)(M + (unsigned)(row * 1024 + col)) = pack4(o0, o1, o2, o3);
      }, [&](int idx, int row, int col) {
        gbuf[idx] = ld4(PROJ + (unsigned)(row * NPJ + C_SK + col));
        if (i > 0) mbuf[idx] = ld4(M + (unsigned)(row * 1024 + col));
      });
    }
  }
}

template <int MODE>
static __device__ __attribute__((always_inline)) inline void phase_gemm(const u16* A, int lda, const u16* Bt, int ldb, int K, int nM, int nN, u16* C, int ldc) {
  for (int t = blockIdx.x; t < nM * nN; t += gridDim.x) {
    int pm, pn; tile_map(t, nM, nN, pm, pn);
    gemm_tile(A, lda, Bt, ldb, K, pm * 256, pn * 256, [&](int idx, int row, int col, f32x4 v) {
      if (MODE == 1) {
#pragma unroll
        for (int q = 0; q < 4; ++q) { float t = fmaxf(v[q], 0.f); v[q] = t * t; }
      }
      *(s16x4*)(C + (size_t)row * ldc + col) = pack4(v[0], v[1], v[2], v[3]);
    });
  }
}


#define XB_TMO      128
#define XB_XCNT(j)  (256  + 64 * (j))
#define XB_XSUB(j)  (1280 + 64 * (j))
#define XB_XGEN(j)  (2304 + 64 * (j))
#define XB_TOP      3328
#define XB_TOPGEN   3392
#define XCD_BAR_WORDS 3456
#define XB_SPIN_CAP (1u << 18)
#define LAS __attribute__((address_space(3)))
DI unsigned xb_ld(unsigned* q)              { return __hip_atomic_load(q, __ATOMIC_RELAXED, __HIP_MEMORY_SCOPE_AGENT); }
DI unsigned xb_add(unsigned* q, unsigned v) { return __hip_atomic_fetch_add(q, v, __ATOMIC_RELAXED, __HIP_MEMORY_SCOPE_AGENT); }
DI unsigned xb_xcc_id() { return (unsigned)__builtin_amdgcn_s_getreg((3 << 11) | 20) & 0xFu; }
#define XB_SPIN(cond, bar) do { unsigned _sp = 0; while (cond) { __builtin_amdgcn_s_sleep(1); \
    if ((++_sp & 255u) == 0u) { if (xb_ld(&(bar)[XB_TMO])) break; if (_sp > XB_SPIN_CAP) { atomicAdd(&(bar)[XB_TMO], 1u); break; } } } } while (0)
struct XcdBarrier { unsigned* bar; unsigned x; volatile LAS unsigned* st; };
DI XcdBarrier xcd_barrier_post(unsigned* bar, volatile LAS unsigned* st) {
  XcdBarrier b; b.bar = bar; b.x = xb_xcc_id(); b.st = st;
  if (threadIdx.x == 0) (void)xb_add(&bar[XB_XCNT(b.x)], 1u);
  return b;
}
DI void xcd_barrier_complete(unsigned* bar, unsigned x, unsigned& nloc, unsigned& nx) {
  const unsigned G = gridDim.x * gridDim.y * gridDim.z;
  unsigned sum, cnt, mine, sp = 0u;
  for (;;) {
    sum = 0u; cnt = 0u; mine = 0u;
#pragma unroll
    for (unsigned j = 0; j < 16; ++j) { const unsigned c = xb_ld(&bar[XB_XCNT(j)]); sum += c; cnt += (c > 0u) ? 1u : 0u; mine = (j == x) ? c : mine; }
    if (sum == G) break;
    __builtin_amdgcn_s_sleep(1);
    if ((++sp & 255u) == 0u) { if (xb_ld(&bar[XB_TMO])) break; if (sp > XB_SPIN_CAP) { atomicAdd(&bar[XB_TMO], 1u); break; } }
  }
  nloc = mine > 0u ? mine : 1u; nx = cnt > 0u ? cnt : 1u;
}
DI void xcd_barrier(const XcdBarrier& b) {
  asm volatile("s_waitcnt vmcnt(0)" ::: "memory");
  __syncthreads();
  if (threadIdx.x == 0) {
    unsigned* bar = b.bar;
    __builtin_amdgcn_s_waitcnt(0);
    unsigned nloc = b.st[0], nx = b.st[1];
    if (nloc == 0u) { xcd_barrier_complete(bar, b.x, nloc, nx); b.st[0] = nloc; b.st[1] = nx; }
    const unsigned old = xb_add(&bar[XB_XSUB(b.x)], 1u);
    const unsigned gen = old / nloc;
    if (old + 1u == (gen + 1u) * nloc) {
      __builtin_amdgcn_fence(__ATOMIC_RELEASE, "agent");
      asm volatile("s_waitcnt vmcnt(0)" ::: "memory");
      const unsigned og = xb_add(&bar[XB_TOP], 1u);
      const unsigned tg = og / nx;
      if (og + 1u == (tg + 1u) * nx) xb_add(&bar[XB_TOPGEN], 1u);
      else XB_SPIN(xb_ld(&bar[XB_TOPGEN]) == tg, bar);
      __builtin_amdgcn_fence(__ATOMIC_ACQUIRE, "agent");
      xb_add(&bar[XB_XGEN(b.x)], 1u);
      asm volatile("s_waitcnt vmcnt(0)" ::: "memory");
    } else {
      XB_SPIN(xb_ld(&bar[XB_XGEN(b.x)]) == gen, bar);
      __builtin_amdgcn_fence(__ATOMIC_ACQUIRE, "agent");
      asm volatile("s_waitcnt vmcnt(0)" ::: "memory");
    }
  }
  __syncthreads();
}

__global__ void __launch_bounds__(512) fwd_megakernel(Params p_unused) {
#define p (kp())
  cg::grid_group grid = cg::this_grid();
  volatile LAS unsigned* xst = (volatile LAS unsigned*)((LAS char*)g_shm + LDS_XST);
  if (threadIdx.x == 0) { xst[0] = 0u; xst[1] = 0u; }
  __syncthreads();
  (void)xcd_barrier_post((unsigned*)(lsp(p.ws) + OFF_BAR), xst);
#define GSYNC() do { XcdBarrier xb_; xb_.bar = (unsigned*)(lsp(p.ws) + OFF_BAR); unsigned xx_ = xb_xcc_id(); asm volatile("" : "+s"(xx_)); xb_.x = xx_; \
    xb_.st = (volatile LAS unsigned*)((LAS char*)g_shm + LDS_XST); xcd_barrier(xb_); } while (0)
#define WSP(off) ((u16*)(lsp(p.ws) + (off)))
  phase_norm(p.x, nullptr, nullptr, p.g_mix_pre, nullptr, WSP(OFF_H));
  convert_mixer_weights(p, 0);
  if (p.ws == nullptr) grid.sync();
  GSYNC();
#pragma unroll 1
  for (int l = 0; l < 2; ++l) {
    phase_inproj(p);
    GSYNC();
    {
      volatile LAS int* qslot = (volatile LAS int*)((LAS char*)g_shm + LDS_XST + 16);
#pragma unroll 1
      for (;;) {
        if (threadIdx.x == 0) *qslot = (int)atomicAdd((unsigned*)(lsp(p.ws) + OFF_QCTR) + l * 64 + 32, 1u);
        __syncthreads();
        const int it = *qslot;
        __syncthreads();
        if (it >= 1152) break;
        if (it < 1024) gdn_prep(p, l, it);
        else nsa_compress(p, l, it - 1024);
      }
    }
    GSYNC();
    if (blockIdx.x < 32) gdn_scan(p, l, blockIdx.x);
    {
      volatile LAS int* qslot = (volatile LAS int*)((LAS char*)g_shm + LDS_XST + 16);
#pragma unroll 1
      for (;;) {
        if (threadIdx.x == 0) *qslot = (int)atomicAdd((unsigned*)(lsp(p.ws) + OFF_QCTR) + l * 64, 1u);
        __syncthreads();
        const int it = *qslot;
        __syncthreads();
        if (it >= 768) break;
        if (it < 192) nsa_attn(p, it);
        else if (it < 448) { sb_attn_wave(p, (it - 192) * 8 + (lv(threadIdx.x) >> 6)); __syncthreads(); }
        else nsa_attn(p, it - 256);
      }
    }
    GSYNC();
    phase_merge(p);
    GSYNC();
    phase_gemm<0>(WSP(OFF_SCR), 1024, WSP(OFF_WOUT), 1024, 1024, 64, 4, WSP(OFF_H), 1024);
    GSYNC();
    phase_norm(l == 0 ? p.x : p.out, WSP(OFF_H), p.g_mix_post + l * 1024, p.g_ff_pre + l * 1024, p.out, WSP(OFF_H));
    convert_ffn_weights(p, l);
    GSYNC();
    phase_gemm<1>(WSP(OFF_H), 1024, WSP(OFF_WBIG), 1024, 1024, 64, 16, WSP(OFF_PROJ), 4096);
    GSYNC();
    phase_gemm<0>(WSP(OFF_PROJ), 4096, WSP(OFF_WBIG) + (size_t)4096 * 1024, 4096, 4096, 64, 4, WSP(OFF_SCR), 1024);
    GSYNC();
    phase_norm(p.out, WSP(OFF_SCR), p.g_ff_post + l * 1024, (l == 0) ? p.g_mix_pre + 1024 : nullptr, p.out, WSP(OFF_H));
    if (l == 0) { convert_mixer_weights(p, 1); GSYNC(); }
  }
}
#undef p

extern "C" void kernel_launch(void* const* d_in, const int* in_sizes, int n_in, void* d_out, int out_size, void* d_ws,
                              size_t ws_size, hipStream_t stream) {
  static int grid_blocks = 0;
  if (!grid_blocks) {
    int dev = 0, cus = 0, per_cu = 0;
    (void)hipGetDevice(&dev);
    (void)hipDeviceGetAttribute(&cus, hipDeviceAttributeMultiprocessorCount, dev);
    (void)hipFuncSetAttribute((const void*)fwd_megakernel, hipFuncAttributeMaxDynamicSharedMemorySize, LDS_BYTES);
    (void)hipOccupancyMaxActiveBlocksPerMultiprocessor(&per_cu, (const void*)fwd_megakernel, 512, LDS_BYTES);
    if (per_cu < 1) per_cu = 1;
    grid_blocks = cus * 1;
    if (ws_size < WS_NEED) fprintf(stderr, "workspace too small: %zu < %zu\n", ws_size, (size_t)WS_NEED);
  }
  Params p{};
  p.x = (const float*)d_in[0]; p.g_mix_pre = (const float*)d_in[1]; p.g_mix_post = (const float*)d_in[2];
  p.g_ff_pre = (const float*)d_in[3]; p.g_ff_post = (const float*)d_in[4]; p.w_in = (const float*)d_in[5];
  p.conv_w = (const float*)d_in[6]; p.a_log = (const float*)d_in[7]; p.dt_bias = (const float*)d_in[8];
  p.norm_g = (const float*)d_in[9]; p.cmp_wk = (const float*)d_in[10]; p.cmp_pk = (const float*)d_in[11];
  p.cmp_wv = (const float*)d_in[12]; p.cmp_pv = (const float*)d_in[13]; p.w_br0 = (const float*)d_in[14];
  p.w_br1 = (const float*)d_in[15]; p.w_br2 = (const float*)d_in[16]; p.w_out = (const float*)d_in[17];
  p.w_ff1 = (const float*)d_in[18]; p.w_ff2 = (const float*)d_in[19];
  p.out = (float*)d_out; p.ws = (char*)d_ws;
  (void)hipMemsetAsync((char*)d_ws + OFF_BAR, 0, 16384, stream);
  void* args[] = {&p};
  hipError_t e = hipLaunchCooperativeKernel((const void*)fwd_megakernel, dim3(grid_blocks), dim3(512), args, LDS_BYTES, stream);
  if (e != hipSuccess) fprintf(stderr, "cooperative launch failed: %s (grid %d)\n", hipGetErrorString(e), grid_blocks);
}
```
